# Optimizing an MI355X kernel written in HIP

```python
import math
import jax, jax.numpy as jnp
from jax import lax
import numpy as np

D_MODEL = 1024
BATCH = 2
SEQ = 16384
DEPTH = 2

GRID_W = 64
CTX_LEN = 256
N_MIXERS = 2
EXPAND = 2
E_CONV = EXPAND * D_MODEL
CONV_W = 3
E_SSM = EXPAND * D_MODEL
SSM_GROUP = 16
N_GROUPS = E_SSM // SSM_GROUP
SSM_STATE = 64
SCAN_CHUNK = 128
LN_EPS = 1e-5
DN_ALPHA = (2 * DEPTH) ** 0.25
DN_BETA = (8 * DEPTH) ** -0.25
N_CONV_LAYERS = (DEPTH + 1) // 2
N_SSM_LAYERS = DEPTH // 2

kernel_name = "hybrid_shortconv_s5_prefix_dit"


def _layernorm(x, g, b):
    xf = x.astype(jnp.float32)
    mu = jnp.mean(xf, axis=-1, keepdims=True)
    var = jnp.mean(jnp.square(xf - mu), axis=-1, keepdims=True)
    return ((xf - mu) * lax.rsqrt(var + LN_EPS) * g.astype(jnp.float32) + b.astype(jnp.float32)).astype(x.dtype)


def _ada(cvec, w, b):
    m = jax.nn.silu(cvec) @ w + b
    shift, scale, gate = jnp.split(m, 3, axis=-1)
    return shift[..., None, :], scale[..., None, :], gate[..., None, :]


def _shift_conv(u, w, axis):
    n = u.shape[axis]
    pad = [(0, 0)] * u.ndim
    pad[axis] = (1, 1)
    up = jnp.pad(u, pad)
    sl = lambda k: lax.slice_in_dim(up, k, k + n, axis=axis)
    return sl(0) * w[0] + sl(1) * w[1] + sl(2) * w[2]


def _conv_grid(u, w):
    bsz, L, E = u.shape
    rows = L // GRID_W
    half = E // 2
    ug = u.reshape(bsz, rows, GRID_W, E)
    yh = _shift_conv(ug[..., :half], w[:, :half], axis=2)
    yv = _shift_conv(ug[..., half:], w[:, half:], axis=1)
    return jnp.concatenate([yh, yv], axis=-1).reshape(bsz, L, E)


def _conv_mixer(h, w_in, w_conv, w_out, grid):
    bg, cg, v, z = jnp.split(h @ w_in, 4, axis=-1)
    u = cg * v
    yc = _conv_grid(u, w_conv) if grid else _shift_conv(u, w_conv, axis=1)
    return (bg * yc * jax.nn.silu(z)) @ w_out


def _zoh(lam_re, lam_im, log_step, b_re, b_im):
    dt = jnp.exp(log_step)[:, None]
    mag = jnp.exp(lam_re * dt)
    ar = mag * jnp.cos(lam_im * dt)
    ai = mag * jnp.sin(lam_im * dt)
    qr, qi = ar - 1.0, ai
    den = lam_re * lam_re + lam_im * lam_im
    fr = (qr * lam_re + qi * lam_im) / den
    fi = (qi * lam_re - qr * lam_im) / den
    bbr = fr[..., None] * b_re - fi[..., None] * b_im
    bbi = fr[..., None] * b_im + fi[..., None] * b_re
    return ar, ai, bbr, bbi


def _binop(e1, e2):
    a1r, a1i, b1r, b1i = e1
    a2r, a2i, b2r, b2i = e2
    return (a2r * a1r - a2i * a1i,
            a2r * a1i + a2i * a1r,
            a2r * b1r - a2i * b1i + b2r,
            a2r * b1i + a2i * b1r + b2i)


def _s5_scan(u, h0r, h0i, ar, ai, bbr, bbi, c_re, c_im, with_output):
    bsz, L, _ = u.shape
    n_blk = L // SCAN_CHUNK
    ub = u.reshape(bsz, n_blk, SCAN_CHUNK, N_GROUPS, SSM_GROUP).transpose(1, 0, 2, 3, 4)

    def step(carry, u_blk):
        hr, hi = carry
        bur = jnp.einsum('btgp,gnp->btgn', u_blk, bbr)
        bui = jnp.einsum('btgp,gnp->btgn', u_blk, bbi)
        bur = bur.at[:, 0].add(ar * hr - ai * hi)
        bui = bui.at[:, 0].add(ar * hi + ai * hr)
        a_r = jnp.broadcast_to(ar, bur.shape)
        a_i = jnp.broadcast_to(ai, bur.shape)
        _, _, sr, si = lax.associative_scan(_binop, (a_r, a_i, bur, bui), axis=1)
        new = (sr[:, -1], si[:, -1])
        if with_output:
            y = jnp.einsum('btgn,gpn->btgp', sr, c_re) - jnp.einsum('btgn,gpn->btgp', si, c_im)
            return new, y
        return new, None

    h_final, ys = lax.scan(step, (h0r, h0i), ub)
    if with_output:
        ys = ys.transpose(1, 0, 2, 3, 4).reshape(bsz, L, E_SSM)
    return ys, h_final


def _glu_gate_out(y, z, w_glu, b_glu, w_out):
    g = jax.nn.gelu(y)
    g = g * jax.nn.sigmoid(g @ w_glu + b_glu)
    return (g * jax.nn.silu(z)) @ w_out


def _s5_mixer(h_lat, h_ctx, w_in, lam_re, lam_im, log_step, b_re, b_im, c_re, c_im, d,
              w_glu, b_glu, w_out, ctx_out):
    u_l, z_l = jnp.split(h_lat @ w_in, 2, axis=-1)
    pc = h_ctx @ w_in
    u_c = pc[..., :E_SSM]
    y_l = d * u_l
    y_c = d * u_c if ctx_out else None
    for r in range(2):
        ar, ai, bbr, bbi = _zoh(lam_re[r], lam_im[r], log_step[r], b_re[r], b_im[r])
        seq = (lambda t: t[:, ::-1]) if r == 1 else (lambda t: t)
        dtype = jnp.result_type(u_c.dtype, bbr.dtype)
        h0 = jnp.zeros((u_c.shape[0], N_GROUPS, SSM_STATE), dtype)
        yc, hc = _s5_scan(seq(u_c), h0, h0, ar, ai, bbr, bbi, c_re[r], c_im[r], ctx_out)
        yl, _ = _s5_scan(seq(u_l), hc[0], hc[1], ar, ai, bbr, bbi, c_re[r], c_im[r], True)
        y_l = y_l + seq(yl)
        if ctx_out:
            y_c = y_c + seq(yc)
    out_l = _glu_gate_out(y_l, z_l, w_glu, b_glu, w_out)
    out_c = _glu_gate_out(y_c, pc[..., E_SSM:], w_glu, b_glu, w_out) if ctx_out else None
    return out_l, out_c


def setup_inputs(seed: int = 0) -> dict:
    key = jax.random.key(seed)
    ks = jax.random.split(key, 24)
    f32 = jnp.float32
    nrm = lambda k, shape, s: jax.random.normal(k, shape, f32) * s
    nA, nB = N_CONV_LAYERS, N_SSM_LAYERS
    G, N, P = N_GROUPS, SSM_STATE, SSM_GROUP
    return {
        "x": nrm(ks[0], (BATCH, SEQ, D_MODEL), 1.0),
        "c": nrm(ks[1], (BATCH, D_MODEL), 1.0),
        "ctx": nrm(ks[2], (BATCH, CTX_LEN, D_MODEL), 1.0),
        "c_ctx": nrm(ks[3], (D_MODEL,), 1.0),
        "ada_w": nrm(ks[4], (DEPTH, D_MODEL, 3 * D_MODEL), D_MODEL ** -0.5),
        "ada_b": nrm(ks[5], (DEPTH, 3 * D_MODEL), 0.02),
        "ln_g": 1.0 + nrm(ks[6], (DEPTH, D_MODEL), 0.02),
        "ln_b": nrm(ks[7], (DEPTH, D_MODEL), 0.02),
        "conv_w_in": nrm(ks[8], (nA, D_MODEL, 4 * E_CONV), D_MODEL ** -0.5),
        "conv_w": nrm(ks[9], (nA, CONV_W, E_CONV), CONV_W ** -0.5),
        "conv_w_out": nrm(ks[10], (nA, E_CONV, D_MODEL), DN_BETA * E_CONV ** -0.5),
        "ssm_w_in": nrm(ks[11], (nB, D_MODEL, 2 * E_SSM), D_MODEL ** -0.5),
        "ssm_lam_re": -0.5 * jnp.exp(nrm(ks[12], (nB, 2, G, N), 0.05)),
        "ssm_lam_im": jnp.pi * jnp.arange(N, dtype=f32) + nrm(ks[13], (nB, 2, G, N), 0.05),
        "ssm_log_step": jax.random.uniform(ks[14], (nB, 2, G), f32, math.log(1e-3), math.log(1e-1)),
        "ssm_b_re": nrm(ks[15], (nB, 2, G, N, P), (2 * P) ** -0.5),
        "ssm_b_im": nrm(ks[16], (nB, 2, G, N, P), (2 * P) ** -0.5),
        "ssm_c_re": nrm(ks[17], (nB, 2, G, P, N), N ** -0.5),
        "ssm_c_im": nrm(ks[18], (nB, 2, G, P, N), N ** -0.5),
        "ssm_d": nrm(ks[19], (nB, E_SSM), 1.0),
        "ssm_w_glu": nrm(ks[20], (nB, E_SSM, E_SSM), E_SSM ** -0.5),
        "ssm_b_glu": nrm(ks[21], (nB, E_SSM), 0.02),
        "ssm_w_out": nrm(ks[22], (nB, E_SSM, D_MODEL), DN_BETA * E_SSM ** -0.5),
    }


def reference(x, c, ctx, c_ctx, ada_w, ada_b, ln_g, ln_b, conv_w_in, conv_w, conv_w_out,
              ssm_w_in, ssm_lam_re, ssm_lam_im, ssm_log_step, ssm_b_re, ssm_b_im,
              ssm_c_re, ssm_c_im, ssm_d, ssm_w_glu, ssm_b_glu, ssm_w_out):
    for i in range(DEPTH):
        last = i == DEPTH - 1
        is_conv = (i % N_MIXERS) == 0
        j = i // N_MIXERS
        need_ctx_out = not last
        need_ctx_in = need_ctx_out or not is_conv
        sh, sc, gt = _ada(c, ada_w[i], ada_b[i])
        hx = x * (1.0 + sc) + sh
        if need_ctx_in:
            sh_c, sc_c, gt_c = _ada(c_ctx, ada_w[i], ada_b[i])
            hc = ctx * (1.0 + sc_c) + sh_c
        if is_conv:
            fx = _conv_mixer(hx, conv_w_in[j], conv_w[j], conv_w_out[j], True)
            fc = _conv_mixer(hc, conv_w_in[j], conv_w[j], conv_w_out[j], False) if need_ctx_out else None
        else:
            fx, fc = _s5_mixer(hx, hc, ssm_w_in[j], ssm_lam_re[j], ssm_lam_im[j], ssm_log_step[j],
                               ssm_b_re[j], ssm_b_im[j], ssm_c_re[j], ssm_c_im[j], ssm_d[j],
                               ssm_w_glu[j], ssm_b_glu[j], ssm_w_out[j], need_ctx_out)
        x = _layernorm(DN_ALPHA * x + gt * fx, ln_g[i], ln_b[i])
        if need_ctx_out:
            ctx = _layernorm(DN_ALPHA * ctx + gt_c * fc, ln_g[i], ln_b[i])
    return x
```

```cpp
#include <hip/hip_runtime.h>
#include <cstdio>
#include <cstdint>

#ifndef MK_N_LAUNCHES
#define MK_N_LAUNCHES 1
#endif
#ifndef NAIVE_MASK
#define NAIVE_MASK 0
#endif

#define GAS __attribute__((address_space(1)))
#define LAS __attribute__((address_space(3)))
typedef unsigned short bf16;
typedef short bf16x8 __attribute__((ext_vector_type(8)));
typedef float f32x4 __attribute__((ext_vector_type(4)));
typedef float f32x2 __attribute__((ext_vector_type(2)));
typedef unsigned u32x4 __attribute__((ext_vector_type(4)));
typedef unsigned u32x2 __attribute__((ext_vector_type(2)));

constexpr int D = 1024, NBATCH = 2, SEQ = 16384, CTXL = 256, GRIDW = 64, EW = 2048, NG = 128, NST = 64, PG = 16;
constexpr int RL = NBATCH * SEQ;
constexpr int RC = NBATCH * CTXL;
constexpr int RT = RL + RC;
constexpr int TCH = 64;
constexpr int TP = TCH * PG;
constexpr int XLD = TP + 4 * NST;
constexpr int NCHB = SEQ / TCH;
constexpr int NCOL = NBATCH * NCHB;
constexpr int PSTR = 2 * TCH * PG;
constexpr int KRG = PG * PSTR;
constexpr float LN_EPS = 1e-5f;
constexpr float DN_ALPHA = 1.41421356237f;

constexpr size_t MiB = 1u << 20;
constexpr size_t WS_CTL = 0, CTL_ZERO_BYTES = 1 * MiB;
constexpr size_t WS_MOD = 1 * MiB;
constexpr size_t WS_ZA = 1 * MiB + 256 * 1024;
constexpr size_t WS_BBG = 2 * MiB;
constexpr size_t WS_WG = 6 * MiB, WS_W5 = 14 * MiB, WS_W3 = 18 * MiB;
constexpr size_t WS_KR = 26 * MiB;
constexpr size_t WS_M4 = 34 * MiB;
constexpr size_t WS_HX = 98 * MiB;
constexpr size_t WS_X = 163 * MiB;
constexpr size_t WS_A2 = 163 * MiB;
constexpr size_t WS_SZ = 195 * MiB;
constexpr size_t WS_M2 = 323 * MiB;
constexpr size_t WS_G = 323 * MiB;
constexpr size_t WS_S = 387 * MiB;
constexpr size_t WS_HXV = 387 * MiB;
constexpr size_t WS_UCTX = 452 * MiB;
constexpr size_t WS_W1 = 454 * MiB, WS_W2 = 470 * MiB;
constexpr size_t WS_Y1C = 474 * MiB;
constexpr size_t WS_A4 = 34 * MiB;
constexpr size_t WS_END = 476 * MiB;
constexpr size_t HXPLANE = (size_t)RT * 128;
constexpr size_t A4PLANE = (size_t)RL * 128;
constexpr size_t GPLANE = (size_t)RL * 32;
constexpr size_t XPLANE = (size_t)NCOL * XLD * 2;
static_assert(WS_X + (size_t)NG * XPLANE <= WS_M2 && WS_A2 + 32 * HXPLANE <= WS_M2, "map");
static_assert(WS_HX + 16 * HXPLANE <= WS_X && WS_HXV + 16 * HXPLANE <= WS_UCTX + 2 * MiB && WS_S + (size_t)NG * NCOL * 256 * 4 <= WS_UCTX, "map");
static_assert(WS_G + (size_t)NG * GPLANE <= WS_UCTX && WS_SZ + (size_t)RL * 2048 * 2 <= WS_G && WS_A4 + 32 * A4PLANE <= WS_X, "map");
static_assert(WS_M4 + (size_t)NG * TP * 256 * 2 <= WS_HX && WS_KR + (size_t)NG * KRG * 2 <= WS_M4 && WS_M2 + (size_t)NG * 256 * TP * 2 <= WS_S, "map");
constexpr int CW_BAR = 4096;

constexpr int RING_BYTES = 131072;
constexpr int XL_OFF = RING_BYTES;
constexpr int XL_BYTES = 130 * 128;
constexpr int MISC_OFF = XL_OFF + XL_BYTES;
constexpr int LDS_BYTES = MISC_OFF + 128;

#define RLX_AGENT __ATOMIC_RELAXED, __HIP_MEMORY_SCOPE_AGENT
#define LDS_WAIT() asm volatile("s_waitcnt lgkmcnt(0)" ::: "memory")
#define VM_WAIT() asm volatile("s_waitcnt vmcnt(0)" ::: "memory")
__host__ __device__ __forceinline__ unsigned f2bf(float f) { unsigned u = __builtin_bit_cast(unsigned, f); return (u + 0x7fffu + ((u >> 16) & 1u)) >> 16; }
__host__ __device__ __forceinline__ unsigned pk2(float lo, float hi) { return f2bf(lo) | (f2bf(hi) << 16); }
__host__ __device__ __forceinline__ float bf2f(unsigned b) { return __builtin_bit_cast(float, (b & 0xffffu) << 16); }
__device__ __forceinline__ float sigmoidf_(float x) { return 1.0f / (1.0f + __expf(-x)); }
__device__ __forceinline__ float siluf_(float x) { return x * sigmoidf_(x); }
__device__ __forceinline__ float gelu_tanh(float x) { return x * sigmoidf_(1.5957691216f * (x + 0.044715f * x * x * x)); }
__device__ __forceinline__ float wave_sum(float v) {
#pragma unroll
    for (int o = 1; o < 64; o <<= 1) v += __shfl_xor(v, o);
    return v;
}

#define XB_TMO      128
#define XB_XCNT(j)  (256  + 64 * (j))
#define XB_XSUB(j)  (1280 + 64 * (j))
#define XB_XGEN(j)  (2304 + 64 * (j))
#define XB_TOP      3328
#define XB_TOPGEN   3392
#define XCD_BAR_WORDS 3456
#define XB_SPIN_CAP (1u << 20)
__device__ __forceinline__ unsigned xb_ld(unsigned* p)              { return __hip_atomic_load(p, __ATOMIC_RELAXED, __HIP_MEMORY_SCOPE_AGENT); }
__device__ __forceinline__ unsigned xb_add(unsigned* p, unsigned v) { return __hip_atomic_fetch_add(p, v, __ATOMIC_RELAXED, __HIP_MEMORY_SCOPE_AGENT); }
__device__ __forceinline__ unsigned xb_xcc_id() { return (unsigned)__builtin_amdgcn_s_getreg((3 << 11) | 20) & 0xFu; }
#define XB_SPIN(cond, bar) do { unsigned _sp = 0; while (cond) { __builtin_amdgcn_s_sleep(1); \
    if ((++_sp & 255u) == 0u) { if (xb_ld(&(bar)[XB_TMO])) break; if (_sp > XB_SPIN_CAP) { atomicAdd(&(bar)[XB_TMO], 1u); break; } } } } while (0)
struct XcdBarrier { unsigned* bar; unsigned x; volatile LAS unsigned* st; };
__device__ __forceinline__ XcdBarrier xcd_barrier_post(unsigned* bar, volatile LAS unsigned* st) {
    XcdBarrier b; b.bar = bar; b.x = xb_xcc_id(); b.st = st;
    if (threadIdx.x == 0) (void)xb_add(&bar[XB_XCNT(b.x)], 1u);
    return b;
}
__device__ __forceinline__ void xcd_barrier_complete(unsigned* bar, unsigned x, unsigned& nloc, unsigned& nx) {
    const unsigned G = gridDim.x * gridDim.y * gridDim.z;
    unsigned sum, cnt, mine, sp = 0u;
    for (;;) {
        sum = 0u; cnt = 0u; mine = 0u;
#pragma unroll
        for (unsigned j = 0; j < 16; ++j) { const unsigned c = xb_ld(&bar[XB_XCNT(j)]); sum += c; cnt += (c > 0u) ? 1u : 0u; mine = (j == x) ? c : mine; }
        if (sum == G) break;
        __builtin_amdgcn_s_sleep(1);
        if ((++sp & 255u) == 0u) { if (xb_ld(&bar[XB_TMO])) break; if (sp > XB_SPIN_CAP) { atomicAdd(&bar[XB_TMO], 1u); break; } }
    }
    nloc = mine > 0u ? mine : 1u; nx = cnt > 0u ? cnt : 1u;
}
__device__ __forceinline__ void xcd_barrier(const XcdBarrier& b) {
    asm volatile("s_waitcnt vmcnt(0)" ::: "memory");
    __syncthreads();
    if (threadIdx.x == 0) {
        unsigned* bar = b.bar;
        __builtin_amdgcn_s_waitcnt(0);
        unsigned nloc = b.st[0], nx = b.st[1];
        if (nloc == 0u) { xcd_barrier_complete(bar, b.x, nloc, nx); b.st[0] = nloc; b.st[1] = nx; }
        const unsigned old = xb_add(&bar[XB_XSUB(b.x)], 1u);
        const unsigned gen = old / nloc;
        if (old + 1u == (gen + 1u) * nloc) {
            __builtin_amdgcn_fence(__ATOMIC_RELEASE, "agent");
            asm volatile("s_waitcnt vmcnt(0)" ::: "memory");
            const unsigned og = xb_add(&bar[XB_TOP], 1u);
            const unsigned tg = og / nx;
            if (og + 1u == (tg + 1u) * nx) xb_add(&bar[XB_TOPGEN], 1u);
            else XB_SPIN(xb_ld(&bar[XB_TOPGEN]) == tg, bar);
            __builtin_amdgcn_fence(__ATOMIC_ACQUIRE, "agent");
            xb_add(&bar[XB_XGEN(b.x)], 1u);
            asm volatile("s_waitcnt vmcnt(0)" ::: "memory");
        } else {
            XB_SPIN(xb_ld(&bar[XB_XGEN(b.x)]) == gen, bar);
            __builtin_amdgcn_fence(__ATOMIC_ACQUIRE, "agent");
            asm volatile("s_waitcnt vmcnt(0)" ::: "memory");
        }
    }
    __syncthreads();
}

struct Args {
    const float* in[23];
    float* out; unsigned char* ws;
    int ph_lo, ph_hi;
};
enum { I_X = 0, I_C, I_CTX, I_CCTX, I_ADAW, I_ADAB, I_LNG, I_LNB, I_CWIN, I_CW, I_CWOUT, I_SWIN, I_LRE, I_LIM, I_LSTEP, I_BRE, I_BIM, I_CRE, I_CIM, I_SD, I_WGLU, I_BGLU, I_SWOUT };

namespace g8 {
constexpr int BM = 256, BK = 64, HALF = 128, HTB = HALF * BK * 2, NXCD = 8, WGM = 8;
__host__ __device__ __forceinline__ int lds_byte(int r, int c) { const int st = (r >> 4) * 2 + (c >> 5), rr = r & 15, cc = c & 31, ob = rr * 64 + cc * 2; return st * 1024 + (ob ^ (((ob >> 9) & 1) << 5)); }
__host__ __device__ __forceinline__ void stage_rc(int b, int& R, int& C) { const int st = b / 1024, sb = b % 1024, swz = sb ^ (((sb >> 9) & 1) << 5); R = (st >> 1) * 16 + swz / 64; C = (st & 1) * 32 + (swz % 64) / 2; }
__host__ __device__ __forceinline__ int perm32(int rho) { const int n = rho >> 4, i = rho & 15; return 8 * (i >> 2) + 4 * n + (i & 3); }

struct Unit { int pm, pn, g; };
__host__ __device__ __forceinline__ int xcd_remap(int L, int nwg) { const int q = nwg / NXCD, r = nwg % NXCD, xcd = L % NXCD, off = L / NXCD; return (xcd < r ? xcd * (q + 1) : r * (q + 1) + (xcd - r) * q) + off; }
__host__ __device__ __forceinline__ bool order_mn(int L, int nM, int nN, Unit& u) {
    const int nwg = nM * nN; if (L >= nwg) return false;
    const int wgid = xcd_remap(L, nwg);
    const int nig = WGM * nN, gid = wgid / nig, fm = gid * WGM, gsz = (nM - fm) < WGM ? (nM - fm) : WGM;
    u.pm = fm + ((wgid % nig) % gsz); u.pn = (wgid % nig) / gsz; u.g = 0; return true;
}
__host__ __device__ __forceinline__ bool order_g(int L, int ng, int nM, int nN, Unit& u) {
    const int per = nM * nN, nwg = ng * per; if (L >= nwg) return false;
    const int wgid = xcd_remap(L, nwg);
    u.g = wgid / per; const int rem = wgid % per; u.pm = rem / nN; u.pn = rem % nN; return true;
}

__device__ __forceinline__ unsigned cvt_pk_bf16(float lo, float hi) { unsigned r; asm volatile("v_cvt_pk_bf16_f32 %0, %1, %2" : "=v"(r) : "v"(lo), "v"(hi)); return r; }

typedef f32x4 Acc[2][2][4][2];

template <class P>
__device__ __forceinline__ void gemm_phase(LAS unsigned char* lds, const P& p, const int G, const int c) {
    const int tid = threadIdx.x, wid = __builtin_amdgcn_readfirstlane(tid >> 6), lane = tid & 63, wr = wid >> 2, wc = wid & 3, fr = lane & 15, fq = lane >> 4;
    constexpr int NS = P::NSEG; constexpr int S1 = NS - 1;
    const int nt = p.nt(), nt0 = p.nt0();
    unsigned voffA0, voffA1, voffB0, voffB1;
    { int R, C; stage_rc(tid * 16, R, C); const int Rb = P::PERM ? ((R & ~31) + perm32(R & 31)) : R;
      voffA0 = (unsigned)(p.a_off(0, R, C) - p.a_off(0, 0, 0) + p.a_bias(0)); voffB0 = (unsigned)(p.b_off(0, Rb, C) - p.b_off(0, 0, 0) + p.b_bias(0));
      voffA1 = (unsigned)(p.a_off(S1, R, C) - p.a_off(S1, 0, 0) + p.a_bias(S1)); voffB1 = (unsigned)(p.b_off(S1, Rb, C) - p.b_off(S1, 0, 0) + p.b_bias(S1)); }
    const long r64A0 = p.a_off(0, 64, 0) - p.a_off(0, 0, 0), r64A1 = p.a_off(S1, 64, 0) - p.a_off(S1, 0, 0), r64B0 = p.b_off(0, 64, 0) - p.b_off(0, 0, 0), r64B1 = p.b_off(S1, 64, 0) - p.b_off(S1, 0, 0);
    const long hA0 = p.a_off(0, 128, 0) - p.a_off(0, 0, 0), hA1 = p.a_off(S1, 128, 0) - p.a_off(S1, 0, 0), hB0 = p.b_off(0, 128, 0) - p.b_off(0, 0, 0), hB1 = p.b_off(S1, 128, 0) - p.b_off(S1, 0, 0);
    const long ksA0 = p.a_off(0, 0, 64) - p.a_off(0, 0, 0), ksA1 = p.a_off(S1, 0, 64) - p.a_off(S1, 0, 0), ksB0 = p.b_off(0, 0, 64) - p.b_off(0, 0, 0), ksB1 = p.b_off(S1, 0, 64) - p.b_off(S1, 0, 0);
    const unsigned ldsw = (unsigned)wid * 1024u;
    const int aoff = lds_byte(wr * 64 + fr, fq * 8), boff = lds_byte(wc * 32 + fr, fq * 8);
#define G8_SA(b, h) (((b) * 2 + (h)) * HTB)
#define G8_SB(b, h) ((4 + (b) * 2 + (h)) * HTB)
#define G8_STAGE1(bufoff, gptr, voff, r64) do { \
        __builtin_amdgcn_global_load_lds((const unsigned*)((gptr) + (voff)), (LAS unsigned*)(lds + (bufoff) + ldsw), 16, 0, 0); \
        __builtin_amdgcn_global_load_lds((const unsigned*)((gptr) + (r64) + (voff)), (LAS unsigned*)(lds + (bufoff) + ldsw + 8192), 16, 0, 0); } while (0)
#define G8_STA(bufoff, ptr, sg, h) G8_STAGE1(bufoff, (ptr) + (h) * ((sg) ? hA1 : hA0), ((sg) ? voffA1 : voffA0), ((sg) ? r64A1 : r64A0))
#define G8_STB(bufoff, ptr, sg, h) G8_STAGE1(bufoff, (ptr) + (h) * ((sg) ? hB1 : hB0), ((sg) ? voffB1 : voffB0), ((sg) ? r64B1 : r64B0))
#define G8_LDA(dst, b, h) do { _Pragma("unroll") for (int m = 0; m < 4; ++m) _Pragma("unroll") for (int k = 0; k < 2; ++k) dst[m][k] = *(const LAS bf16x8*)(lds + G8_SA(b, h) + aoff + m * 2048 + k * 1024); } while (0)
#define G8_LDB(dst, b, h) do { _Pragma("unroll") for (int n = 0; n < 2; ++n) _Pragma("unroll") for (int k = 0; k < 2; ++k) dst[n][k] = *(const LAS bf16x8*)(lds + G8_SB(b, h) + boff + n * 2048 + k * 1024); } while (0)
#define G8_MMA(ai, bj, At, Bt) do { __builtin_amdgcn_s_setprio(1); _Pragma("unroll") for (int m = 0; m < 4; ++m) _Pragma("unroll") for (int n = 0; n < 2; ++n) _Pragma("unroll") for (int k = 0; k < 2; ++k) \
        acc[ai][bj][m][n] = __builtin_amdgcn_mfma_f32_16x16x32_bf16(Bt[n][k], At[m][k], acc[ai][bj][m][n], 0, 0, 0); __builtin_amdgcn_s_setprio(0); } while (0)
#define G8_WAIT_V(n) asm volatile("s_waitcnt vmcnt(" #n ")" ::: "memory")
#define G8_WAIT_L(n) asm volatile("s_waitcnt lgkmcnt(" #n ")" ::: "memory")
#define G8_BAR __builtin_amdgcn_s_barrier()
#define G8_SCHED __builtin_amdgcn_sched_barrier(0)
    Unit cur, nxt; int ui = 0;
    if (!p.unit(c, cur)) return;
    Acc acc;
#pragma unroll
    for (int a = 0; a < 2; ++a)
#pragma unroll
        for (int b = 0; b < 2; ++b)
#pragma unroll
            for (int m = 0; m < 4; ++m)
#pragma unroll
                for (int n = 0; n < 2; ++n) acc[a][b][m][n] = (f32x4){0.f, 0.f, 0.f, 0.f};
    bf16x8 At[4][2], B0[2][2], B1[2][2];
    const char* cA0 = p.a_base(cur, 0) - p.a_bias(0); const char* cA1 = p.a_base(cur, S1) - p.a_bias(S1);
    const char* cB0 = p.b_base(cur, 0) - p.b_bias(0); const char* cB1 = p.b_base(cur, S1) - p.b_bias(S1);
    G8_STB(G8_SB(0, 0), cB0, false, 0); G8_STB(G8_SB(0, 1), cB0, false, 1); G8_STA(G8_SA(0, 0), cA0, false, 0); G8_STA(G8_SA(0, 1), cA0, false, 1);
    if (wr == 1) G8_BAR;
    G8_WAIT_V(2); G8_BAR;
    G8_STB(G8_SB(1, 0), cB0 + ksB0, false, 0); G8_STA(G8_SA(1, 0), cA0 + ksA0, false, 0); G8_STB(G8_SB(1, 1), cB0 + ksB0, false, 1);
    G8_WAIT_V(6); G8_BAR;
    for (;;) {
        const bool has_next = p.unit((ui + 1) * G + c, nxt);
        const char* nA0 = has_next ? p.a_base(nxt, 0) - p.a_bias(0) : cA0; const char* nA1 = has_next ? p.a_base(nxt, S1) - p.a_bias(S1) : cA1;
        const char* nB0 = has_next ? p.b_base(nxt, 0) - p.b_bias(0) : cB0; const char* nB1 = has_next ? p.b_base(nxt, S1) - p.b_bias(S1) : cB1;
        for (int t = 0; t < nt; t += 2) {
            const bool last = (t == nt - 2);
            const bool sg1 = (NS > 1) && (t + 1 >= nt0);
            const bool sg2 = (NS > 1) && !last && (t + 2 >= nt0);
            const char* a1 = sg1 ? cA1 + (long)(t + 1 - nt0) * ksA1 : cA0 + (long)(t + 1) * ksA0;
            const char* a2 = last ? nA0 : (sg2 ? cA1 + (long)(t + 2 - nt0) * ksA1 : cA0 + (long)(t + 2) * ksA0);
            const char* b2 = last ? nB0 : (sg2 ? cB1 + (long)(t + 2 - nt0) * ksB1 : cB0 + (long)(t + 2) * ksB0);
            const char* a3 = a2 + (sg2 ? ksA1 : ksA0); const char* b3 = b2 + (sg2 ? ksB1 : ksB0);
            G8_LDB(B0, 0, 0); G8_LDB(B1, 0, 1); G8_SCHED; G8_LDA(At, 0, 0); G8_STA(G8_SA(1, 1), a1, sg1, 1);
            G8_WAIT_V(8); G8_WAIT_L(0); G8_BAR; G8_MMA(0, 0, At, B0); G8_MMA(0, 1, At, B1); G8_BAR; G8_SCHED;
            G8_LDA(At, 0, 1); G8_STB(G8_SB(0, 0), b2, sg2, 0); G8_STB(G8_SB(0, 1), b2, sg2, 1); G8_STA(G8_SA(0, 0), a2, sg2, 0);
            G8_WAIT_V(8); G8_WAIT_L(0); G8_BAR; G8_MMA(1, 0, At, B0); G8_MMA(1, 1, At, B1); G8_BAR; G8_SCHED;
            G8_LDB(B0, 1, 0); G8_LDB(B1, 1, 1); G8_SCHED; G8_LDA(At, 1, 0); G8_STA(G8_SA(0, 1), a2, sg2, 1);
            G8_WAIT_V(8); G8_WAIT_L(0); G8_BAR; G8_MMA(0, 0, At, B0); G8_MMA(0, 1, At, B1); G8_BAR; G8_SCHED;
            G8_LDA(At, 1, 1); G8_STB(G8_SB(1, 0), b3, sg2, 0); G8_STB(G8_SB(1, 1), b3, sg2, 1); G8_STA(G8_SA(1, 0), a3, sg2, 0);
            G8_WAIT_V(8); G8_WAIT_L(0); G8_BAR; G8_MMA(1, 0, At, B0); G8_MMA(1, 1, At, B1); G8_BAR; G8_SCHED;
        }
        if (wr == 0) G8_BAR;
        p.epi(acc, cur, wr, wc, fr, fq, lds);
        if (!has_next) break;
#pragma unroll
        for (int a = 0; a < 2; ++a)
#pragma unroll
            for (int b = 0; b < 2; ++b)
#pragma unroll
                for (int m = 0; m < 4; ++m)
#pragma unroll
                    for (int n = 0; n < 2; ++n) acc[a][b][m][n] = (f32x4){0.f, 0.f, 0.f, 0.f};
        cur = nxt; ++ui; cA0 = nA0; cA1 = nA1; cB0 = nB0; cB1 = nB1;
        if (wr == 1) G8_BAR;
    }
    G8_WAIT_V(0);
    G8_BAR;
#undef G8_SA
#undef G8_SB
#undef G8_STAGE1
#undef G8_STA
#undef G8_STB
#undef G8_LDA
#undef G8_LDB
#undef G8_MMA
#undef G8_WAIT_V
#undef G8_WAIT_L
#undef G8_BAR
#undef G8_SCHED
}

template <class P>
__device__ __forceinline__ void gemm_phase_naive(LAS unsigned char* lds, const P& p, const int G, const int c) {
    const int tid = threadIdx.x, wid = tid >> 6, lane = tid & 63, wr = wid >> 2, wc = wid & 3, fr = lane & 15, fq = lane >> 4;
    LAS float* As = (LAS float*)lds;
    LAS float* Bs = As + 16 * 260;
    const int nt = p.nt(), nt0 = p.nt0();
    Unit u;
    for (int ui = 0; p.unit(ui * G + c, u); ++ui) {
        Acc acc;
#pragma unroll
        for (int a = 0; a < 2; ++a)
#pragma unroll
            for (int b = 0; b < 2; ++b)
#pragma unroll
                for (int m = 0; m < 4; ++m)
#pragma unroll
                    for (int n = 0; n < 2; ++n) acc[a][b][m][n] = (f32x4){0.f, 0.f, 0.f, 0.f};
        for (int k0 = 0; k0 < nt * 64; k0 += 16) {
            const int seg = (P::NSEG > 1 && k0 >= nt0 * 64) ? 1 : 0, ks = k0 - (seg ? nt0 * 64 : 0);
            { const int row = tid >> 1, h8 = tid & 1;
              const u32x4 va = *(const u32x4*)(p.a_base(u, seg) + p.a_off(seg, row, ks + 8 * h8));
              const u32x4 vb = *(const u32x4*)(p.b_base(u, seg) + p.b_off(seg, row, ks + 8 * h8));
              __syncthreads();
#pragma unroll
              for (int i = 0; i < 4; ++i) { As[(8 * h8 + 2 * i) * 260 + row] = bf2f(va[i]); As[(8 * h8 + 2 * i + 1) * 260 + row] = bf2f(va[i] >> 16);
                                            Bs[(8 * h8 + 2 * i) * 260 + row] = bf2f(vb[i]); Bs[(8 * h8 + 2 * i + 1) * 260 + row] = bf2f(vb[i] >> 16); }
              __syncthreads(); }
            for (int kk = 0; kk < 16; ++kk) {
                float av[2][4], bv[2][2][4];
#pragma unroll
                for (int ai = 0; ai < 2; ++ai)
#pragma unroll
                    for (int m = 0; m < 4; ++m) av[ai][m] = As[kk * 260 + ai * 128 + wr * 64 + m * 16 + fr];
#pragma unroll
                for (int bj = 0; bj < 2; ++bj)
#pragma unroll
                    for (int n = 0; n < 2; ++n)
#pragma unroll
                        for (int j = 0; j < 4; ++j) bv[bj][n][j] = Bs[kk * 260 + bj * 128 + wc * 32 + (P::PERM ? 8 * fq + 4 * n + j : 16 * n + 4 * fq + j)];
#pragma unroll
                for (int ai = 0; ai < 2; ++ai)
#pragma unroll
                    for (int bj = 0; bj < 2; ++bj)
#pragma unroll
                        for (int m = 0; m < 4; ++m)
#pragma unroll
                            for (int n = 0; n < 2; ++n)
#pragma unroll
                                for (int j = 0; j < 4; ++j) acc[ai][bj][m][n][j] += av[ai][m] * bv[bj][n][j];
            }
        }
        __syncthreads();
        p.epi(acc, u, wr, wc, fr, fq, lds);
        __syncthreads();
    }
}


struct ProbG1 {
    static constexpr bool PERM = false; static constexpr int NSEG = 1;
    const char* HX; const char* HXV; const char* W1; const float* convw; char* A2;
    __host__ __device__ int nt0() const { return 16; } __host__ __device__ int nt() const { return 16; }
    __host__ __device__ long a_bias(int) const { return 0; } __host__ __device__ long b_bias(int) const { return 0; }
    __host__ __device__ bool unit(int L, Unit& u) const { return order_mn(L, RT / 256, 32, u); }
    __host__ __device__ const char* a_base(const Unit& u, int) const { return ((u.pn < 16 || u.pm >= 128) ? HX : HXV) + (size_t)u.pm * 256 * 128; }
    __host__ __device__ long a_off(int, int r, int k) const { return (long)r * 128 + (long)(k >> 6) * (long)HXPLANE + (k & 63) * 2; }
    __host__ __device__ const char* b_base(const Unit& u, int) const { return W1 + (size_t)u.pn * 256 * 2048; }
    __host__ __device__ long b_off(int, int c, int k) const { return (long)c * 2048 + k * 2; }
    __device__ __forceinline__ void epi(Acc& acc, const Unit& u, int wr, int wc, int fr, int fq, LAS unsigned char* lds) const {
        LAS unsigned char* xl = lds + XL_OFF;
        const bool chain = (u.pn >= 16) || (u.pm >= 128);
        const bool vert = (u.pn >= 16) && (u.pm < 128);
        const int ch0 = wc * 16 + fq * 4, chg = u.pn * 64 + ch0;
        const f32x4 w0 = *(const f32x4*)(convw + chg), w1 = *(const f32x4*)(convw + 2048 + chg), w2 = *(const f32x4*)(convw + 4096 + chg);
        const int slot = wc * 4 + fq;
#pragma unroll
        for (int ai = 0; ai < 2; ++ai) {
            f32x4 uu[4];
#pragma unroll
            for (int m = 0; m < 4; ++m) uu[m] = acc[ai][0][m][1] * acc[ai][1][m][0];
            LDS_WAIT(); __builtin_amdgcn_s_barrier();
#pragma unroll
            for (int m = 0; m < 4; ++m) { const int br = 1 + wr * 64 + m * 16 + fr;
                u32x2 w; w.x = pk2(uu[m][0], uu[m][1]); w.y = pk2(uu[m][2], uu[m][3]);
                *(LAS u32x2*)(xl + br * 128 + ((slot ^ (br & 15)) << 3)) = w; }
            if (ai == 0) { if (wr == 0 && fr == 0) { const f32x4 e = acc[1][0][0][1] * acc[1][1][0][0];
                    u32x2 w; w.x = pk2(e[0], e[1]); w.y = pk2(e[2], e[3]); *(LAS u32x2*)(xl + 129 * 128 + ((slot ^ (129 & 15)) << 3)) = w; } }
            else { if (wr == 1 && fr == 15) { const f32x4 e = acc[0][0][3][1] * acc[0][1][3][0];
                    u32x2 w; w.x = pk2(e[0], e[1]); w.y = pk2(e[2], e[3]); *(LAS u32x2*)(xl + 0 * 128 + ((slot ^ 0) << 3)) = w; } }
            LDS_WAIT();
            __builtin_amdgcn_s_barrier();
#pragma unroll
            for (int m = 0; m < 4; ++m) {
                const int rl = wr * 64 + m * 16 + fr, rt = ai * 128 + rl;
                const u32x2 up = *(const LAS u32x2*)(xl + rl * 128 + ((slot ^ (rl & 15)) << 3));
                const u32x2 dn = *(const LAS u32x2*)(xl + (rl + 2) * 128 + ((slot ^ ((rl + 2) & 15)) << 3));
                const bool first = chain ? (rt == 0) : ((rt & 63) == 0), lastr = chain ? (rt == 255) : ((rt & 63) == 63);
                f32x4 upv = {bf2f(up.x), bf2f(up.x >> 16), bf2f(up.y), bf2f(up.y >> 16)}, dnv = {bf2f(dn.x), bf2f(dn.x >> 16), bf2f(dn.y), bf2f(dn.y >> 16)};
                if (first) upv = (f32x4){0.f, 0.f, 0.f, 0.f};
                if (lastr) dnv = (f32x4){0.f, 0.f, 0.f, 0.f};
                const f32x4 yc = w1 * uu[m] + w0 * upv + w2 * dnv;
                const f32x4 bgv = acc[ai][0][m][0], zv = acc[ai][1][m][1];
                f32x4 o;
#pragma unroll
                for (int j = 0; j < 4; ++j) o[j] = bgv[j] * yc[j] * siluf_(zv[j]);
                const int tok = vert ? ((u.pm >> 6) * SEQ + rt * GRIDW + (u.pm & 63)) : (u.pm * 256 + rt);
                u32x2 w; w.x = pk2(o[0], o[1]); w.y = pk2(o[2], o[3]);
                *(u32x2*)(A2 + (size_t)u.pn * HXPLANE + (size_t)tok * 128 + ch0 * 2) = w;
            }
        }
    }
};

struct ProbG2 {
    static constexpr bool PERM = false; static constexpr int NSEG = 1;
    const char* A2; const char* W2; const float* x; const float* ctx; const float* mod; float* out; float* y1c;
    __host__ __device__ int nt0() const { return 32; } __host__ __device__ int nt() const { return 32; }
    __host__ __device__ long a_bias(int) const { return 0; } __host__ __device__ long b_bias(int) const { return 0; }
    __host__ __device__ bool unit(int L, Unit& u) const { return order_mn(L, RT / 256, 4, u); }
    __host__ __device__ const char* a_base(const Unit& u, int) const { return A2 + (size_t)u.pm * 256 * 128; }
    __host__ __device__ long a_off(int, int r, int k) const { return (long)r * 128 + (long)(k >> 6) * (long)HXPLANE + (k & 63) * 2; }
    __host__ __device__ const char* b_base(const Unit& u, int) const { return W2 + (size_t)u.pn * 256 * 4096; }
    __host__ __device__ long b_off(int, int c, int k) const { return (long)c * 4096 + k * 2; }
    __device__ __forceinline__ void epi(Acc& acc, const Unit& u, int wr, int wc, int fr, int fq, LAS unsigned char*) const {
        const bool isctx = u.pm >= 128;
        const int rho = isctx ? 2 : (u.pm >> 6);
        const float* src = isctx ? ctx - (size_t)RL * D : x; float* dst = isctx ? y1c - (size_t)RL * D : out;
        const int col0 = u.pn * 256 + wc * 32 + 4 * fq;
        f32x4 gt[2][2];
#pragma unroll
        for (int bj = 0; bj < 2; ++bj)
#pragma unroll
            for (int n = 0; n < 2; ++n) gt[bj][n] = *(const f32x4*)(mod + rho * 3072 + 2048 + col0 + bj * 128 + n * 16);
#pragma unroll
        for (int ai = 0; ai < 2; ++ai)
#pragma unroll
            for (int m = 0; m < 4; ++m) { const size_t off = (size_t)(u.pm * 256 + ai * 128 + wr * 64 + m * 16 + fr) * D + col0;
#pragma unroll
                for (int bj = 0; bj < 2; ++bj)
#pragma unroll
                    for (int n = 0; n < 2; ++n) { const f32x4 xv = *(const f32x4*)(src + off + bj * 128 + n * 16);
                        *(f32x4*)(dst + off + bj * 128 + n * 16) = DN_ALPHA * xv + gt[bj][n] * acc[ai][bj][m][n]; } }
    }
};

struct ProbG3 {
    static constexpr bool PERM = true; static constexpr int NSEG = 1;
    const char* HX; const char* W3; char* X; char* UCTX; char* SZ; int zhalf;
    __host__ __device__ int nt0() const { return 16; } __host__ __device__ int nt() const { return 16; }
    __host__ __device__ long a_bias(int) const { return 0; } __host__ __device__ long b_bias(int) const { return 0; }
    __host__ __device__ bool unit(int L, Unit& u) const { return order_mn(L, zhalf ? RL / 256 : RT / 256, 8, u); }
    __host__ __device__ const char* a_base(const Unit& u, int) const { return HX + (size_t)u.pm * 256 * 128; }
    __host__ __device__ long a_off(int, int r, int k) const { return (long)r * 128 + (long)(k >> 6) * (long)HXPLANE + (k & 63) * 2; }
    __host__ __device__ const char* b_base(const Unit& u, int) const { return W3 + (size_t)(zhalf * 2048 + u.pn * 256) * 2048; }
    __host__ __device__ long b_off(int, int c, int k) const { return (long)c * 2048 + k * 2; }
    __device__ __forceinline__ void epi(Acc& acc, const Unit& u, int wr, int wc, int fr, int fq, LAS unsigned char*) const {
#pragma unroll
        for (int ai = 0; ai < 2; ++ai)
#pragma unroll
            for (int m = 0; m < 4; ++m) { const int tok = u.pm * 256 + ai * 128 + wr * 64 + m * 16 + fr;
#pragma unroll
                for (int bj = 0; bj < 2; ++bj) { const int n0 = u.pn * 256 + bj * 128 + wc * 32 + 8 * fq;
                    f32x4 v0 = acc[ai][bj][m][0], v1 = acc[ai][bj][m][1];
                    if (zhalf) {
#pragma unroll
                        for (int j = 0; j < 4; ++j) { v0[j] = siluf_(v0[j]); v1[j] = siluf_(v1[j]); } }
                    u32x4 w; w.x = pk2(v0[0], v0[1]); w.y = pk2(v0[2], v0[3]); w.z = pk2(v1[0], v1[1]); w.w = pk2(v1[2], v1[3]);
                    if (zhalf) *(u32x4*)(SZ + ((size_t)tok * 2048 + n0) * 2) = w;
                    else { const int g = n0 >> 4, p0 = n0 & 15;
                        if (tok < RL) { const int b = tok / SEQ, tt = tok % SEQ, col = b * NCHB + tt / TCH, t = tt % TCH;
                            *(u32x4*)(X + (size_t)g * XPLANE + ((size_t)col * XLD + t * 16 + p0) * 2) = w; }
                        else *(u32x4*)(UCTX + (size_t)g * (RC * 32) + (size_t)(tok - RL) * 32 + p0 * 2) = w; } } }
    }
};

struct ProbS {
    static constexpr bool PERM = false; static constexpr int NSEG = 1;
    const char* X; const char* M2; float* S;
    __host__ __device__ int nt0() const { return TP / 64; } __host__ __device__ int nt() const { return TP / 64; }
    __host__ __device__ long a_bias(int) const { return 0; } __host__ __device__ long b_bias(int) const { return 0; }
    __host__ __device__ bool unit(int L, Unit& u) const { return order_g(L, NG, NCOL / 256, 1, u); }
    __host__ __device__ const char* a_base(const Unit& u, int) const { return X + (size_t)u.g * XPLANE + (size_t)u.pm * 256 * XLD * 2; }
    __host__ __device__ long a_off(int, int r, int k) const { return (long)r * XLD * 2 + k * 2; }
    __host__ __device__ const char* b_base(const Unit& u, int) const { return M2 + (size_t)u.g * 256 * TP * 2; }
    __host__ __device__ long b_off(int, int c, int k) const { return (long)c * TP * 2 + k * 2; }
    __device__ __forceinline__ void epi(Acc& acc, const Unit& u, int wr, int wc, int fr, int fq, LAS unsigned char*) const {
#pragma unroll
        for (int ai = 0; ai < 2; ++ai)
#pragma unroll
            for (int m = 0; m < 4; ++m) { const int col = u.pm * 256 + ai * 128 + wr * 64 + m * 16 + fr;
                float* rowp = S + ((size_t)u.g * NCOL + col) * 256 + wc * 32 + 4 * fq;
#pragma unroll
                for (int bj = 0; bj < 2; ++bj)
#pragma unroll
                    for (int n = 0; n < 2; ++n) *(f32x4*)(rowp + bj * 128 + n * 16) = acc[ai][bj][m][n]; }
    }
};

struct ProbY {
    static constexpr bool PERM = true; static constexpr int NSEG = 2;
    const char* X; const char* KR; const char* M4; char* Gout;
    __host__ __device__ int nt0() const { return TP / 64; } __host__ __device__ int nt() const { return XLD / 64; }
    __host__ __device__ long a_bias(int) const { return 0; } __host__ __device__ long b_bias(int seg) const { return seg ? 0 : 96; }
    __host__ __device__ bool unit(int L, Unit& u) const { return order_g(L, NG, NCOL / 256, TP / 256, u); }
    __host__ __device__ const char* a_base(const Unit& u, int seg) const { return X + (size_t)u.g * XPLANE + (size_t)u.pm * 256 * XLD * 2 + (seg ? TP * 2 : 0); }
    __host__ __device__ long a_off(int, int r, int k) const { return (long)r * XLD * 2 + k * 2; }
    __host__ __device__ const char* b_base(const Unit& u, int seg) const {
        return seg ? M4 + (size_t)u.g * TP * 512 + (size_t)u.pn * 256 * 512 : KR + (size_t)u.g * KRG * 2 + (size_t)(TCH - 1 - 16 * u.pn) * 32; }
    __host__ __device__ long b_off(int seg, int c, int k) const { return seg ? (long)c * 512 + k * 2 : ((long)(c & 15) * PSTR - (long)(c >> 4) * 16 + k) * 2; }
    __device__ __forceinline__ void epi(Acc& acc, const Unit& u, int wr, int wc, int fr, int fq, LAS unsigned char*) const {
#pragma unroll
        for (int ai = 0; ai < 2; ++ai)
#pragma unroll
            for (int m = 0; m < 4; ++m) { const int col = u.pm * 256 + ai * 128 + wr * 64 + m * 16 + fr;
#pragma unroll
                for (int bj = 0; bj < 2; ++bj) { const int n0 = u.pn * 256 + bj * 128 + wc * 32 + 8 * fq;
                    const f32x4 v0 = acc[ai][bj][m][0], v1 = acc[ai][bj][m][1];
                    u32x4 w; w.x = pk2(gelu_tanh(v0[0]), gelu_tanh(v0[1])); w.y = pk2(gelu_tanh(v0[2]), gelu_tanh(v0[3]));
                    w.z = pk2(gelu_tanh(v1[0]), gelu_tanh(v1[1])); w.w = pk2(gelu_tanh(v1[2]), gelu_tanh(v1[3]));
                    *(u32x4*)(Gout + (size_t)u.g * GPLANE + ((size_t)col * TP + n0) * 2) = w; } }
    }
};

struct ProbG4 {
    static constexpr bool PERM = true; static constexpr int NSEG = 1;
    const char* Gin; const char* WG; const char* SZ; const float* bglu; char* A4;
    __host__ __device__ int nt0() const { return 32; } __host__ __device__ int nt() const { return 32; }
    __host__ __device__ long a_bias(int) const { return 0; } __host__ __device__ long b_bias(int) const { return 0; }
    __host__ __device__ bool unit(int L, Unit& u) const { return order_mn(L, RL / 256, 8, u); }
    __host__ __device__ const char* a_base(const Unit& u, int) const { return Gin + (size_t)u.pm * 256 * 32; }
    __host__ __device__ long a_off(int, int r, int k) const { return (long)(k >> 4) * (long)GPLANE + (long)r * 32 + (k & 15) * 2; }
    __host__ __device__ const char* b_base(const Unit& u, int) const { return WG + (size_t)u.pn * 256 * 4096; }
    __host__ __device__ long b_off(int, int c, int k) const { return (long)c * 4096 + k * 2; }
    __device__ __forceinline__ void epi(Acc& acc, const Unit& u, int wr, int wc, int fr, int fq, LAS unsigned char*) const {
#pragma unroll
        for (int bj = 0; bj < 2; ++bj) { const int n0 = u.pn * 256 + bj * 128 + wc * 32 + 8 * fq;
            const f32x4 b0 = *(const f32x4*)(bglu + n0), b1 = *(const f32x4*)(bglu + n0 + 4);
#pragma unroll
            for (int ai = 0; ai < 2; ++ai)
#pragma unroll
                for (int m = 0; m < 4; ++m) { const int tok = u.pm * 256 + ai * 128 + wr * 64 + m * 16 + fr;
                    const u32x4 gv = *(const u32x4*)(Gin + (size_t)(n0 >> 4) * GPLANE + (size_t)tok * 32 + (n0 & 15) * 2);
                    const u32x4 sv = *(const u32x4*)(SZ + ((size_t)tok * 2048 + n0) * 2);
                    const f32x4 v0 = acc[ai][bj][m][0] + b0, v1 = acc[ai][bj][m][1] + b1;
                    float o[8];
#pragma unroll
                    for (int i = 0; i < 4; ++i) { const float g0 = bf2f(gv[i]), g1 = bf2f(gv[i] >> 16), s0 = bf2f(sv[i]), s1 = bf2f(sv[i] >> 16);
                        const float a0 = (2 * i < 4) ? v0[2 * i] : v1[2 * i - 4], a1 = (2 * i + 1 < 4) ? v0[2 * i + 1] : v1[2 * i + 1 - 4];
                        o[2 * i] = g0 * sigmoidf_(a0) * s0; o[2 * i + 1] = g1 * sigmoidf_(a1) * s1; }
                    u32x4 w; w.x = pk2(o[0], o[1]); w.y = pk2(o[2], o[3]); w.z = pk2(o[4], o[5]); w.w = pk2(o[6], o[7]);
                    *(u32x4*)(A4 + (size_t)(n0 >> 6) * A4PLANE + (size_t)tok * 128 + (n0 & 63) * 2) = w; } }
    }
};

struct ProbG5 {
    static constexpr bool PERM = false; static constexpr int NSEG = 1;
    const char* A4; const char* W5; const float* mod; float* out;
    __host__ __device__ int nt0() const { return 32; } __host__ __device__ int nt() const { return 32; }
    __host__ __device__ long a_bias(int) const { return 0; } __host__ __device__ long b_bias(int) const { return 0; }
    __host__ __device__ bool unit(int L, Unit& u) const { return order_mn(L, RL / 256, 4, u); }
    __host__ __device__ const char* a_base(const Unit& u, int) const { return A4 + (size_t)u.pm * 256 * 128; }
    __host__ __device__ long a_off(int, int r, int k) const { return (long)r * 128 + (long)(k >> 6) * (long)A4PLANE + (k & 63) * 2; }
    __host__ __device__ const char* b_base(const Unit& u, int) const { return W5 + (size_t)u.pn * 256 * 4096; }
    __host__ __device__ long b_off(int, int c, int k) const { return (long)c * 4096 + k * 2; }
    __device__ __forceinline__ void epi(Acc& acc, const Unit& u, int wr, int wc, int fr, int fq, LAS unsigned char*) const {
        const int rho = u.pm >> 6, col0 = u.pn * 256 + wc * 32 + 4 * fq;
        f32x4 gt[2][2];
#pragma unroll
        for (int bj = 0; bj < 2; ++bj)
#pragma unroll
            for (int n = 0; n < 2; ++n) gt[bj][n] = *(const f32x4*)(mod + (3 + rho) * 3072 + 2048 + col0 + bj * 128 + n * 16);
#pragma unroll
        for (int ai = 0; ai < 2; ++ai)
#pragma unroll
            for (int m = 0; m < 4; ++m) { float* rowp = out + (size_t)(u.pm * 256 + ai * 128 + wr * 64 + m * 16 + fr) * D + col0;
#pragma unroll
                for (int bj = 0; bj < 2; ++bj)
#pragma unroll
                    for (int n = 0; n < 2; ++n) { const f32x4 xv = *(const f32x4*)(rowp + bj * 128 + n * 16);
                        *(f32x4*)(rowp + bj * 128 + n * 16) = DN_ALPHA * xv + gt[bj][n] * acc[ai][bj][m][n]; } }
    }
};
}

struct Frame {
    LAS unsigned char* lds;
    int tid, lane, wave, G, bid;
    const float* in[23]; float* out; unsigned char* ws;
};

template <class RM>
__device__ __forceinline__ void transpose_item(const float* W, int K, int N, bf16* WT, LAS float* scr, int item, int lane, RM rowmap) {
    const int nblk = N / 32, kb = item / nblk, nb = item % nblk, k0 = 64 * kb, n0 = 32 * nb;
#pragma unroll 8
    for (int i = 0; i < 32; ++i) { const int kk = 2 * i + (lane >> 5); scr[kk * 33 + (lane & 31)] = W[(size_t)(k0 + kk) * N + n0 + (lane & 31)]; }
    LDS_WAIT(); asm volatile("" ::: "memory");
    const int c = lane & 7;
#pragma unroll
    for (int j = 0; j < 4; ++j) { const int n = (lane >> 3) + 8 * j; const LAS float* s = scr + (8 * c) * 33 + n;
        u32x4 o; o.x = pk2(s[0 * 33], s[1 * 33]); o.y = pk2(s[2 * 33], s[3 * 33]); o.z = pk2(s[4 * 33], s[5 * 33]); o.w = pk2(s[6 * 33], s[7 * 33]);
        *(u32x4*)(WT + (size_t)rowmap(n0 + n) * K + k0 + 8 * c) = o; }
    LDS_WAIT(); asm volatile("" ::: "memory");
}
struct RowId { __device__ int operator()(int n) const { return n; } };
struct RowW1 { __device__ int operator()(int n) const { const int p = n >> 11, chg = n & 2047, nt = chg >> 6, ch = chg & 63; return nt * 256 + 128 * (p >> 1) + 16 * (p & 1) + 32 * (ch >> 4) + (ch & 15); } };

__device__ __forceinline__ void phase_prep(Frame& F) {
    LAS float* fl = (LAS float*)F.lds;
    const int tid = F.tid;
    for (int item = F.bid; item < 2 * NG; item += F.G) {
        const int g = item >> 1, r = item & 1;
        LAS float* Av = fl; LAS float* Fv = fl + 256; LAS float* BBs = fl + 512; LAS float* Cs = fl + 4608; LAS float* PW = fl + 8768;
        __syncthreads();
        if (tid < 128) { const int rr = tid >> 6, n = tid & 63;
            const float dt = expf(F.in[I_LSTEP][rr * NG + g]);
            const float lre = F.in[I_LRE][(rr * NG + g) * 64 + n], lim = F.in[I_LIM][(rr * NG + g) * 64 + n];
            const float mag = expf(lre * dt); float sn, cs; sincosf(lim * dt, &sn, &cs);
            const float ar = mag * cs, ai = mag * sn, qr = ar - 1.0f, qi = ai, den = lre * lre + lim * lim;
            Av[(rr * 64 + n) * 2] = ar; Av[(rr * 64 + n) * 2 + 1] = ai;
            Fv[(rr * 64 + n) * 2] = (qr * lre + qi * lim) / den; Fv[(rr * 64 + n) * 2 + 1] = (qi * lre - qr * lim) / den;
            if (rr == r) { const float magT = expf(lre * dt * (float)TCH); float snT, csT; sincosf(lim * dt * (float)TCH, &snT, &csT);
                float* za = (float*)(F.ws + WS_ZA) + ((size_t)(r * NG + g) * 64 + n) * 4; za[0] = ar; za[1] = ai; za[2] = magT * csT; za[3] = magT * snT; } }
        __syncthreads();
        for (int e = tid; e < 2 * 64 * 16; e += 512) { const int rr = e >> 10, n = (e >> 4) & 63, q = e & 15;
            const float bre = F.in[I_BRE][((size_t)(rr * NG + g) * 64 + n) * 16 + q], bim = F.in[I_BIM][((size_t)(rr * NG + g) * 64 + n) * 16 + q];
            const float fr_ = Fv[(rr * 64 + n) * 2], fi_ = Fv[(rr * 64 + n) * 2 + 1];
            const float bbr = fr_ * bre - fi_ * bim, bbi = fr_ * bim + fi_ * bre;
            BBs[e * 2] = bbr; BBs[e * 2 + 1] = bbi;
            if (rr == r) { float* bg = (float*)(F.ws + WS_BBG) + (((size_t)(r * NG + g) * 64 + n) * 16 + q) * 2; bg[0] = bbr; bg[1] = bbi; }
            const int p = (e >> 6) & 15, nn = e & 63;
            Cs[((rr * 16 + p) * 65 + nn) * 2] = F.in[I_CRE][((size_t)(rr * NG + g) * 16 + p) * 64 + nn];
            Cs[((rr * 16 + p) * 65 + nn) * 2 + 1] = F.in[I_CIM][((size_t)(rr * NG + g) * 16 + p) * 64 + nn]; }
        { const float dt = expf(F.in[I_LSTEP][r * NG + g]);
          for (int e = tid; e < 64 * 65; e += 512) { const int n = e / 65, ee = e % 65;
            const float lre = F.in[I_LRE][(r * NG + g) * 64 + n], lim = F.in[I_LIM][(r * NG + g) * 64 + n];
            const float mg = expf(lre * dt * (float)ee); float sn, cs; sincosf(lim * dt * (float)ee, &sn, &cs);
            PW[e * 2] = mg * cs; PW[e * 2 + 1] = mg * sn; } }
        __syncthreads();
        { bf16* M2g = (bf16*)(F.ws + WS_M2) + (size_t)g * 256 * TP;
          const int k = tid * 2, s = k >> 4, q = k & 15, e = r ? s : (TCH - 1 - s);
          for (int j = 0; j < 128; ++j) { const int cc = j >> 6, n = j & 63;
            const float pr = PW[(n * 65 + e) * 2], pi = PW[(n * 65 + e) * 2 + 1];
            const float b0r = BBs[((r * 64 + n) * 16 + q) * 2], b0i = BBs[((r * 64 + n) * 16 + q) * 2 + 1], b1r = BBs[((r * 64 + n) * 16 + q + 1) * 2], b1i = BBs[((r * 64 + n) * 16 + q + 1) * 2 + 1];
            const float v0 = cc ? (pr * b0i + pi * b0r) : (pr * b0r - pi * b0i), v1 = cc ? (pr * b1i + pi * b1r) : (pr * b1r - pi * b1i);
            *(unsigned*)(M2g + (size_t)(r * 128 + j) * TP + k) = pk2(v0, v1); } }
        { bf16* M4g = (bf16*)(F.ws + WS_M4) + (size_t)g * TP * 256;
          const int jj = (tid & 63) * 2, cc = jj >> 6, n = jj & 63;
          for (int row = tid >> 6; row < TP; row += 8) { const int t = row >> 4, p = row & 15, e = r ? (TCH - t) : (t + 1);
            float v[2];
#pragma unroll
            for (int i = 0; i < 2; ++i) { const float cr = Cs[((r * 16 + p) * 65 + n + i) * 2], ci = Cs[((r * 16 + p) * 65 + n + i) * 2 + 1], pr = PW[((n + i) * 65 + e) * 2], pi = PW[((n + i) * 65 + e) * 2 + 1];
                v[i] = cc ? -(cr * pi + ci * pr) : (cr * pr - ci * pi); }
            *(unsigned*)(M4g + (size_t)row * 256 + r * 128 + jj) = pk2(v[0], v[1]); } }
        { bf16* KRg = (bf16*)(F.ws + WS_KR) + (size_t)g * KRG;
          const int el = tid >> 6, p = (tid >> 2) & 15, qb = tid & 3;
          for (int jx = el; jx < TCH; jx += 8) {
            int j, e; if (r == 0) { j = jx; e = TCH - 1 - jx; } else { if (jx == 0) continue; j = TCH - 1 + jx; e = jx; }
            float a4[4] = {0.f, 0.f, 0.f, 0.f};
            for (int n = 0; n < 64; ++n) { const float cr = Cs[((r * 16 + p) * 65 + n) * 2], ci = Cs[((r * 16 + p) * 65 + n) * 2 + 1], pr = PW[(n * 65 + e) * 2], pi = PW[(n * 65 + e) * 2 + 1];
                const float wr_ = cr * pr - ci * pi, wi_ = cr * pi + ci * pr;
#pragma unroll
                for (int q = 0; q < 4; ++q) a4[q] += wr_ * BBs[((r * 64 + n) * 16 + qb * 4 + q) * 2] - wi_ * BBs[((r * 64 + n) * 16 + qb * 4 + q) * 2 + 1]; }
            if (r == 0 && e == 0) {
                for (int n = 0; n < 64; ++n) { const float cr = Cs[((16 + p) * 65 + n) * 2], ci = Cs[((16 + p) * 65 + n) * 2 + 1];
#pragma unroll
                    for (int q = 0; q < 4; ++q) a4[q] += cr * BBs[((64 + n) * 16 + qb * 4 + q) * 2] - ci * BBs[((64 + n) * 16 + qb * 4 + q) * 2 + 1]; }
#pragma unroll
                for (int q = 0; q < 4; ++q) if (qb * 4 + q == p) a4[q] += F.in[I_SD][g * 16 + p]; }
            u32x2 w; w.x = pk2(a4[0], a4[1]); w.y = pk2(a4[2], a4[3]);
            *(u32x2*)(KRg + (size_t)p * PSTR + j * 16 + qb * 4) = w; }
          if (r == 1 && tid < 64) { const int p2 = tid >> 2, q4 = tid & 3; *(u32x2*)(KRg + (size_t)p2 * PSTR + (2 * TCH - 1) * 16 + q4 * 4) = (u32x2){0u, 0u}; } }
    }
    __syncthreads();
    {   LAS float* sc = fl;
        for (int e = tid; e < 3 * D; e += 512) { const int rho = e >> 10, k = e & 1023; const float v = rho < 2 ? F.in[I_C][rho * D + k] : F.in[I_CCTX][k]; sc[e] = siluf_(v); }
        __syncthreads();
        LAS float* red = fl + 3 * D;
        for (int item = F.bid; item < 2 * 96; item += F.G) {
            const int layer = item / 96, n0 = (item % 96) * 32, kk = tid >> 5, nn = tid & 31;
            const float* w = F.in[I_ADAW] + (size_t)layer * D * 3072 + n0 + nn;
            float s0 = 0.f, s1 = 0.f, s2 = 0.f;
            for (int k = kk; k < D; k += 16) { const float wv = w[(size_t)k * 3072]; s0 += sc[k] * wv; s1 += sc[D + k] * wv; s2 += sc[2 * D + k] * wv; }
            red[(kk * 32 + nn) * 3] = s0; red[(kk * 32 + nn) * 3 + 1] = s1; red[(kk * 32 + nn) * 3 + 2] = s2;
            __syncthreads();
            if (tid < 96) { const int rho = tid >> 5, n = tid & 31; float s = 0.f;
                for (int k2 = 0; k2 < 16; ++k2) s += red[(k2 * 32 + n) * 3 + rho];
                ((float*)(F.ws + WS_MOD))[(layer * 3 + rho) * 3072 + n0 + n] = s + F.in[I_ADAB][layer * 3072 + n0 + n]; }
            __syncthreads();
        }
    }
    __syncthreads();
    {   LAS float* scr = (LAS float*)(F.lds + F.wave * 16384);
        const int gw = F.bid * 8 + F.wave, NGW = F.G * 8;
        constexpr int I1 = (1024 / 64) * (8192 / 32), I2 = (2048 / 64) * (1024 / 32), I3 = (1024 / 64) * (4096 / 32), I4 = (2048 / 64) * (2048 / 32), I5 = (2048 / 64) * (1024 / 32);
        for (int it = gw; it < I1 + I2 + I3 + I4 + I5; it += NGW) {
            int rI = it;
            if (rI < I1) { transpose_item(F.in[I_CWIN], 1024, 8192, (bf16*)(F.ws + WS_W1), scr, rI, F.lane, RowW1()); continue; } rI -= I1;
            if (rI < I2) { transpose_item(F.in[I_CWOUT], 2048, 1024, (bf16*)(F.ws + WS_W2), scr, rI, F.lane, RowId()); continue; } rI -= I2;
            if (rI < I3) { transpose_item(F.in[I_SWIN], 1024, 4096, (bf16*)(F.ws + WS_W3), scr, rI, F.lane, RowId()); continue; } rI -= I3;
            if (rI < I4) { transpose_item(F.in[I_WGLU], 2048, 2048, (bf16*)(F.ws + WS_WG), scr, rI, F.lane, RowId()); continue; } rI -= I4;
            transpose_item(F.in[I_SWOUT], 2048, 1024, (bf16*)(F.ws + WS_W5), scr, rI, F.lane, RowId());
        }
    }
}

__device__ __forceinline__ void store_row_blk64(char* base, size_t row, int lane, const f32x4 (&v)[4]) {
#pragma unroll
    for (int j = 0; j < 4; ++j) { const int kb = 4 * j + (lane >> 4), col = 4 * (lane & 15);
        u32x2 w; w.x = pk2(v[j][0], v[j][1]); w.y = pk2(v[j][2], v[j][3]);
        *(u32x2*)(base + (size_t)kb * HXPLANE + row * 128 + col * 2) = w; }
}
__device__ __forceinline__ void phase_mod0(Frame& F) {
    const int gw = F.bid * 8 + F.wave, NGW = F.G * 8; const float* mod = (const float*)(F.ws + WS_MOD);
    for (int row = gw; row < RT; row += NGW) {
        const bool isctx = row >= RL; const int rho = isctx ? 2 : row / SEQ;
        const float* src = isctx ? F.in[I_CTX] + (size_t)(row - RL) * D : F.in[I_X] + (size_t)row * D;
        f32x4 v[4];
#pragma unroll
        for (int j = 0; j < 4; ++j) { const int idx = 256 * j + 4 * F.lane; const f32x4 xv = *(const f32x4*)(src + idx);
            const f32x4 sh = *(const f32x4*)(mod + rho * 3072 + idx), sc = *(const f32x4*)(mod + rho * 3072 + 1024 + idx);
            v[j] = xv * (1.0f + sc) + sh; }
        store_row_blk64((char*)F.ws + WS_HX, (size_t)row, F.lane, v);
        if (!isctx) { const int b = row / SEQ, t = row % SEQ; store_row_blk64((char*)F.ws + WS_HXV, (size_t)b * SEQ + (size_t)(t % GRIDW) * 256 + t / GRIDW, F.lane, v); }
    }
}
__device__ __forceinline__ void ln_row(f32x4 (&v)[4], const float* g, const float* b, int lane) {
    float s = 0.f;
#pragma unroll
    for (int j = 0; j < 4; ++j) s += (v[j][0] + v[j][1]) + (v[j][2] + v[j][3]);
    const float mean = wave_sum(s) * (1.f / D); float s2 = 0.f;
#pragma unroll
    for (int j = 0; j < 4; ++j) { v[j] = v[j] - mean; s2 += (v[j][0] * v[j][0] + v[j][1] * v[j][1]) + (v[j][2] * v[j][2] + v[j][3] * v[j][3]); }
    const float rstd = 1.0f / sqrtf(wave_sum(s2) * (1.f / D) + LN_EPS);
#pragma unroll
    for (int j = 0; j < 4; ++j) { const int idx = 256 * j + 4 * lane; v[j] = v[j] * rstd * *(const f32x4*)(g + idx) + *(const f32x4*)(b + idx); }
}
__device__ __forceinline__ void phase_ln_mod1(Frame& F) {
    const int gw = F.bid * 8 + F.wave, NGW = F.G * 8; const float* mod = (const float*)(F.ws + WS_MOD) + 3 * 3072;
    for (int row = gw; row < RT; row += NGW) {
        const bool isctx = row >= RL; const int rho = isctx ? 2 : row / SEQ;
        float* src = isctx ? (float*)(F.ws + WS_Y1C) + (size_t)(row - RL) * D : F.out + (size_t)row * D;
        f32x4 v[4];
#pragma unroll
        for (int j = 0; j < 4; ++j) v[j] = *(const f32x4*)(src + 256 * j + 4 * F.lane);
        ln_row(v, F.in[I_LNG], F.in[I_LNB], F.lane);
        if (!isctx) {
#pragma unroll
            for (int j = 0; j < 4; ++j) *(f32x4*)(src + 256 * j + 4 * F.lane) = v[j]; }
#pragma unroll
        for (int j = 0; j < 4; ++j) { const int idx = 256 * j + 4 * F.lane;
            const f32x4 sh = *(const f32x4*)(mod + rho * 3072 + idx), sc = *(const f32x4*)(mod + rho * 3072 + 1024 + idx);
            v[j] = v[j] * (1.0f + sc) + sh; }
        store_row_blk64((char*)F.ws + WS_HX, (size_t)row, F.lane, v);
    }
}
__device__ __forceinline__ void phase_ln_out(Frame& F) {
    const int gw = F.bid * 8 + F.wave, NGW = F.G * 8;
    for (int row = gw; row < RL; row += NGW) {
        float* src = F.out + (size_t)row * D;
        f32x4 v[4];
#pragma unroll
        for (int j = 0; j < 4; ++j) v[j] = *(const f32x4*)(src + 256 * j + 4 * F.lane);
        ln_row(v, F.in[I_LNG] + D, F.in[I_LNB] + D, F.lane);
#pragma unroll
        for (int j = 0; j < 4; ++j) *(f32x4*)(src + 256 * j + 4 * F.lane) = v[j];
    }
}
__device__ __forceinline__ void phase_scan(Frame& F) {
    const int gw = F.bid * 8 + F.wave, NGW = F.G * 8, n = F.lane;
    for (int item = gw; item < NG * NBATCH * 2; item += NGW) {
        const int g = item >> 2, b = (item >> 1) & 1, r = item & 1;
        const f32x4 za = *(const f32x4*)((const float*)(F.ws + WS_ZA) + ((size_t)(r * NG + g) * 64 + n) * 4);
        const float ar = za[0], ai = za[1], aTr = za[2], aTi = za[3];
        f32x4 bb[8];
        { const f32x4* bp = (const f32x4*)((const float*)(F.ws + WS_BBG) + ((size_t)(r * NG + g) * 64 + n) * 32);
#pragma unroll
          for (int i = 0; i < 8; ++i) bb[i] = bp[i]; }
        float hr = 0.f, hi = 0.f;
        const char* uc = (const char*)F.ws + WS_UCTX + (size_t)g * (RC * 32) + (size_t)b * CTXL * 32;
        for (int s = 0; s < CTXL; ++s) { const int t = r ? (CTXL - 1 - s) : s;
            const u32x4 u0 = *(const u32x4*)(uc + t * 32), u1 = *(const u32x4*)(uc + t * 32 + 16);
            float sr = 0.f, si = 0.f;
#pragma unroll
            for (int i = 0; i < 8; ++i) { const unsigned w = i < 4 ? u0[i] : u1[i - 4]; const float ua = bf2f(w), ub = bf2f(w >> 16);
                sr += bb[i][0] * ua + bb[i][2] * ub; si += bb[i][1] * ua + bb[i][3] * ub; }
            const float nr = ar * hr - ai * hi + sr, ni = ar * hi + ai * hr + si; hr = nr; hi = ni; }
        const float* Sg = (const float*)(F.ws + WS_S) + (size_t)g * NCOL * 256 + r * 128 + n;
        bf16* Xg = (bf16*)(F.ws + WS_X + (size_t)g * XPLANE) + TP + r * 128 + n;
        for (int s = 0; s < NCHB; ++s) { const int col = b * NCHB + (r ? (NCHB - 1 - s) : s);
            const float s_re = Sg[(size_t)col * 256], s_im = Sg[(size_t)col * 256 + 64];
            Xg[(size_t)col * XLD] = (bf16)f2bf(hr); Xg[(size_t)col * XLD + 64] = (bf16)f2bf(hi);
            const float nr = aTr * hr - aTi * hi + s_re, ni = aTr * hi + aTi * hr + s_im; hr = nr; hi = ni; }
    }
}

constexpr int N_PHASES = 13;
template <class P> __device__ __forceinline__ void run_gemm(Frame& F, const P& p, int bit) {
    if ((NAIVE_MASK >> bit) & 1) g8::gemm_phase_naive<P>(F.lds, p, F.G, F.bid); else g8::gemm_phase<P>(F.lds, p, F.G, F.bid);
}
__global__ void __launch_bounds__(512, 2) mk_fwd(Args args) {
    extern __shared__ __attribute__((aligned(16))) unsigned char lds_raw[];
    Frame F;
    F.lds = (LAS unsigned char*)lds_raw;
    F.tid = threadIdx.x; F.lane = F.tid & 63; F.wave = __builtin_amdgcn_readfirstlane(F.tid >> 6); F.G = gridDim.x; F.bid = blockIdx.x;
#pragma unroll
    for (int i = 0; i < 23; ++i) F.in[i] = args.in[i];
    F.out = args.out; F.ws = args.ws;
    volatile LAS unsigned* MISC = (volatile LAS unsigned*)(F.lds + MISC_OFF);
    if (F.tid < 32) MISC[F.tid] = 0u;
    __syncthreads();
    XcdBarrier bar; bar.bar = (unsigned*)(F.ws + WS_CTL) + CW_BAR; bar.x = 0; bar.st = nullptr;
    if (MK_N_LAUNCHES == 1) bar = xcd_barrier_post((unsigned*)(F.ws + WS_CTL) + CW_BAR, MISC + 8);
    const int lo = args.ph_lo, hi = args.ph_hi;
#define IN(k) (lo <= (k) && (k) < hi)
#define SEAM(k) do { if (IN(k) && IN((k) + 1)) xcd_barrier(bar); } while (0)
    unsigned char* ws = F.ws; const float* mod = (const float*)(ws + WS_MOD);
    if (IN(0)) { phase_prep(F); } SEAM(0);
    if (IN(1)) { phase_mod0(F); } SEAM(1);
    if (IN(2)) { g8::ProbG1 p{(const char*)ws + WS_HX, (const char*)ws + WS_HXV, (const char*)ws + WS_W1, F.in[I_CW], (char*)ws + WS_A2}; run_gemm(F, p, 0); } SEAM(2);
    if (IN(3)) { g8::ProbG2 p{(const char*)ws + WS_A2, (const char*)ws + WS_W2, F.in[I_X], F.in[I_CTX], mod, F.out, (float*)(ws + WS_Y1C)}; run_gemm(F, p, 1); } SEAM(3);
    if (IN(4)) { phase_ln_mod1(F); } SEAM(4);
    if (IN(5)) { g8::ProbG3 p{(const char*)ws + WS_HX, (const char*)ws + WS_W3, (char*)ws + WS_X, (char*)ws + WS_UCTX, (char*)ws + WS_SZ, 0}; run_gemm(F, p, 2); } SEAM(5);
    if (IN(6)) { g8::ProbS p{(const char*)ws + WS_X, (const char*)ws + WS_M2, (float*)(ws + WS_S)}; run_gemm(F, p, 3); } SEAM(6);
    if (IN(7)) { phase_scan(F); } SEAM(7);
    if (IN(8)) { g8::ProbY p{(const char*)ws + WS_X, (const char*)ws + WS_KR, (const char*)ws + WS_M4, (char*)ws + WS_G}; run_gemm(F, p, 4); } SEAM(8);
    if (IN(9)) { g8::ProbG3 p{(const char*)ws + WS_HX, (const char*)ws + WS_W3, (char*)ws + WS_X, (char*)ws + WS_UCTX, (char*)ws + WS_SZ, 1}; run_gemm(F, p, 5); } SEAM(9);
    if (IN(10)) { g8::ProbG4 p{(const char*)ws + WS_G, (const char*)ws + WS_WG, (const char*)ws + WS_SZ, F.in[I_BGLU], (char*)ws + WS_A4}; run_gemm(F, p, 6); } SEAM(10);
    if (IN(11)) { g8::ProbG5 p{(const char*)ws + WS_A4, (const char*)ws + WS_W5, mod, F.out}; run_gemm(F, p, 7); } SEAM(11);
    if (IN(12)) { phase_ln_out(F); }
#undef IN
#undef SEAM
}

extern "C" void kernel_launch(void* const* d_in, const int* in_sizes, int n_in, void* d_out, int out_size, void* d_ws, size_t ws_size, hipStream_t stream) {
    static int grid = 0;
    if (grid == 0) {
        if (n_in != 23 || in_sizes[0] != RL * D || out_size != RL * D || ws_size < WS_END) { fprintf(stderr, "kernel_launch: unexpected shapes (n_in %d, in0 %d, out %d, ws %zu); nothing launched\n", n_in, n_in > 0 ? in_sizes[0] : -1, out_size, ws_size); grid = -1; return; }
        int dev = 0, cus = 0, per_cu = 0;
        if (hipGetDevice(&dev) != hipSuccess || hipDeviceGetAttribute(&cus, hipDeviceAttributeMultiprocessorCount, dev) != hipSuccess) { grid = -1; return; }
        if (hipFuncSetAttribute((const void*)mk_fwd, hipFuncAttributeMaxDynamicSharedMemorySize, LDS_BYTES) != hipSuccess) { fprintf(stderr, "kernel_launch: hipFuncSetAttribute failed\n"); grid = -1; return; }
        if (hipOccupancyMaxActiveBlocksPerMultiprocessor(&per_cu, (const void*)mk_fwd, 512, LDS_BYTES) != hipSuccess || per_cu < 1) { fprintf(stderr, "kernel_launch: occupancy query says %d\n", per_cu); per_cu = 1; }
        (void)hipGetLastError();
        grid = cus * 1;
        if (per_cu < 1) grid = -1;
    }
    if (grid < 0) return;
    (void)hipMemsetAsync((char*)d_ws + WS_CTL, 0, CTL_ZERO_BYTES, stream);
    Args a{};
    for (int i = 0; i < 23; ++i) a.in[i] = (const float*)d_in[i];
    a.out = (float*)d_out; a.ws = (unsigned char*)d_ws;
    if (MK_N_LAUNCHES == 1) {
        a.ph_lo = 0; a.ph_hi = N_PHASES;
        void* kargs[] = {&a};
        hipError_t e = hipLaunchCooperativeKernel((const void*)mk_fwd, dim3(grid), dim3(512), kargs, LDS_BYTES, stream);
        if (e != hipSuccess) fprintf(stderr, "kernel_launch: cooperative launch failed: %s (grid %d)\n", hipGetErrorString(e), grid);
    } else {
        for (int ph = 0; ph < N_PHASES; ++ph) { a.ph_lo = ph; a.ph_hi = ph + 1; hipLaunchKernelGGL(mk_fwd, dim3(grid), dim3(512), LDS_BYTES, stream, a); }
    }
}
```

```cpp
#include <hip/hip_runtime.h>
#include <cstdio>
#include <cstdint>

#ifndef MK_N_LAUNCHES
#define MK_N_LAUNCHES 1
#endif
#ifndef NAIVE_MASK
#define NAIVE_MASK 0
#endif

#ifndef PROBE_REP_PHASE
#define PROBE_REP_PHASE -1
#define PROBE_REP_N 0
#endif
#define GAS __attribute__((address_space(1)))
#define LAS __attribute__((address_space(3)))
typedef unsigned short bf16;
typedef short bf16x8 __attribute__((ext_vector_type(8)));
typedef float f32x4 __attribute__((ext_vector_type(4)));
typedef float f32x2 __attribute__((ext_vector_type(2)));
typedef unsigned u32x4 __attribute__((ext_vector_type(4)));
typedef unsigned u32x2 __attribute__((ext_vector_type(2)));

constexpr int D = 1024, NBATCH = 2, SEQ = 16384, CTXL = 256, GRIDW = 64, EW = 2048, NG = 128, NST = 64, PG = 16;
constexpr int RL = NBATCH * SEQ;
constexpr int RC = NBATCH * CTXL;
constexpr int RT = RL + RC;
constexpr int TCH = 64;
constexpr int TP = TCH * PG;
constexpr int XLD = TP + 4 * NST;
constexpr int NCHB = SEQ / TCH;
constexpr int NCOL = NBATCH * NCHB;
constexpr int PSTR = 2 * TCH * PG;
constexpr int KRG = PG * PSTR;
constexpr float LN_EPS = 1e-5f;
constexpr float DN_ALPHA = 1.41421356237f;

constexpr size_t MiB = 1u << 20;
constexpr size_t WS_CTL = 0, CTL_ZERO_BYTES = 1 * MiB;
constexpr size_t WS_MOD = 1 * MiB;
constexpr size_t WS_ZA = 1 * MiB + 256 * 1024;
constexpr size_t WS_BBG = 2 * MiB;
constexpr size_t WS_WG = 6 * MiB, WS_W5 = 14 * MiB, WS_W3 = 18 * MiB;
constexpr size_t WS_KR = 26 * MiB;
constexpr size_t WS_M4 = 34 * MiB;
constexpr size_t WS_HX = 98 * MiB;
constexpr size_t WS_X = 163 * MiB;
constexpr size_t WS_A2 = 163 * MiB;
constexpr size_t WS_SZ = 195 * MiB;
constexpr size_t WS_M2 = 323 * MiB;
constexpr size_t WS_G = 323 * MiB;
constexpr size_t WS_S = 387 * MiB;
constexpr size_t WS_HXV = 387 * MiB;
constexpr size_t WS_UCTX = 452 * MiB;
constexpr size_t WS_W1 = 454 * MiB, WS_W2 = 470 * MiB;
constexpr size_t WS_Y1C = 474 * MiB;
constexpr size_t WS_A4 = 34 * MiB;
constexpr size_t WS_END = 476 * MiB;
constexpr size_t HXPLANE = (size_t)RT * 128;
constexpr size_t A4PLANE = (size_t)RL * 128;
constexpr size_t GPLANE = (size_t)RL * 32;
constexpr size_t XPLANE = (size_t)NCOL * XLD * 2;
static_assert(WS_X + (size_t)NG * XPLANE <= WS_M2 && WS_A2 + 32 * HXPLANE <= WS_M2, "map");
static_assert(WS_HX + 16 * HXPLANE <= WS_X && WS_HXV + 16 * HXPLANE <= WS_UCTX + 2 * MiB && WS_S + (size_t)NG * NCOL * 256 * 4 <= WS_UCTX, "map");
static_assert(WS_G + (size_t)NG * GPLANE <= WS_UCTX && WS_SZ + (size_t)RL * 2048 * 2 <= WS_G && WS_A4 + 32 * A4PLANE <= WS_X, "map");
static_assert(WS_M4 + (size_t)NG * TP * 256 * 2 <= WS_HX && WS_KR + (size_t)NG * KRG * 2 <= WS_M4 && WS_M2 + (size_t)NG * 256 * TP * 2 <= WS_S, "map");
constexpr int CW_BAR = 4096;

constexpr int RING_BYTES = 131072;
constexpr int XL_OFF = RING_BYTES;
constexpr int XL_BYTES = 130 * 128;
constexpr int MISC_OFF = XL_OFF + XL_BYTES;
constexpr int LDS_BYTES = MISC_OFF + 128;

#define RLX_AGENT __ATOMIC_RELAXED, __HIP_MEMORY_SCOPE_AGENT
#define LDS_WAIT() asm volatile("s_waitcnt lgkmcnt(0)" ::: "memory")
#define VM_WAIT() asm volatile("s_waitcnt vmcnt(0)" ::: "memory")
__host__ __device__ __forceinline__ unsigned f2bf(float f) { unsigned u = __builtin_bit_cast(unsigned, f); return (u + 0x7fffu + ((u >> 16) & 1u)) >> 16; }
__host__ __device__ __forceinline__ unsigned pk2(float lo, float hi) { return f2bf(lo) | (f2bf(hi) << 16); }
__host__ __device__ __forceinline__ float bf2f(unsigned b) { return __builtin_bit_cast(float, (b & 0xffffu) << 16); }
__device__ __forceinline__ float sigmoidf_(float x) { return 1.0f / (1.0f + __expf(-x)); }
__device__ __forceinline__ float siluf_(float x) { return x * sigmoidf_(x); }
__device__ __forceinline__ float gelu_tanh(float x) { return x * sigmoidf_(1.5957691216f * (x + 0.044715f * x * x * x)); }
__device__ __forceinline__ float wave_sum(float v) {
#pragma unroll
    for (int o = 1; o < 64; o <<= 1) v += __shfl_xor(v, o);
    return v;
}

#define XB_TMO      128
#define XB_XCNT(j)  (256  + 64 * (j))
#define XB_XSUB(j)  (1280 + 64 * (j))
#define XB_XGEN(j)  (2304 + 64 * (j))
#define XB_TOP      3328
#define XB_TOPGEN   3392
#define XCD_BAR_WORDS 3456
#define XB_SPIN_CAP (1u << 20)
__device__ __forceinline__ unsigned xb_ld(unsigned* p)              { return __hip_atomic_load(p, __ATOMIC_RELAXED, __HIP_MEMORY_SCOPE_AGENT); }
__device__ __forceinline__ unsigned xb_add(unsigned* p, unsigned v) { return __hip_atomic_fetch_add(p, v, __ATOMIC_RELAXED, __HIP_MEMORY_SCOPE_AGENT); }
__device__ __forceinline__ unsigned xb_xcc_id() { return (unsigned)__builtin_amdgcn_s_getreg((3 << 11) | 20) & 0xFu; }
#define XB_SPIN(cond, bar) do { unsigned _sp = 0; while (cond) { __builtin_amdgcn_s_sleep(1); \
    if ((++_sp & 255u) == 0u) { if (xb_ld(&(bar)[XB_TMO])) break; if (_sp > XB_SPIN_CAP) { atomicAdd(&(bar)[XB_TMO], 1u); break; } } } } while (0)
struct XcdBarrier { unsigned* bar; unsigned x; volatile LAS unsigned* st; };
__device__ __forceinline__ XcdBarrier xcd_barrier_post(unsigned* bar, volatile LAS unsigned* st) {
    XcdBarrier b; b.bar = bar; b.x = xb_xcc_id(); b.st = st;
    if (threadIdx.x == 0) (void)xb_add(&bar[XB_XCNT(b.x)], 1u);
    return b;
}
__device__ __forceinline__ void xcd_barrier_complete(unsigned* bar, unsigned x, unsigned& nloc, unsigned& nx) {
    const unsigned G = gridDim.x * gridDim.y * gridDim.z;
    unsigned sum, cnt, mine, sp = 0u;
    for (;;) {
        sum = 0u; cnt = 0u; mine = 0u;
#pragma unroll
        for (unsigned j = 0; j < 16; ++j) { const unsigned c = xb_ld(&bar[XB_XCNT(j)]); sum += c; cnt += (c > 0u) ? 1u : 0u; mine = (j == x) ? c : mine; }
        if (sum == G) break;
        __builtin_amdgcn_s_sleep(1);
        if ((++sp & 255u) == 0u) { if (xb_ld(&bar[XB_TMO])) break; if (sp > XB_SPIN_CAP) { atomicAdd(&bar[XB_TMO], 1u); break; } }
    }
    nloc = mine > 0u ? mine : 1u; nx = cnt > 0u ? cnt : 1u;
}
__device__ __forceinline__ void xcd_barrier(const XcdBarrier& b) {
    asm volatile("s_waitcnt vmcnt(0)" ::: "memory");
    __syncthreads();
    if (threadIdx.x == 0) {
        unsigned* bar = b.bar;
        __builtin_amdgcn_s_waitcnt(0);
        unsigned nloc = b.st[0], nx = b.st[1];
        if (nloc == 0u) { xcd_barrier_complete(bar, b.x, nloc, nx); b.st[0] = nloc; b.st[1] = nx; }
        const unsigned old = xb_add(&bar[XB_XSUB(b.x)], 1u);
        const unsigned gen = old / nloc;
        if (old + 1u == (gen + 1u) * nloc) {
            __builtin_amdgcn_fence(__ATOMIC_RELEASE, "agent");
            asm volatile("s_waitcnt vmcnt(0)" ::: "memory");
            const unsigned og = xb_add(&bar[XB_TOP], 1u);
            const unsigned tg = og / nx;
            if (og + 1u == (tg + 1u) * nx) xb_add(&bar[XB_TOPGEN], 1u);
            else XB_SPIN(xb_ld(&bar[XB_TOPGEN]) == tg, bar);
            __builtin_amdgcn_fence(__ATOMIC_ACQUIRE, "agent");
            xb_add(&bar[XB_XGEN(b.x)], 1u);
            asm volatile("s_waitcnt vmcnt(0)" ::: "memory");
        } else {
            XB_SPIN(xb_ld(&bar[XB_XGEN(b.x)]) == gen, bar);
            __builtin_amdgcn_fence(__ATOMIC_ACQUIRE, "agent");
            asm volatile("s_waitcnt vmcnt(0)" ::: "memory");
        }
    }
    __syncthreads();
}

struct Args {
    const float* in[23];
    float* out; unsigned char* ws;
    int ph_lo, ph_hi;
};
enum { I_X = 0, I_C, I_CTX, I_CCTX, I_ADAW, I_ADAB, I_LNG, I_LNB, I_CWIN, I_CW, I_CWOUT, I_SWIN, I_LRE, I_LIM, I_LSTEP, I_BRE, I_BIM, I_CRE, I_CIM, I_SD, I_WGLU, I_BGLU, I_SWOUT };

namespace g8 {
constexpr int BM = 256, BK = 64, HALF = 128, HTB = HALF * BK * 2, NXCD = 8, WGM = 8;
__host__ __device__ __forceinline__ int lds_byte(int r, int c) { const int st = (r >> 4) * 2 + (c >> 5), rr = r & 15, cc = c & 31, ob = rr * 64 + cc * 2; return st * 1024 + (ob ^ (((ob >> 9) & 1) << 5)); }
__host__ __device__ __forceinline__ void stage_rc(int b, int& R, int& C) { const int st = b / 1024, sb = b % 1024, swz = sb ^ (((sb >> 9) & 1) << 5); R = (st >> 1) * 16 + swz / 64; C = (st & 1) * 32 + (swz % 64) / 2; }
__host__ __device__ __forceinline__ int perm32(int rho) { const int n = rho >> 4, i = rho & 15; return 8 * (i >> 2) + 4 * n + (i & 3); }

struct Unit { int pm, pn, g; };
__host__ __device__ __forceinline__ int xcd_remap(int L, int nwg) { const int q = nwg / NXCD, r = nwg % NXCD, xcd = L % NXCD, off = L / NXCD; return (xcd < r ? xcd * (q + 1) : r * (q + 1) + (xcd - r) * q) + off; }
__host__ __device__ __forceinline__ bool order_mn(int L, int nM, int nN, Unit& u) {
    const int nwg = nM * nN; if (L >= nwg) return false;
    const int wgid = xcd_remap(L, nwg);
    const int nig = WGM * nN, gid = wgid / nig, fm = gid * WGM, gsz = (nM - fm) < WGM ? (nM - fm) : WGM;
    u.pm = fm + ((wgid % nig) % gsz); u.pn = (wgid % nig) / gsz; u.g = 0; return true;
}
__host__ __device__ __forceinline__ bool order_g(int L, int ng, int nM, int nN, Unit& u) {
    const int per = nM * nN, nwg = ng * per; if (L >= nwg) return false;
    const int wgid = xcd_remap(L, nwg);
    u.g = wgid / per; const int rem = wgid % per; u.pm = rem / nN; u.pn = rem % nN; return true;
}

__device__ __forceinline__ unsigned cvt_pk_bf16(float lo, float hi) { unsigned r; asm volatile("v_cvt_pk_bf16_f32 %0, %1, %2" : "=v"(r) : "v"(lo), "v"(hi)); return r; }

typedef f32x4 Acc[2][2][4][2];

template <class P>
__device__ __forceinline__ void gemm_phase(LAS unsigned char* lds, const P& p, const int G, const int c) {
    const int tid = threadIdx.x, wid = __builtin_amdgcn_readfirstlane(tid >> 6), lane = tid & 63, wr = wid >> 2, wc = wid & 3, fr = lane & 15, fq = lane >> 4;
    constexpr int NS = P::NSEG; constexpr int S1 = NS - 1;
    const int nt = p.nt(), nt0 = p.nt0();
    unsigned voffA0, voffA1, voffB0, voffB1;
    { int R, C; stage_rc(tid * 16, R, C); const int Rb = P::PERM ? ((R & ~31) + perm32(R & 31)) : R;
      voffA0 = (unsigned)(p.a_off(0, R, C) - p.a_off(0, 0, 0) + p.a_bias(0)); voffB0 = (unsigned)(p.b_off(0, Rb, C) - p.b_off(0, 0, 0) + p.b_bias(0));
      voffA1 = (unsigned)(p.a_off(S1, R, C) - p.a_off(S1, 0, 0) + p.a_bias(S1)); voffB1 = (unsigned)(p.b_off(S1, Rb, C) - p.b_off(S1, 0, 0) + p.b_bias(S1)); }
    const long r64A0 = p.a_off(0, 64, 0) - p.a_off(0, 0, 0), r64A1 = p.a_off(S1, 64, 0) - p.a_off(S1, 0, 0), r64B0 = p.b_off(0, 64, 0) - p.b_off(0, 0, 0), r64B1 = p.b_off(S1, 64, 0) - p.b_off(S1, 0, 0);
    const long hA0 = p.a_off(0, 128, 0) - p.a_off(0, 0, 0), hA1 = p.a_off(S1, 128, 0) - p.a_off(S1, 0, 0), hB0 = p.b_off(0, 128, 0) - p.b_off(0, 0, 0), hB1 = p.b_off(S1, 128, 0) - p.b_off(S1, 0, 0);
    const long ksA0 = p.a_off(0, 0, 64) - p.a_off(0, 0, 0), ksA1 = p.a_off(S1, 0, 64) - p.a_off(S1, 0, 0), ksB0 = p.b_off(0, 0, 64) - p.b_off(0, 0, 0), ksB1 = p.b_off(S1, 0, 64) - p.b_off(S1, 0, 0);
    const unsigned ldsw = (unsigned)wid * 1024u;
    const int aoff = lds_byte(wr * 64 + fr, fq * 8), boff = lds_byte(wc * 32 + fr, fq * 8);
#define G8_SA(b, h) (((b) * 2 + (h)) * HTB)
#define G8_SB(b, h) ((4 + (b) * 2 + (h)) * HTB)
#define G8_STAGE1(bufoff, gptr, voff, r64) do { \
        __builtin_amdgcn_global_load_lds((const unsigned*)((gptr) + (voff)), (LAS unsigned*)(lds + (bufoff) + ldsw), 16, 0, 0); \
        __builtin_amdgcn_global_load_lds((const unsigned*)((gptr) + (r64) + (voff)), (LAS unsigned*)(lds + (bufoff) + ldsw + 8192), 16, 0, 0); } while (0)
#define G8_STA(bufoff, ptr, sg, h) G8_STAGE1(bufoff, (ptr) + (h) * ((sg) ? hA1 : hA0), ((sg) ? voffA1 : voffA0), ((sg) ? r64A1 : r64A0))
#define G8_STB(bufoff, ptr, sg, h) G8_STAGE1(bufoff, (ptr) + (h) * ((sg) ? hB1 : hB0), ((sg) ? voffB1 : voffB0), ((sg) ? r64B1 : r64B0))
#define G8_LDA(dst, b, h) do { _Pragma("unroll") for (int m = 0; m < 4; ++m) _Pragma("unroll") for (int k = 0; k < 2; ++k) dst[m][k] = *(const LAS bf16x8*)(lds + G8_SA(b, h) + aoff + m * 2048 + k * 1024); } while (0)
#define G8_LDB(dst, b, h) do { _Pragma("unroll") for (int n = 0; n < 2; ++n) _Pragma("unroll") for (int k = 0; k < 2; ++k) dst[n][k] = *(const LAS bf16x8*)(lds + G8_SB(b, h) + boff + n * 2048 + k * 1024); } while (0)
#define G8_MMA(ai, bj, At, Bt) do { __builtin_amdgcn_s_setprio(1); _Pragma("unroll") for (int m = 0; m < 4; ++m) _Pragma("unroll") for (int n = 0; n < 2; ++n) _Pragma("unroll") for (int k = 0; k < 2; ++k) \
        acc[ai][bj][m][n] = __builtin_amdgcn_mfma_f32_16x16x32_bf16(Bt[n][k], At[m][k], acc[ai][bj][m][n], 0, 0, 0); __builtin_amdgcn_s_setprio(0); } while (0)
#define G8_WAIT_V(n) asm volatile("s_waitcnt vmcnt(" #n ")" ::: "memory")
#define G8_WAIT_L(n) asm volatile("s_waitcnt lgkmcnt(" #n ")" ::: "memory")
#define G8_BAR __builtin_amdgcn_s_barrier()
#define G8_SCHED __builtin_amdgcn_sched_barrier(0)
    Unit cur, nxt; int ui = 0;
    if (!p.unit(c, cur)) return;
    Acc acc;
#pragma unroll
    for (int a = 0; a < 2; ++a)
#pragma unroll
        for (int b = 0; b < 2; ++b)
#pragma unroll
            for (int m = 0; m < 4; ++m)
#pragma unroll
                for (int n = 0; n < 2; ++n) acc[a][b][m][n] = (f32x4){0.f, 0.f, 0.f, 0.f};
    bf16x8 At[4][2], B0[2][2], B1[2][2];
    const char* cA0 = p.a_base(cur, 0) - p.a_bias(0); const char* cA1 = p.a_base(cur, S1) - p.a_bias(S1);
    const char* cB0 = p.b_base(cur, 0) - p.b_bias(0); const char* cB1 = p.b_base(cur, S1) - p.b_bias(S1);
    G8_STB(G8_SB(0, 0), cB0, false, 0); G8_STB(G8_SB(0, 1), cB0, false, 1); G8_STA(G8_SA(0, 0), cA0, false, 0); G8_STA(G8_SA(0, 1), cA0, false, 1);
    if (wr == 1) G8_BAR;
    G8_WAIT_V(2); G8_BAR;
    G8_STB(G8_SB(1, 0), cB0 + ksB0, false, 0); G8_STA(G8_SA(1, 0), cA0 + ksA0, false, 0); G8_STB(G8_SB(1, 1), cB0 + ksB0, false, 1);
    G8_WAIT_V(6); G8_BAR;
    for (;;) {
        const bool has_next = p.unit((ui + 1) * G + c, nxt);
        const char* nA0 = has_next ? p.a_base(nxt, 0) - p.a_bias(0) : cA0; const char* nA1 = has_next ? p.a_base(nxt, S1) - p.a_bias(S1) : cA1;
        const char* nB0 = has_next ? p.b_base(nxt, 0) - p.b_bias(0) : cB0; const char* nB1 = has_next ? p.b_base(nxt, S1) - p.b_bias(S1) : cB1;
        for (int t = 0; t < nt; t += 2) {
            const bool last = (t == nt - 2);
            const bool sg1 = (NS > 1) && (t + 1 >= nt0);
            const bool sg2 = (NS > 1) && !last && (t + 2 >= nt0);
            const char* a1 = sg1 ? cA1 + (long)(t + 1 - nt0) * ksA1 : cA0 + (long)(t + 1) * ksA0;
            const char* a2 = last ? nA0 : (sg2 ? cA1 + (long)(t + 2 - nt0) * ksA1 : cA0 + (long)(t + 2) * ksA0);
            const char* b2 = last ? nB0 : (sg2 ? cB1 + (long)(t + 2 - nt0) * ksB1 : cB0 + (long)(t + 2) * ksB0);
            const char* a3 = a2 + (sg2 ? ksA1 : ksA0); const char* b3 = b2 + (sg2 ? ksB1 : ksB0);
            G8_LDB(B0, 0, 0); G8_LDB(B1, 0, 1); G8_SCHED; G8_LDA(At, 0, 0); G8_STA(G8_SA(1, 1), a1, sg1, 1);
            G8_WAIT_V(8); G8_WAIT_L(0); G8_BAR; G8_MMA(0, 0, At, B0); G8_MMA(0, 1, At, B1); G8_BAR; G8_SCHED;
            G8_LDA(At, 0, 1); G8_STB(G8_SB(0, 0), b2, sg2, 0); G8_STB(G8_SB(0, 1), b2, sg2, 1); G8_STA(G8_SA(0, 0), a2, sg2, 0);
            G8_WAIT_V(8); G8_WAIT_L(0); G8_BAR; G8_MMA(1, 0, At, B0); G8_MMA(1, 1, At, B1); G8_BAR; G8_SCHED;
            G8_LDB(B0, 1, 0); G8_LDB(B1, 1, 1); G8_SCHED; G8_LDA(At, 1, 0); G8_STA(G8_SA(0, 1), a2, sg2, 1);
            G8_WAIT_V(8); G8_WAIT_L(0); G8_BAR; G8_MMA(0, 0, At, B0); G8_MMA(0, 1, At, B1); G8_BAR; G8_SCHED;
            G8_LDA(At, 1, 1); G8_STB(G8_SB(1, 0), b3, sg2, 0); G8_STB(G8_SB(1, 1), b3, sg2, 1); G8_STA(G8_SA(1, 0), a3, sg2, 0);
            G8_WAIT_V(8); G8_WAIT_L(0); G8_BAR; G8_MMA(1, 0, At, B0); G8_MMA(1, 1, At, B1); G8_BAR; G8_SCHED;
        }
        if (wr == 0) G8_BAR;
        p.epi(acc, cur, wr, wc, fr, fq, lds);
        if (!has_next) break;
#pragma unroll
        for (int a = 0; a < 2; ++a)
#pragma unroll
            for (int b = 0; b < 2; ++b)
#pragma unroll
                for (int m = 0; m < 4; ++m)
#pragma unroll
                    for (int n = 0; n < 2; ++n) acc[a][b][m][n] = (f32x4){0.f, 0.f, 0.f, 0.f};
        cur = nxt; ++ui; cA0 = nA0; cA1 = nA1; cB0 = nB0; cB1 = nB1;
        if (wr == 1) G8_BAR;
    }
    G8_WAIT_V(0);
    G8_BAR;
#undef G8_SA
#undef G8_SB
#undef G8_STAGE1
#undef G8_STA
#undef G8_STB
#undef G8_LDA
#undef G8_LDB
#undef G8_MMA
#undef G8_WAIT_V
#undef G8_WAIT_L
#undef G8_BAR
#undef G8_SCHED
}

template <class P>
__device__ __forceinline__ void gemm_phase_naive(LAS unsigned char* lds, const P& p, const int G, const int c) {
    const int tid = threadIdx.x, wid = tid >> 6, lane = tid & 63, wr = wid >> 2, wc = wid & 3, fr = lane & 15, fq = lane >> 4;
    LAS float* As = (LAS float*)lds;
    LAS float* Bs = As + 16 * 260;
    const int nt = p.nt(), nt0 = p.nt0();
    Unit u;
    for (int ui = 0; p.unit(ui * G + c, u); ++ui) {
        Acc acc;
#pragma unroll
        for (int a = 0; a < 2; ++a)
#pragma unroll
            for (int b = 0; b < 2; ++b)
#pragma unroll
                for (int m = 0; m < 4; ++m)
#pragma unroll
                    for (int n = 0; n < 2; ++n) acc[a][b][m][n] = (f32x4){0.f, 0.f, 0.f, 0.f};
        for (int k0 = 0; k0 < nt * 64; k0 += 16) {
            const int seg = (P::NSEG > 1 && k0 >= nt0 * 64) ? 1 : 0, ks = k0 - (seg ? nt0 * 64 : 0);
            { const int row = tid >> 1, h8 = tid & 1;
              const u32x4 va = *(const u32x4*)(p.a_base(u, seg) + p.a_off(seg, row, ks + 8 * h8));
              const u32x4 vb = *(const u32x4*)(p.b_base(u, seg) + p.b_off(seg, row, ks + 8 * h8));
              __syncthreads();
#pragma unroll
              for (int i = 0; i < 4; ++i) { As[(8 * h8 + 2 * i) * 260 + row] = bf2f(va[i]); As[(8 * h8 + 2 * i + 1) * 260 + row] = bf2f(va[i] >> 16);
                                            Bs[(8 * h8 + 2 * i) * 260 + row] = bf2f(vb[i]); Bs[(8 * h8 + 2 * i + 1) * 260 + row] = bf2f(vb[i] >> 16); }
              __syncthreads(); }
            for (int kk = 0; kk < 16; ++kk) {
                float av[2][4], bv[2][2][4];
#pragma unroll
                for (int ai = 0; ai < 2; ++ai)
#pragma unroll
                    for (int m = 0; m < 4; ++m) av[ai][m] = As[kk * 260 + ai * 128 + wr * 64 + m * 16 + fr];
#pragma unroll
                for (int bj = 0; bj < 2; ++bj)
#pragma unroll
                    for (int n = 0; n < 2; ++n)
#pragma unroll
                        for (int j = 0; j < 4; ++j) bv[bj][n][j] = Bs[kk * 260 + bj * 128 + wc * 32 + (P::PERM ? 8 * fq + 4 * n + j : 16 * n + 4 * fq + j)];
#pragma unroll
                for (int ai = 0; ai < 2; ++ai)
#pragma unroll
                    for (int bj = 0; bj < 2; ++bj)
#pragma unroll
                        for (int m = 0; m < 4; ++m)
#pragma unroll
                            for (int n = 0; n < 2; ++n)
#pragma unroll
                                for (int j = 0; j < 4; ++j) acc[ai][bj][m][n][j] += av[ai][m] * bv[bj][n][j];
            }
        }
        __syncthreads();
        p.epi(acc, u, wr, wc, fr, fq, lds);
        __syncthreads();
    }
}


struct ProbG1 {
    static constexpr bool PERM = false; static constexpr int NSEG = 1;
    const char* HX; const char* HXV; const char* W1; const float* convw; char* A2;
    __host__ __device__ int nt0() const { return 16; } __host__ __device__ int nt() const { return 16; }
    __host__ __device__ long a_bias(int) const { return 0; } __host__ __device__ long b_bias(int) const { return 0; }
    __host__ __device__ bool unit(int L, Unit& u) const { return order_mn(L, RT / 256, 32, u); }
    __host__ __device__ const char* a_base(const Unit& u, int) const { return ((u.pn < 16 || u.pm >= 128) ? HX : HXV) + (size_t)u.pm * 256 * 128; }
    __host__ __device__ long a_off(int, int r, int k) const { return (long)r * 128 + (long)(k >> 6) * (long)HXPLANE + (k & 63) * 2; }
    __host__ __device__ const char* b_base(const Unit& u, int) const { return W1 + (size_t)u.pn * 256 * 2048; }
    __host__ __device__ long b_off(int, int c, int k) const { return (long)c * 2048 + k * 2; }
    __device__ __forceinline__ void epi(Acc& acc, const Unit& u, int wr, int wc, int fr, int fq, LAS unsigned char* lds) const {
        LAS unsigned char* xl = lds + XL_OFF;
        const bool chain = (u.pn >= 16) || (u.pm >= 128);
        const bool vert = (u.pn >= 16) && (u.pm < 128);
        const int ch0 = wc * 16 + fq * 4, chg = u.pn * 64 + ch0;
        const f32x4 w0 = *(const f32x4*)(convw + chg), w1 = *(const f32x4*)(convw + 2048 + chg), w2 = *(const f32x4*)(convw + 4096 + chg);
        const int slot = wc * 4 + fq;
#pragma unroll
        for (int ai = 0; ai < 2; ++ai) {
            f32x4 uu[4];
#pragma unroll
            for (int m = 0; m < 4; ++m) uu[m] = acc[ai][0][m][1] * acc[ai][1][m][0];
            LDS_WAIT(); __builtin_amdgcn_s_barrier();
#pragma unroll
            for (int m = 0; m < 4; ++m) { const int br = 1 + wr * 64 + m * 16 + fr;
                u32x2 w; w.x = pk2(uu[m][0], uu[m][1]); w.y = pk2(uu[m][2], uu[m][3]);
                *(LAS u32x2*)(xl + br * 128 + ((slot ^ (br & 15)) << 3)) = w; }
            if (ai == 0) { if (wr == 0 && fr == 0) { const f32x4 e = acc[1][0][0][1] * acc[1][1][0][0];
                    u32x2 w; w.x = pk2(e[0], e[1]); w.y = pk2(e[2], e[3]); *(LAS u32x2*)(xl + 129 * 128 + ((slot ^ (129 & 15)) << 3)) = w; } }
            else { if (wr == 1 && fr == 15) { const f32x4 e = acc[0][0][3][1] * acc[0][1][3][0];
                    u32x2 w; w.x = pk2(e[0], e[1]); w.y = pk2(e[2], e[3]); *(LAS u32x2*)(xl + 0 * 128 + ((slot ^ 0) << 3)) = w; } }
            LDS_WAIT();
            __builtin_amdgcn_s_barrier();
#pragma unroll
            for (int m = 0; m < 4; ++m) {
                const int rl = wr * 64 + m * 16 + fr, rt = ai * 128 + rl;
                const u32x2 up = *(const LAS u32x2*)(xl + rl * 128 + ((slot ^ (rl & 15)) << 3));
                const u32x2 dn = *(const LAS u32x2*)(xl + (rl + 2) * 128 + ((slot ^ ((rl + 2) & 15)) << 3));
                const bool first = chain ? (rt == 0) : ((rt & 63) == 0), lastr = chain ? (rt == 255) : ((rt & 63) == 63);
                f32x4 upv = {bf2f(up.x), bf2f(up.x >> 16), bf2f(up.y), bf2f(up.y >> 16)}, dnv = {bf2f(dn.x), bf2f(dn.x >> 16), bf2f(dn.y), bf2f(dn.y >> 16)};
                if (first) upv = (f32x4){0.f, 0.f, 0.f, 0.f};
                if (lastr) dnv = (f32x4){0.f, 0.f, 0.f, 0.f};
                const f32x4 yc = w1 * uu[m] + w0 * upv + w2 * dnv;
                const f32x4 bgv = acc[ai][0][m][0], zv = acc[ai][1][m][1];
                f32x4 o;
#pragma unroll
                for (int j = 0; j < 4; ++j) o[j] = bgv[j] * yc[j] * siluf_(zv[j]);
                const int tok = vert ? ((u.pm >> 6) * SEQ + rt * GRIDW + (u.pm & 63)) : (u.pm * 256 + rt);
                u32x2 w; w.x = pk2(o[0], o[1]); w.y = pk2(o[2], o[3]);
                *(u32x2*)(A2 + (size_t)u.pn * HXPLANE + (size_t)tok * 128 + ch0 * 2) = w;
            }
        }
    }
};

struct ProbG2 {
    static constexpr bool PERM = false; static constexpr int NSEG = 1;
    const char* A2; const char* W2; const float* x; const float* ctx; const float* mod; float* out; float* y1c;
    __host__ __device__ int nt0() const { return 32; } __host__ __device__ int nt() const { return 32; }
    __host__ __device__ long a_bias(int) const { return 0; } __host__ __device__ long b_bias(int) const { return 0; }
    __host__ __device__ bool unit(int L, Unit& u) const { return order_mn(L, RT / 256, 4, u); }
    __host__ __device__ const char* a_base(const Unit& u, int) const { return A2 + (size_t)u.pm * 256 * 128; }
    __host__ __device__ long a_off(int, int r, int k) const { return (long)r * 128 + (long)(k >> 6) * (long)HXPLANE + (k & 63) * 2; }
    __host__ __device__ const char* b_base(const Unit& u, int) const { return W2 + (size_t)u.pn * 256 * 4096; }
    __host__ __device__ long b_off(int, int c, int k) const { return (long)c * 4096 + k * 2; }
    __device__ __forceinline__ void epi(Acc& acc, const Unit& u, int wr, int wc, int fr, int fq, LAS unsigned char*) const {
        const bool isctx = u.pm >= 128;
        const int rho = isctx ? 2 : (u.pm >> 6);
        const float* src = isctx ? ctx - (size_t)RL * D : x; float* dst = isctx ? y1c - (size_t)RL * D : out;
        const int col0 = u.pn * 256 + wc * 32 + 4 * fq;
        f32x4 gt[2][2];
#pragma unroll
        for (int bj = 0; bj < 2; ++bj)
#pragma unroll
            for (int n = 0; n < 2; ++n) gt[bj][n] = *(const f32x4*)(mod + rho * 3072 + 2048 + col0 + bj * 128 + n * 16);
#pragma unroll
        for (int ai = 0; ai < 2; ++ai)
#pragma unroll
            for (int m = 0; m < 4; ++m) { const size_t off = (size_t)(u.pm * 256 + ai * 128 + wr * 64 + m * 16 + fr) * D + col0;
#pragma unroll
                for (int bj = 0; bj < 2; ++bj)
#pragma unroll
                    for (int n = 0; n < 2; ++n) { const f32x4 xv = *(const f32x4*)(src + off + bj * 128 + n * 16);
                        *(f32x4*)(dst + off + bj * 128 + n * 16) = DN_ALPHA * xv + gt[bj][n] * acc[ai][bj][m][n]; } }
    }
};

struct ProbG3 {
    static constexpr bool PERM = true; static constexpr int NSEG = 1;
    const char* HX; const char* W3; char* X; char* UCTX; char* SZ; int zhalf;
    __host__ __device__ int nt0() const { return 16; } __host__ __device__ int nt() const { return 16; }
    __host__ __device__ long a_bias(int) const { return 0; } __host__ __device__ long b_bias(int) const { return 0; }
    __host__ __device__ bool unit(int L, Unit& u) const { return order_mn(L, zhalf ? RL / 256 : RT / 256, 8, u); }
    __host__ __device__ const char* a_base(const Unit& u, int) const { return HX + (size_t)u.pm * 256 * 128; }
    __host__ __device__ long a_off(int, int r, int k) const { return (long)r * 128 + (long)(k >> 6) * (long)HXPLANE + (k & 63) * 2; }
    __host__ __device__ const char* b_base(const Unit& u, int) const { return W3 + (size_t)(zhalf * 2048 + u.pn * 256) * 2048; }
    __host__ __device__ long b_off(int, int c, int k) const { return (long)c * 2048 + k * 2; }
    __device__ __forceinline__ void epi(Acc& acc, const Unit& u, int wr, int wc, int fr, int fq, LAS unsigned char*) const {
#pragma unroll
        for (int ai = 0; ai < 2; ++ai)
#pragma unroll
            for (int m = 0; m < 4; ++m) { const int tok = u.pm * 256 + ai * 128 + wr * 64 + m * 16 + fr;
#pragma unroll
                for (int bj = 0; bj < 2; ++bj) { const int n0 = u.pn * 256 + bj * 128 + wc * 32 + 8 * fq;
                    f32x4 v0 = acc[ai][bj][m][0], v1 = acc[ai][bj][m][1];
                    if (zhalf) {
#pragma unroll
                        for (int j = 0; j < 4; ++j) { v0[j] = siluf_(v0[j]); v1[j] = siluf_(v1[j]); } }
                    u32x4 w; w.x = pk2(v0[0], v0[1]); w.y = pk2(v0[2], v0[3]); w.z = pk2(v1[0], v1[1]); w.w = pk2(v1[2], v1[3]);
                    if (zhalf) *(u32x4*)(SZ + ((size_t)tok * 2048 + n0) * 2) = w;
                    else { const int g = n0 >> 4, p0 = n0 & 15;
                        if (tok < RL) { const int b = tok / SEQ, tt = tok % SEQ, col = b * NCHB + tt / TCH, t = tt % TCH;
                            *(u32x4*)(X + (size_t)g * XPLANE + ((size_t)col * XLD + t * 16 + p0) * 2) = w; }
                        else *(u32x4*)(UCTX + (size_t)g * (RC * 32) + (size_t)(tok - RL) * 32 + p0 * 2) = w; } } }
    }
};

struct ProbS {
    static constexpr bool PERM = false; static constexpr int NSEG = 1;
    const char* X; const char* M2; float* S;
    __host__ __device__ int nt0() const { return TP / 64; } __host__ __device__ int nt() const { return TP / 64; }
    __host__ __device__ long a_bias(int) const { return 0; } __host__ __device__ long b_bias(int) const { return 0; }
    __host__ __device__ bool unit(int L, Unit& u) const { return order_g(L, NG, NCOL / 256, 1, u); }
    __host__ __device__ const char* a_base(const Unit& u, int) const { return X + (size_t)u.g * XPLANE + (size_t)u.pm * 256 * XLD * 2; }
    __host__ __device__ long a_off(int, int r, int k) const { return (long)r * XLD * 2 + k * 2; }
    __host__ __device__ const char* b_base(const Unit& u, int) const { return M2 + (size_t)u.g * 256 * TP * 2; }
    __host__ __device__ long b_off(int, int c, int k) const { return (long)c * TP * 2 + k * 2; }
    __device__ __forceinline__ void epi(Acc& acc, const Unit& u, int wr, int wc, int fr, int fq, LAS unsigned char*) const {
#pragma unroll
        for (int ai = 0; ai < 2; ++ai)
#pragma unroll
            for (int m = 0; m < 4; ++m) { const int col = u.pm * 256 + ai * 128 + wr * 64 + m * 16 + fr;
                float* rowp = S + ((size_t)u.g * NCOL + col) * 256 + wc * 32 + 4 * fq;
#pragma unroll
                for (int bj = 0; bj < 2; ++bj)
#pragma unroll
                    for (int n = 0; n < 2; ++n) *(f32x4*)(rowp + bj * 128 + n * 16) = acc[ai][bj][m][n]; }
    }
};

struct ProbY {
    static constexpr bool PERM = true; static constexpr int NSEG = 2;
    const char* X; const char* KR; const char* M4; char* Gout;
    __host__ __device__ int nt0() const { return TP / 64; } __host__ __device__ int nt() const { return XLD / 64; }
    __host__ __device__ long a_bias(int) const { return 0; } __host__ __device__ long b_bias(int seg) const { return seg ? 0 : 96; }
    __host__ __device__ bool unit(int L, Unit& u) const { return order_g(L, NG, NCOL / 256, TP / 256, u); }
    __host__ __device__ const char* a_base(const Unit& u, int seg) const { return X + (size_t)u.g * XPLANE + (size_t)u.pm * 256 * XLD * 2 + (seg ? TP * 2 : 0); }
    __host__ __device__ long a_off(int, int r, int k) const { return (long)r * XLD * 2 + k * 2; }
    __host__ __device__ const char* b_base(const Unit& u, int seg) const {
        return seg ? M4 + (size_t)u.g * TP * 512 + (size_t)u.pn * 256 * 512 : KR + (size_t)u.g * KRG * 2 + (size_t)(TCH - 1 - 16 * u.pn) * 32; }
    __host__ __device__ long b_off(int seg, int c, int k) const { return seg ? (long)c * 512 + k * 2 : ((long)(c & 15) * PSTR - (long)(c >> 4) * 16 + k) * 2; }
    __device__ __forceinline__ void epi(Acc& acc, const Unit& u, int wr, int wc, int fr, int fq, LAS unsigned char*) const {
#pragma unroll
        for (int ai = 0; ai < 2; ++ai)
#pragma unroll
            for (int m = 0; m < 4; ++m) { const int col = u.pm * 256 + ai * 128 + wr * 64 + m * 16 + fr;
#pragma unroll
                for (int bj = 0; bj < 2; ++bj) { const int n0 = u.pn * 256 + bj * 128 + wc * 32 + 8 * fq;
                    const f32x4 v0 = acc[ai][bj][m][0], v1 = acc[ai][bj][m][1];
                    u32x4 w; w.x = pk2(gelu_tanh(v0[0]), gelu_tanh(v0[1])); w.y = pk2(gelu_tanh(v0[2]), gelu_tanh(v0[3]));
                    w.z = pk2(gelu_tanh(v1[0]), gelu_tanh(v1[1])); w.w = pk2(gelu_tanh(v1[2]), gelu_tanh(v1[3]));
                    *(u32x4*)(Gout + (size_t)u.g * GPLANE + ((size_t)col * TP + n0) * 2) = w; } }
    }
};

struct ProbG4 {
    static constexpr bool PERM = true; static constexpr int NSEG = 1;
    const char* Gin; const char* WG; const char* SZ; const float* bglu; char* A4;
    __host__ __device__ int nt0() const { return 32; } __host__ __device__ int nt() const { return 32; }
    __host__ __device__ long a_bias(int) const { return 0; } __host__ __device__ long b_bias(int) const { return 0; }
    __host__ __device__ bool unit(int L, Unit& u) const { return order_mn(L, RL / 256, 8, u); }
    __host__ __device__ const char* a_base(const Unit& u, int) const { return Gin + (size_t)u.pm * 256 * 32; }
    __host__ __device__ long a_off(int, int r, int k) const { return (long)(k >> 4) * (long)GPLANE + (long)r * 32 + (k & 15) * 2; }
    __host__ __device__ const char* b_base(const Unit& u, int) const { return WG + (size_t)u.pn * 256 * 4096; }
    __host__ __device__ long b_off(int, int c, int k) const { return (long)c * 4096 + k * 2; }
    __device__ __forceinline__ void epi(Acc& acc, const Unit& u, int wr, int wc, int fr, int fq, LAS unsigned char*) const {
#pragma unroll
        for (int bj = 0; bj < 2; ++bj) { const int n0 = u.pn * 256 + bj * 128 + wc * 32 + 8 * fq;
            const f32x4 b0 = *(const f32x4*)(bglu + n0), b1 = *(const f32x4*)(bglu + n0 + 4);
#pragma unroll
            for (int ai = 0; ai < 2; ++ai)
#pragma unroll
                for (int m = 0; m < 4; ++m) { const int tok = u.pm * 256 + ai * 128 + wr * 64 + m * 16 + fr;
                    const u32x4 gv = *(const u32x4*)(Gin + (size_t)(n0 >> 4) * GPLANE + (size_t)tok * 32 + (n0 & 15) * 2);
                    const u32x4 sv = *(const u32x4*)(SZ + ((size_t)tok * 2048 + n0) * 2);
                    const f32x4 v0 = acc[ai][bj][m][0] + b0, v1 = acc[ai][bj][m][1] + b1;
                    float o[8];
#pragma unroll
                    for (int i = 0; i < 4; ++i) { const float g0 = bf2f(gv[i]), g1 = bf2f(gv[i] >> 16), s0 = bf2f(sv[i]), s1 = bf2f(sv[i] >> 16);
                        const float a0 = (2 * i < 4) ? v0[2 * i] : v1[2 * i - 4], a1 = (2 * i + 1 < 4) ? v0[2 * i + 1] : v1[2 * i + 1 - 4];
                        o[2 * i] = g0 * sigmoidf_(a0) * s0; o[2 * i + 1] = g1 * sigmoidf_(a1) * s1; }
                    u32x4 w; w.x = pk2(o[0], o[1]); w.y = pk2(o[2], o[3]); w.z = pk2(o[4], o[5]); w.w = pk2(o[6], o[7]);
                    *(u32x4*)(A4 + (size_t)(n0 >> 6) * A4PLANE + (size_t)tok * 128 + (n0 & 63) * 2) = w; } }
    }
};

struct ProbG5 {
    static constexpr bool PERM = false; static constexpr int NSEG = 1;
    const char* A4; const char* W5; const float* mod; float* out;
    __host__ __device__ int nt0() const { return 32; } __host__ __device__ int nt() const { return 32; }
    __host__ __device__ long a_bias(int) const { return 0; } __host__ __device__ long b_bias(int) const { return 0; }
    __host__ __device__ bool unit(int L, Unit& u) const { return order_mn(L, RL / 256, 4, u); }
    __host__ __device__ const char* a_base(const Unit& u, int) const { return A4 + (size_t)u.pm * 256 * 128; }
    __host__ __device__ long a_off(int, int r, int k) const { return (long)r * 128 + (long)(k >> 6) * (long)A4PLANE + (k & 63) * 2; }
    __host__ __device__ const char* b_base(const Unit& u, int) const { return W5 + (size_t)u.pn * 256 * 4096; }
    __host__ __device__ long b_off(int, int c, int k) const { return (long)c * 4096 + k * 2; }
    __device__ __forceinline__ void epi(Acc& acc, const Unit& u, int wr, int wc, int fr, int fq, LAS unsigned char*) const {
        const int rho = u.pm >> 6, col0 = u.pn * 256 + wc * 32 + 4 * fq;
        f32x4 gt[2][2];
#pragma unroll
        for (int bj = 0; bj < 2; ++bj)
#pragma unroll
            for (int n = 0; n < 2; ++n) gt[bj][n] = *(const f32x4*)(mod + (3 + rho) * 3072 + 2048 + col0 + bj * 128 + n * 16);
#pragma unroll
        for (int ai = 0; ai < 2; ++ai)
#pragma unroll
            for (int m = 0; m < 4; ++m) { float* rowp = out + (size_t)(u.pm * 256 + ai * 128 + wr * 64 + m * 16 + fr) * D + col0;
#pragma unroll
                for (int bj = 0; bj < 2; ++bj)
#pragma unroll
                    for (int n = 0; n < 2; ++n) { const f32x4 xv = *(const f32x4*)(rowp + bj * 128 + n * 16);
                        *(f32x4*)(rowp + bj * 128 + n * 16) = DN_ALPHA * xv + gt[bj][n] * acc[ai][bj][m][n]; } }
    }
};
}

struct Frame {
    LAS unsigned char* lds;
    int tid, lane, wave, G, bid;
    const float* in[23]; float* out; unsigned char* ws;
};

template <class RM>
__device__ __forceinline__ void transpose_item(const float* W, int K, int N, bf16* WT, LAS float* scr, int item, int lane, RM rowmap) {
    const int nblk = N / 32, kb = item / nblk, nb = item % nblk, k0 = 64 * kb, n0 = 32 * nb;
#pragma unroll 8
    for (int i = 0; i < 32; ++i) { const int kk = 2 * i + (lane >> 5); scr[kk * 33 + (lane & 31)] = W[(size_t)(k0 + kk) * N + n0 + (lane & 31)]; }
    LDS_WAIT(); asm volatile("" ::: "memory");
    const int c = lane & 7;
#pragma unroll
    for (int j = 0; j < 4; ++j) { const int n = (lane >> 3) + 8 * j; const LAS float* s = scr + (8 * c) * 33 + n;
        u32x4 o; o.x = pk2(s[0 * 33], s[1 * 33]); o.y = pk2(s[2 * 33], s[3 * 33]); o.z = pk2(s[4 * 33], s[5 * 33]); o.w = pk2(s[6 * 33], s[7 * 33]);
        *(u32x4*)(WT + (size_t)rowmap(n0 + n) * K + k0 + 8 * c) = o; }
    LDS_WAIT(); asm volatile("" ::: "memory");
}
struct RowId { __device__ int operator()(int n) const { return n; } };
struct RowW1 { __device__ int operator()(int n) const { const int p = n >> 11, chg = n & 2047, nt = chg >> 6, ch = chg & 63; return nt * 256 + 128 * (p >> 1) + 16 * (p & 1) + 32 * (ch >> 4) + (ch & 15); } };

__device__ __forceinline__ void phase_prep(Frame& F) {
    LAS float* fl = (LAS float*)F.lds;
    const int tid = F.tid;
    for (int item = F.bid; item < 2 * NG; item += F.G) {
        const int g = item >> 1, r = item & 1;
        LAS float* Av = fl; LAS float* Fv = fl + 256; LAS float* BBs = fl + 512; LAS float* Cs = fl + 4608; LAS float* PW = fl + 8768;
        __syncthreads();
        if (tid < 128) { const int rr = tid >> 6, n = tid & 63;
            const float dt = expf(F.in[I_LSTEP][rr * NG + g]);
            const float lre = F.in[I_LRE][(rr * NG + g) * 64 + n], lim = F.in[I_LIM][(rr * NG + g) * 64 + n];
            const float mag = expf(lre * dt); float sn, cs; sincosf(lim * dt, &sn, &cs);
            const float ar = mag * cs, ai = mag * sn, qr = ar - 1.0f, qi = ai, den = lre * lre + lim * lim;
            Av[(rr * 64 + n) * 2] = ar; Av[(rr * 64 + n) * 2 + 1] = ai;
            Fv[(rr * 64 + n) * 2] = (qr * lre + qi * lim) / den; Fv[(rr * 64 + n) * 2 + 1] = (qi * lre - qr * lim) / den;
            if (rr == r) { const float magT = expf(lre * dt * (float)TCH); float snT, csT; sincosf(lim * dt * (float)TCH, &snT, &csT);
                float* za = (float*)(F.ws + WS_ZA) + ((size_t)(r * NG + g) * 64 + n) * 4; za[0] = ar; za[1] = ai; za[2] = magT * csT; za[3] = magT * snT; } }
        __syncthreads();
        for (int e = tid; e < 2 * 64 * 16; e += 512) { const int rr = e >> 10, n = (e >> 4) & 63, q = e & 15;
            const float bre = F.in[I_BRE][((size_t)(rr * NG + g) * 64 + n) * 16 + q], bim = F.in[I_BIM][((size_t)(rr * NG + g) * 64 + n) * 16 + q];
            const float fr_ = Fv[(rr * 64 + n) * 2], fi_ = Fv[(rr * 64 + n) * 2 + 1];
            const float bbr = fr_ * bre - fi_ * bim, bbi = fr_ * bim + fi_ * bre;
            BBs[e * 2] = bbr; BBs[e * 2 + 1] = bbi;
            if (rr == r) { float* bg = (float*)(F.ws + WS_BBG) + (((size_t)(r * NG + g) * 64 + n) * 16 + q) * 2; bg[0] = bbr; bg[1] = bbi; }
            const int p = (e >> 6) & 15, nn = e & 63;
            Cs[((rr * 16 + p) * 65 + nn) * 2] = F.in[I_CRE][((size_t)(rr * NG + g) * 16 + p) * 64 + nn];
            Cs[((rr * 16 + p) * 65 + nn) * 2 + 1] = F.in[I_CIM][((size_t)(rr * NG + g) * 16 + p) * 64 + nn]; }
        { const float dt = expf(F.in[I_LSTEP][r * NG + g]);
          for (int e = tid; e < 64 * 65; e += 512) { const int n = e / 65, ee = e % 65;
            const float lre = F.in[I_LRE][(r * NG + g) * 64 + n], lim = F.in[I_LIM][(r * NG + g) * 64 + n];
            const float mg = expf(lre * dt * (float)ee); float sn, cs; sincosf(lim * dt * (float)ee, &sn, &cs);
            PW[e * 2] = mg * cs; PW[e * 2 + 1] = mg * sn; } }
        __syncthreads();
        { bf16* M2g = (bf16*)(F.ws + WS_M2) + (size_t)g * 256 * TP;
          const int k = tid * 2, s = k >> 4, q = k & 15, e = r ? s : (TCH - 1 - s);
          for (int j = 0; j < 128; ++j) { const int cc = j >> 6, n = j & 63;
            const float pr = PW[(n * 65 + e) * 2], pi = PW[(n * 65 + e) * 2 + 1];
            const float b0r = BBs[((r * 64 + n) * 16 + q) * 2], b0i = BBs[((r * 64 + n) * 16 + q) * 2 + 1], b1r = BBs[((r * 64 + n) * 16 + q + 1) * 2], b1i = BBs[((r * 64 + n) * 16 + q + 1) * 2 + 1];
            const float v0 = cc ? (pr * b0i + pi * b0r) : (pr * b0r - pi * b0i), v1 = cc ? (pr * b1i + pi * b1r) : (pr * b1r - pi * b1i);
            *(unsigned*)(M2g + (size_t)(r * 128 + j) * TP + k) = pk2(v0, v1); } }
        { bf16* M4g = (bf16*)(F.ws + WS_M4) + (size_t)g * TP * 256;
          const int jj = (tid & 63) * 2, cc = jj >> 6, n = jj & 63;
          for (int row = tid >> 6; row < TP; row += 8) { const int t = row >> 4, p = row & 15, e = r ? (TCH - t) : (t + 1);
            float v[2];
#pragma unroll
            for (int i = 0; i < 2; ++i) { const float cr = Cs[((r * 16 + p) * 65 + n + i) * 2], ci = Cs[((r * 16 + p) * 65 + n + i) * 2 + 1], pr = PW[((n + i) * 65 + e) * 2], pi = PW[((n + i) * 65 + e) * 2 + 1];
                v[i] = cc ? -(cr * pi + ci * pr) : (cr * pr - ci * pi); }
            *(unsigned*)(M4g + (size_t)row * 256 + r * 128 + jj) = pk2(v[0], v[1]); } }
        { bf16* KRg = (bf16*)(F.ws + WS_KR) + (size_t)g * KRG;
          const int el = tid >> 6, p = (tid >> 2) & 15, qb = tid & 3;
          for (int jx = el; jx < TCH; jx += 8) {
            int j, e; if (r == 0) { j = jx; e = TCH - 1 - jx; } else { if (jx == 0) continue; j = TCH - 1 + jx; e = jx; }
            float a4[4] = {0.f, 0.f, 0.f, 0.f};
            for (int n = 0; n < 64; ++n) { const float cr = Cs[((r * 16 + p) * 65 + n) * 2], ci = Cs[((r * 16 + p) * 65 + n) * 2 + 1], pr = PW[(n * 65 + e) * 2], pi = PW[(n * 65 + e) * 2 + 1];
                const float wr_ = cr * pr - ci * pi, wi_ = cr * pi + ci * pr;
#pragma unroll
                for (int q = 0; q < 4; ++q) a4[q] += wr_ * BBs[((r * 64 + n) * 16 + qb * 4 + q) * 2] - wi_ * BBs[((r * 64 + n) * 16 + qb * 4 + q) * 2 + 1]; }
            if (r == 0 && e == 0) {
                for (int n = 0; n < 64; ++n) { const float cr = Cs[((16 + p) * 65 + n) * 2], ci = Cs[((16 + p) * 65 + n) * 2 + 1];
#pragma unroll
                    for (int q = 0; q < 4; ++q) a4[q] += cr * BBs[((64 + n) * 16 + qb * 4 + q) * 2] - ci * BBs[((64 + n) * 16 + qb * 4 + q) * 2 + 1]; }
#pragma unroll
                for (int q = 0; q < 4; ++q) if (qb * 4 + q == p) a4[q] += F.in[I_SD][g * 16 + p]; }
            u32x2 w; w.x = pk2(a4[0], a4[1]); w.y = pk2(a4[2], a4[3]);
            *(u32x2*)(KRg + (size_t)p * PSTR + j * 16 + qb * 4) = w; }
          if (r == 1 && tid < 64) { const int p2 = tid >> 2, q4 = tid & 3; *(u32x2*)(KRg + (size_t)p2 * PSTR + (2 * TCH - 1) * 16 + q4 * 4) = (u32x2){0u, 0u}; } }
    }
    __syncthreads();
    {   LAS float* sc = fl;
        for (int e = tid; e < 3 * D; e += 512) { const int rho = e >> 10, k = e & 1023; const float v = rho < 2 ? F.in[I_C][rho * D + k] : F.in[I_CCTX][k]; sc[e] = siluf_(v); }
        __syncthreads();
        LAS float* red = fl + 3 * D;
        for (int item = F.bid; item < 2 * 96; item += F.G) {
            const int layer = item / 96, n0 = (item % 96) * 32, kk = tid >> 5, nn = tid & 31;
            const float* w = F.in[I_ADAW] + (size_t)layer * D * 3072 + n0 + nn;
            float s0 = 0.f, s1 = 0.f, s2 = 0.f;
            for (int k = kk; k < D; k += 16) { const float wv = w[(size_t)k * 3072]; s0 += sc[k] * wv; s1 += sc[D + k] * wv; s2 += sc[2 * D + k] * wv; }
            red[(kk * 32 + nn) * 3] = s0; red[(kk * 32 + nn) * 3 + 1] = s1; red[(kk * 32 + nn) * 3 + 2] = s2;
            __syncthreads();
            if (tid < 96) { const int rho = tid >> 5, n = tid & 31; float s = 0.f;
                for (int k2 = 0; k2 < 16; ++k2) s += red[(k2 * 32 + n) * 3 + rho];
                ((float*)(F.ws + WS_MOD))[(layer * 3 + rho) * 3072 + n0 + n] = s + F.in[I_ADAB][layer * 3072 + n0 + n]; }
            __syncthreads();
        }
    }
    __syncthreads();
    {   LAS float* scr = (LAS float*)(F.lds + F.wave * 16384);
        const int gw = F.bid * 8 + F.wave, NGW = F.G * 8;
        constexpr int I1 = (1024 / 64) * (8192 / 32), I2 = (2048 / 64) * (1024 / 32), I3 = (1024 / 64) * (4096 / 32), I4 = (2048 / 64) * (2048 / 32), I5 = (2048 / 64) * (1024 / 32);
        for (int it = gw; it < I1 + I2 + I3 + I4 + I5; it += NGW) {
            int rI = it;
            if (rI < I1) { transpose_item(F.in[I_CWIN], 1024, 8192, (bf16*)(F.ws + WS_W1), scr, rI, F.lane, RowW1()); continue; } rI -= I1;
            if (rI < I2) { transpose_item(F.in[I_CWOUT], 2048, 1024, (bf16*)(F.ws + WS_W2), scr, rI, F.lane, RowId()); continue; } rI -= I2;
            if (rI < I3) { transpose_item(F.in[I_SWIN], 1024, 4096, (bf16*)(F.ws + WS_W3), scr, rI, F.lane, RowId()); continue; } rI -= I3;
            if (rI < I4) { transpose_item(F.in[I_WGLU], 2048, 2048, (bf16*)(F.ws + WS_WG), scr, rI, F.lane, RowId()); continue; } rI -= I4;
            transpose_item(F.in[I_SWOUT], 2048, 1024, (bf16*)(F.ws + WS_W5), scr, rI, F.lane, RowId());
        }
    }
}

__device__ __forceinline__ void store_row_blk64(char* base, size_t row, int lane, const f32x4 (&v)[4]) {
#pragma unroll
    for (int j = 0; j < 4; ++j) { const int kb = 4 * j + (lane >> 4), col = 4 * (lane & 15);
        u32x2 w; w.x = pk2(v[j][0], v[j][1]); w.y = pk2(v[j][2], v[j][3]);
        *(u32x2*)(base + (size_t)kb * HXPLANE + row * 128 + col * 2) = w; }
}
__device__ __forceinline__ void phase_mod0(Frame& F) {
    const int gw = F.bid * 8 + F.wave, NGW = F.G * 8; const float* mod = (const float*)(F.ws + WS_MOD);
    for (int row = gw; row < RT; row += NGW) {
        const bool isctx = row >= RL; const int rho = isctx ? 2 : row / SEQ;
        const float* src = isctx ? F.in[I_CTX] + (size_t)(row - RL) * D : F.in[I_X] + (size_t)row * D;
        f32x4 v[4];
#pragma unroll
        for (int j = 0; j < 4; ++j) { const int idx = 256 * j + 4 * F.lane; const f32x4 xv = *(const f32x4*)(src + idx);
            const f32x4 sh = *(const f32x4*)(mod + rho * 3072 + idx), sc = *(const f32x4*)(mod + rho * 3072 + 1024 + idx);
            v[j] = xv * (1.0f + sc) + sh; }
        store_row_blk64((char*)F.ws + WS_HX, (size_t)row, F.lane, v);
        if (!isctx) { const int b = row / SEQ, t = row % SEQ; store_row_blk64((char*)F.ws + WS_HXV, (size_t)b * SEQ + (size_t)(t % GRIDW) * 256 + t / GRIDW, F.lane, v); }
    }
}
__device__ __forceinline__ void ln_row(f32x4 (&v)[4], const float* g, const float* b, int lane) {
    float s = 0.f;
#pragma unroll
    for (int j = 0; j < 4; ++j) s += (v[j][0] + v[j][1]) + (v[j][2] + v[j][3]);
    const float mean = wave_sum(s) * (1.f / D); float s2 = 0.f;
#pragma unroll
    for (int j = 0; j < 4; ++j) { v[j] = v[j] - mean; s2 += (v[j][0] * v[j][0] + v[j][1] * v[j][1]) + (v[j][2] * v[j][2] + v[j][3] * v[j][3]); }
    const float rstd = 1.0f / sqrtf(wave_sum(s2) * (1.f / D) + LN_EPS);
#pragma unroll
    for (int j = 0; j < 4; ++j) { const int idx = 256 * j + 4 * lane; v[j] = v[j] * rstd * *(const f32x4*)(g + idx) + *(const f32x4*)(b + idx); }
}
__device__ __forceinline__ void phase_ln_mod1(Frame& F) {
    const int gw = F.bid * 8 + F.wave, NGW = F.G * 8; const float* mod = (const float*)(F.ws + WS_MOD) + 3 * 3072;
    for (int row = gw; row < RT; row += NGW) {
        const bool isctx = row >= RL; const int rho = isctx ? 2 : row / SEQ;
        float* src = isctx ? (float*)(F.ws + WS_Y1C) + (size_t)(row - RL) * D : F.out + (size_t)row * D;
        f32x4 v[4];
#pragma unroll
        for (int j = 0; j < 4; ++j) v[j] = *(const f32x4*)(src + 256 * j + 4 * F.lane);
        ln_row(v, F.in[I_LNG], F.in[I_LNB], F.lane);
        if (!isctx) {
#pragma unroll
            for (int j = 0; j < 4; ++j) *(f32x4*)(src + 256 * j + 4 * F.lane) = v[j]; }
#pragma unroll
        for (int j = 0; j < 4; ++j) { const int idx = 256 * j + 4 * F.lane;
            const f32x4 sh = *(const f32x4*)(mod + rho * 3072 + idx), sc = *(const f32x4*)(mod + rho * 3072 + 1024 + idx);
            v[j] = v[j] * (1.0f + sc) + sh; }
        store_row_blk64((char*)F.ws + WS_HX, (size_t)row, F.lane, v);
    }
}
__device__ __forceinline__ void phase_ln_out(Frame& F) {
    const int gw = F.bid * 8 + F.wave, NGW = F.G * 8;
    for (int row = gw; row < RL; row += NGW) {
        float* src = F.out + (size_t)row * D;
        f32x4 v[4];
#pragma unroll
        for (int j = 0; j < 4; ++j) v[j] = *(const f32x4*)(src + 256 * j + 4 * F.lane);
        ln_row(v, F.in[I_LNG] + D, F.in[I_LNB] + D, F.lane);
#pragma unroll
        for (int j = 0; j < 4; ++j) *(f32x4*)(src + 256 * j + 4 * F.lane) = v[j];
    }
}
__device__ __forceinline__ void cmul_acc(float& hr, float& hi, float ar, float ai, float sr, float si) { const float nr = ar * hr - ai * hi + sr, ni = ar * hi + ai * hr + si; hr = nr; hi = ni; }
__device__ __forceinline__ void phase_scan(Frame& F) {
    const int n = F.lane, wq = F.wave & 3, ih = F.wave >> 2;
    LAS float* ex = (LAS float*)F.lds;
    for (int pair = F.bid; pair < NG * NBATCH; pair += F.G) {
        const int item = pair * 2 + ih, g = item >> 2, b = (item >> 1) & 1, r = item & 1;
        const f32x4 za = *(const f32x4*)((const float*)(F.ws + WS_ZA) + ((size_t)(r * NG + g) * 64 + n) * 4);
        const float ar = za[0], ai = za[1], aTr = za[2], aTi = za[3];
        float hr = 0.f, hi = 0.f;
        {   f32x4 bb[8];
            const f32x4* bp = (const f32x4*)((const float*)(F.ws + WS_BBG) + ((size_t)(r * NG + g) * 64 + n) * 32);
#pragma unroll
            for (int i = 0; i < 8; ++i) bb[i] = bp[i];
            const char* uc = (const char*)F.ws + WS_UCTX + (size_t)g * (RC * 32) + (size_t)b * CTXL * 32;
            for (int s0 = 0; s0 < 64; s0 += 8) {
                u32x4 u0[8], u1[8];
#pragma unroll
                for (int i = 0; i < 8; ++i) { const int s = 64 * wq + s0 + i, t = r ? (CTXL - 1 - s) : s; u0[i] = *(const u32x4*)(uc + t * 32); u1[i] = *(const u32x4*)(uc + t * 32 + 16); }
#pragma unroll
                for (int i = 0; i < 8; ++i) { float sr = 0.f, si = 0.f;
#pragma unroll
                    for (int q = 0; q < 8; ++q) { const unsigned w = q < 4 ? u0[i][q] : u1[i][q - 4]; const float ua = bf2f(w), ub = bf2f(w >> 16);
                        sr += bb[q][0] * ua + bb[q][2] * ub; si += bb[q][1] * ua + bb[q][3] * ub; }
                    cmul_acc(hr, hi, ar, ai, sr, si); } }
        }
        for (int k = wq; k < 3; ++k) cmul_acc(hr, hi, aTr, aTi, 0.f, 0.f);
        __syncthreads();
        ex[((ih * 4 + wq) * 64 + n) * 2] = hr; ex[((ih * 4 + wq) * 64 + n) * 2 + 1] = hi;
        __syncthreads();
        float h0r = 0.f, h0i = 0.f;
#pragma unroll
        for (int k = 0; k < 4; ++k) { h0r += ex[((ih * 4 + k) * 64 + n) * 2]; h0i += ex[((ih * 4 + k) * 64 + n) * 2 + 1]; }
        const float* Sg = (const float*)(F.ws + WS_S) + (size_t)g * NCOL * 256 + r * 128 + n;
        bf16* Xg = (bf16*)(F.ws + WS_X + (size_t)g * XPLANE) + TP + r * 128 + n;
        float sre[64], sim[64];
#pragma unroll
        for (int i = 0; i < 64; ++i) { const int sp = 64 * wq + i, col = b * NCHB + (r ? (NCHB - 1 - sp) : sp); sre[i] = Sg[(size_t)col * 256]; sim[i] = Sg[(size_t)col * 256 + 64]; }
        float er = 0.f, ei = 0.f;
#pragma unroll
        for (int i = 0; i < 64; ++i) cmul_acc(er, ei, aTr, aTi, sre[i], sim[i]);
        float qr = aTr, qi = aTi;
#pragma unroll
        for (int k = 0; k < 6; ++k) { const float nr = qr * qr - qi * qi, ni = 2.f * qr * qi; qr = nr; qi = ni; }
        __syncthreads();
        ex[((ih * 4 + wq) * 64 + n) * 2] = er; ex[((ih * 4 + wq) * 64 + n) * 2 + 1] = ei;
        __syncthreads();
        hr = h0r; hi = h0i;
        for (int k = 0; k < wq; ++k) cmul_acc(hr, hi, qr, qi, ex[((ih * 4 + k) * 64 + n) * 2], ex[((ih * 4 + k) * 64 + n) * 2 + 1]);
#pragma unroll
        for (int i = 0; i < 64; ++i) { const int sp = 64 * wq + i, col = b * NCHB + (r ? (NCHB - 1 - sp) : sp);
            Xg[(size_t)col * XLD] = (bf16)f2bf(hr); Xg[(size_t)col * XLD + 64] = (bf16)f2bf(hi);
            cmul_acc(hr, hi, aTr, aTi, sre[i], sim[i]); }
    }
}

constexpr int N_PHASES = 13;
template <class P> __device__ __forceinline__ void run_gemm(Frame& F, const P& p, int bit) {
    if ((NAIVE_MASK >> bit) & 1) g8::gemm_phase_naive<P>(F.lds, p, F.G, F.bid); else g8::gemm_phase<P>(F.lds, p, F.G, F.bid);
}
__global__ void __launch_bounds__(512, 2) mk_fwd(Args args) {
    extern __shared__ __attribute__((aligned(16))) unsigned char lds_raw[];
    Frame F;
    F.lds = (LAS unsigned char*)lds_raw;
    F.tid = threadIdx.x; F.lane = F.tid & 63; F.wave = __builtin_amdgcn_readfirstlane(F.tid >> 6); F.G = gridDim.x; F.bid = blockIdx.x;
#pragma unroll
    for (int i = 0; i < 23; ++i) F.in[i] = args.in[i];
    F.out = args.out; F.ws = args.ws;
    volatile LAS unsigned* MISC = (volatile LAS unsigned*)(F.lds + MISC_OFF);
    if (F.tid < 32) MISC[F.tid] = 0u;
    __syncthreads();
    XcdBarrier bar; bar.bar = (unsigned*)(F.ws + WS_CTL) + CW_BAR; bar.x = 0; bar.st = nullptr;
    if (MK_N_LAUNCHES == 1) bar = xcd_barrier_post((unsigned*)(F.ws + WS_CTL) + CW_BAR, MISC + 8);
    const int lo = args.ph_lo, hi = args.ph_hi;
#define IN(k) (lo <= (k) && (k) < hi)
#define REP(k) for (int rep_ = 0; rep_ < 1 + ((k) == PROBE_REP_PHASE ? PROBE_REP_N : 0); ++rep_)
#define SEAM(k) do { if (IN(k) && IN((k) + 1)) xcd_barrier(bar); } while (0)
    unsigned char* ws = F.ws; const float* mod = (const float*)(ws + WS_MOD);
    if (IN(0)) REP(0) { phase_prep(F); } SEAM(0);
    if (IN(1)) REP(1) { phase_mod0(F); } SEAM(1);
    if (IN(2)) REP(2) { g8::ProbG1 p{(const char*)ws + WS_HX, (const char*)ws + WS_HXV, (const char*)ws + WS_W1, F.in[I_CW], (char*)ws + WS_A2}; run_gemm(F, p, 0); } SEAM(2);
    if (IN(3)) REP(3) { g8::ProbG2 p{(const char*)ws + WS_A2, (const char*)ws + WS_W2, F.in[I_X], F.in[I_CTX], mod, F.out, (float*)(ws + WS_Y1C)}; run_gemm(F, p, 1); } SEAM(3);
    if (IN(4)) REP(4) { phase_ln_mod1(F); } SEAM(4);
    if (IN(5)) REP(5) { g8::ProbG3 p{(const char*)ws + WS_HX, (const char*)ws + WS_W3, (char*)ws + WS_X, (char*)ws + WS_UCTX, (char*)ws + WS_SZ, 0}; run_gemm(F, p, 2); } SEAM(5);
    if (IN(6)) REP(6) { g8::ProbS p{(const char*)ws + WS_X, (const char*)ws + WS_M2, (float*)(ws + WS_S)}; run_gemm(F, p, 3); } SEAM(6);
    if (IN(7)) REP(7) { phase_scan(F); } SEAM(7);
    if (IN(8)) REP(8) { g8::ProbY p{(const char*)ws + WS_X, (const char*)ws + WS_KR, (const char*)ws + WS_M4, (char*)ws + WS_G}; run_gemm(F, p, 4); } SEAM(8);
    if (IN(9)) REP(9) { g8::ProbG3 p{(const char*)ws + WS_HX, (const char*)ws + WS_W3, (char*)ws + WS_X, (char*)ws + WS_UCTX, (char*)ws + WS_SZ, 1}; run_gemm(F, p, 5); } SEAM(9);
    if (IN(10)) REP(10) { g8::ProbG4 p{(const char*)ws + WS_G, (const char*)ws + WS_WG, (const char*)ws + WS_SZ, F.in[I_BGLU], (char*)ws + WS_A4}; run_gemm(F, p, 6); } SEAM(10);
    if (IN(11)) REP(11) { g8::ProbG5 p{(const char*)ws + WS_A4, (const char*)ws + WS_W5, mod, F.out}; run_gemm(F, p, 7); } SEAM(11);
    if (IN(12)) REP(12) { phase_ln_out(F); }
#undef IN
#undef SEAM
}

extern "C" void kernel_launch(void* const* d_in, const int* in_sizes, int n_in, void* d_out, int out_size, void* d_ws, size_t ws_size, hipStream_t stream) {
    static int grid = 0;
    if (grid == 0) {
        if (n_in != 23 || in_sizes[0] != RL * D || out_size != RL * D || ws_size < WS_END) { fprintf(stderr, "kernel_launch: unexpected shapes (n_in %d, in0 %d, out %d, ws %zu); nothing launched\n", n_in, n_in > 0 ? in_sizes[0] : -1, out_size, ws_size); grid = -1; return; }
        int dev = 0, cus = 0, per_cu = 0;
        if (hipGetDevice(&dev) != hipSuccess || hipDeviceGetAttribute(&cus, hipDeviceAttributeMultiprocessorCount, dev) != hipSuccess) { grid = -1; return; }
        if (hipFuncSetAttribute((const void*)mk_fwd, hipFuncAttributeMaxDynamicSharedMemorySize, LDS_BYTES) != hipSuccess) { fprintf(stderr, "kernel_launch: hipFuncSetAttribute failed\n"); grid = -1; return; }
        if (hipOccupancyMaxActiveBlocksPerMultiprocessor(&per_cu, (const void*)mk_fwd, 512, LDS_BYTES) != hipSuccess || per_cu < 1) { fprintf(stderr, "kernel_launch: occupancy query says %d\n", per_cu); per_cu = 1; }
        (void)hipGetLastError();
        grid = cus * 1;
        if (per_cu < 1) grid = -1;
    }
    if (grid < 0) return;
    (void)hipMemsetAsync((char*)d_ws + WS_CTL, 0, CTL_ZERO_BYTES, stream);
    Args a{};
    for (int i = 0; i < 23; ++i) a.in[i] = (const float*)d_in[i];
    a.out = (float*)d_out; a.ws = (unsigned char*)d_ws;
    if (MK_N_LAUNCHES == 1) {
        a.ph_lo = 0; a.ph_hi = N_PHASES;
        void* kargs[] = {&a};
        hipError_t e = hipLaunchCooperativeKernel((const void*)mk_fwd, dim3(grid), dim3(512), kargs, LDS_BYTES, stream);
        if (e != hipSuccess) fprintf(stderr, "kernel_launch: cooperative launch failed: %s (grid %d)\n", hipGetErrorString(e), grid);
    } else {
        for (int ph = 0; ph < N_PHASES; ++ph) { a.ph_lo = ph; a.ph_hi = ph + 1; hipLaunchKernelGGL(mk_fwd, dim3(grid), dim3(512), LDS_BYTES, stream, a); }
    }
}
```

```cpp
#include <hip/hip_runtime.h>
#include <cstdio>
#include <cstdint>

#ifndef MK_N_LAUNCHES
#define MK_N_LAUNCHES 1
#endif
#ifndef NAIVE_MASK
#define NAIVE_MASK 0
#endif

#ifndef PROBE_REP_PHASE
#define PROBE_REP_PHASE -1
#define PROBE_REP_N 0
#endif
#define GAS __attribute__((address_space(1)))
#define LAS __attribute__((address_space(3)))
typedef unsigned short bf16;
typedef short bf16x8 __attribute__((ext_vector_type(8)));
typedef float f32x4 __attribute__((ext_vector_type(4)));
typedef float f32x2 __attribute__((ext_vector_type(2)));
typedef unsigned u32x4 __attribute__((ext_vector_type(4)));
typedef unsigned u32x2 __attribute__((ext_vector_type(2)));

constexpr int D = 1024, NBATCH = 2, SEQ = 16384, CTXL = 256, GRIDW = 64, EW = 2048, NG = 128, NST = 64, PG = 16;
constexpr int RL = NBATCH * SEQ;
constexpr int RC = NBATCH * CTXL;
constexpr int RT = RL + RC;
constexpr int TCH = 64;
constexpr int TP = TCH * PG;
constexpr int XLD = TP + 4 * NST;
constexpr int NCHB = SEQ / TCH;
constexpr int NCOL = NBATCH * NCHB;
constexpr int PSTR = 2 * TCH * PG;
constexpr int KRG = PG * PSTR;
constexpr float LN_EPS = 1e-5f;
constexpr float DN_ALPHA = 1.41421356237f;

constexpr size_t MiB = 1u << 20;
constexpr size_t WS_CTL = 0, CTL_ZERO_BYTES = 1 * MiB;
constexpr size_t WS_MOD = 1 * MiB;
constexpr size_t WS_ZA = 1 * MiB + 256 * 1024;
constexpr size_t WS_BBG = 2 * MiB;
constexpr size_t WS_WG = 6 * MiB, WS_W5 = 14 * MiB, WS_W3 = 18 * MiB;
constexpr size_t WS_KR = 26 * MiB;
constexpr size_t WS_M4 = 34 * MiB;
constexpr size_t WS_HX = 98 * MiB;
constexpr size_t WS_X = 163 * MiB;
constexpr size_t WS_A2 = 163 * MiB;
constexpr size_t WS_SZ = 195 * MiB;
constexpr size_t WS_M2 = 323 * MiB;
constexpr size_t WS_G = 323 * MiB;
constexpr size_t WS_S = 387 * MiB;
constexpr size_t WS_HXV = 387 * MiB;
constexpr size_t WS_UCTX = 452 * MiB;
constexpr size_t WS_W1 = 454 * MiB, WS_W2 = 470 * MiB;
constexpr size_t WS_Y1S = 294 * MiB;
constexpr size_t WS_UCS = 454 * MiB;
constexpr size_t WS_A4 = 34 * MiB;
constexpr size_t WS_END = 476 * MiB;
constexpr size_t HXPLANE = (size_t)RT * 128;
constexpr size_t A4PLANE = (size_t)RL * 128;
constexpr size_t GPLANE = (size_t)RL * 32;
constexpr size_t XPLANE = (size_t)NCOL * XLD * 2;
static_assert(WS_X + (size_t)NG * XPLANE <= WS_M2 && WS_A2 + 32 * HXPLANE <= WS_M2, "map");
static_assert(WS_HX + 16 * HXPLANE <= WS_X && WS_HXV + 16 * HXPLANE <= WS_UCTX + 2 * MiB && WS_S + (size_t)NG * NCOL * 256 * 4 <= WS_UCTX, "map");
static_assert(WS_G + (size_t)NG * GPLANE <= WS_UCTX && WS_SZ + (size_t)RL * 2048 * 2 <= WS_G && WS_A4 + 32 * A4PLANE <= WS_X, "map");
static_assert(WS_M4 + (size_t)NG * TP * 256 * 2 <= WS_HX && WS_KR + (size_t)NG * KRG * 2 <= WS_M4 && WS_M2 + (size_t)NG * 256 * TP * 2 <= WS_S, "map");
constexpr int CW_BAR = 4096;

constexpr int RING_BYTES = 131072;
constexpr int XL_OFF = RING_BYTES;
constexpr int XL_BYTES = 130 * 128;
constexpr int MISC_OFF = XL_OFF + XL_BYTES;
constexpr int LDS_BYTES = MISC_OFF + 128;

#define RLX_AGENT __ATOMIC_RELAXED, __HIP_MEMORY_SCOPE_AGENT
#define LDS_WAIT() asm volatile("s_waitcnt lgkmcnt(0)" ::: "memory")
#define VM_WAIT() asm volatile("s_waitcnt vmcnt(0)" ::: "memory")
__host__ __device__ __forceinline__ unsigned f2bf(float f) { unsigned u = __builtin_bit_cast(unsigned, f); return (u + 0x7fffu + ((u >> 16) & 1u)) >> 16; }
typedef __bf16 bf16x2_t __attribute__((ext_vector_type(2)));
__host__ __device__ __forceinline__ unsigned pk2(float lo, float hi) {
#if defined(__HIP_DEVICE_COMPILE__)
    const f32x2 v = {lo, hi}; return __builtin_bit_cast(unsigned, __builtin_convertvector(v, bf16x2_t));
#else
    return f2bf(lo) | (f2bf(hi) << 16);
#endif
}
__host__ __device__ __forceinline__ float bf2f(unsigned b) { return __builtin_bit_cast(float, (b & 0xffffu) << 16); }
__device__ __forceinline__ float sigmoidf_(float x) { return __builtin_amdgcn_rcpf(1.0f + __expf(-x)); }
__device__ __forceinline__ float siluf_(float x) { return x * sigmoidf_(x); }
__device__ __forceinline__ float gelu_tanh(float x) { return x * sigmoidf_(1.5957691216f * (x + 0.044715f * x * x * x)); }
__device__ __forceinline__ float wave_sum(float v) {
#pragma unroll
    for (int o = 1; o < 64; o <<= 1) v += __shfl_xor(v, o);
    return v;
}

#define XB_TMO      128
#define XB_XCNT(j)  (256  + 64 * (j))
#define XB_XSUB(j)  (1280 + 64 * (j))
#define XB_XGEN(j)  (2304 + 64 * (j))
#define XB_TOP      3328
#define XB_TOPGEN   3392
#define XCD_BAR_WORDS 3456
#define XB_SPIN_CAP (1u << 20)
__device__ __forceinline__ unsigned xb_ld(unsigned* p)              { return __hip_atomic_load(p, __ATOMIC_RELAXED, __HIP_MEMORY_SCOPE_AGENT); }
__device__ __forceinline__ unsigned xb_add(unsigned* p, unsigned v) { return __hip_atomic_fetch_add(p, v, __ATOMIC_RELAXED, __HIP_MEMORY_SCOPE_AGENT); }
__device__ __forceinline__ unsigned xb_xcc_id() { return (unsigned)__builtin_amdgcn_s_getreg((3 << 11) | 20) & 0xFu; }
#define XB_SPIN(cond, bar) do { unsigned _sp = 0; while (cond) { __builtin_amdgcn_s_sleep(1); \
    if ((++_sp & 255u) == 0u) { if (xb_ld(&(bar)[XB_TMO])) break; if (_sp > XB_SPIN_CAP) { atomicAdd(&(bar)[XB_TMO], 1u); break; } } } } while (0)
struct XcdBarrier { unsigned* bar; unsigned x; volatile LAS unsigned* st; };
__device__ __forceinline__ XcdBarrier xcd_barrier_post(unsigned* bar, volatile LAS unsigned* st) {
    XcdBarrier b; b.bar = bar; b.x = xb_xcc_id(); b.st = st;
    if (threadIdx.x == 0) (void)xb_add(&bar[XB_XCNT(b.x)], 1u);
    return b;
}
__device__ __forceinline__ void xcd_barrier_complete(unsigned* bar, unsigned x, unsigned& nloc, unsigned& nx) {
    const unsigned G = gridDim.x * gridDim.y * gridDim.z;
    unsigned sum, cnt, mine, sp = 0u;
    for (;;) {
        sum = 0u; cnt = 0u; mine = 0u;
#pragma unroll
        for (unsigned j = 0; j < 16; ++j) { const unsigned c = xb_ld(&bar[XB_XCNT(j)]); sum += c; cnt += (c > 0u) ? 1u : 0u; mine = (j == x) ? c : mine; }
        if (sum == G) break;
        __builtin_amdgcn_s_sleep(1);
        if ((++sp & 255u) == 0u) { if (xb_ld(&bar[XB_TMO])) break; if (sp > XB_SPIN_CAP) { atomicAdd(&bar[XB_TMO], 1u); break; } }
    }
    nloc = mine > 0u ? mine : 1u; nx = cnt > 0u ? cnt : 1u;
}
__device__ __forceinline__ void xcd_barrier(const XcdBarrier& b) {
    asm volatile("s_waitcnt vmcnt(0)" ::: "memory");
    __syncthreads();
    if (threadIdx.x == 0) {
        unsigned* bar = b.bar;
        __builtin_amdgcn_s_waitcnt(0);
        unsigned nloc = b.st[0], nx = b.st[1];
        if (nloc == 0u) { xcd_barrier_complete(bar, b.x, nloc, nx); b.st[0] = nloc; b.st[1] = nx; }
        const unsigned old = xb_add(&bar[XB_XSUB(b.x)], 1u);
        const unsigned gen = old / nloc;
        if (old + 1u == (gen + 1u) * nloc) {
            __builtin_amdgcn_fence(__ATOMIC_RELEASE, "agent");
            asm volatile("s_waitcnt vmcnt(0)" ::: "memory");
            const unsigned og = xb_add(&bar[XB_TOP], 1u);
            const unsigned tg = og / nx;
            if (og + 1u == (tg + 1u) * nx) xb_add(&bar[XB_TOPGEN], 1u);
            else XB_SPIN(xb_ld(&bar[XB_TOPGEN]) == tg, bar);
            __builtin_amdgcn_fence(__ATOMIC_ACQUIRE, "agent");
            xb_add(&bar[XB_XGEN(b.x)], 1u);
            asm volatile("s_waitcnt vmcnt(0)" ::: "memory");
        } else {
            XB_SPIN(xb_ld(&bar[XB_XGEN(b.x)]) == gen, bar);
            __builtin_amdgcn_fence(__ATOMIC_ACQUIRE, "agent");
            asm volatile("s_waitcnt vmcnt(0)" ::: "memory");
        }
    }
    __syncthreads();
}

struct Args {
    const float* in[23];
    float* out; unsigned char* ws;
    int ph_lo, ph_hi;
};
enum { I_X = 0, I_C, I_CTX, I_CCTX, I_ADAW, I_ADAB, I_LNG, I_LNB, I_CWIN, I_CW, I_CWOUT, I_SWIN, I_LRE, I_LIM, I_LSTEP, I_BRE, I_BIM, I_CRE, I_CIM, I_SD, I_WGLU, I_BGLU, I_SWOUT };

namespace g8 {
constexpr int BM = 256, BK = 64, HALF = 128, HTB = HALF * BK * 2, NXCD = 8, WGM = 8;
__host__ __device__ __forceinline__ int lds_byte(int r, int c) { const int st = (r >> 4) * 2 + (c >> 5), rr = r & 15, cc = c & 31, ob = rr * 64 + cc * 2; return st * 1024 + (ob ^ (((ob >> 9) & 1) << 5)); }
__host__ __device__ __forceinline__ void stage_rc(int b, int& R, int& C) { const int st = b / 1024, sb = b % 1024, swz = sb ^ (((sb >> 9) & 1) << 5); R = (st >> 1) * 16 + swz / 64; C = (st & 1) * 32 + (swz % 64) / 2; }
__host__ __device__ __forceinline__ int perm32(int rho) { const int n = rho >> 4, i = rho & 15; return 8 * (i >> 2) + 4 * n + (i & 3); }

struct Unit { int pm, pn, g, ks; };
__host__ __device__ __forceinline__ int xcd_remap(int L, int nwg) { const int q = nwg / NXCD, r = nwg % NXCD, xcd = L % NXCD, off = L / NXCD; return (xcd < r ? xcd * (q + 1) : r * (q + 1) + (xcd - r) * q) + off; }
__host__ __device__ __forceinline__ bool order_mn(int L, int nM, int nN, Unit& u) {
    const int nwg = nM * nN; if (L >= nwg) return false;
    const int wgid = xcd_remap(L, nwg);
    const int nig = WGM * nN, gid = wgid / nig, fm = gid * WGM, gsz = (nM - fm) < WGM ? (nM - fm) : WGM;
    u.pm = fm + ((wgid % nig) % gsz); u.pn = (wgid % nig) / gsz; u.g = 0; u.ks = 0; return true;
}
__host__ __device__ __forceinline__ bool order_g(int L, int ng, int nM, int nN, Unit& u) {
    const int per = nM * nN, nwg = ng * per; if (L >= nwg) return false;
    const int wgid = xcd_remap(L, nwg);
    u.g = wgid / per; const int rem = wgid % per; u.pm = rem / nN; u.pn = rem % nN; u.ks = 0; return true;
}

__device__ __forceinline__ unsigned cvt_pk_bf16(float lo, float hi) { unsigned r; asm volatile("v_cvt_pk_bf16_f32 %0, %1, %2" : "=v"(r) : "v"(lo), "v"(hi)); return r; }

typedef f32x4 Acc[2][2][4][2];

template <class P>
__device__ __forceinline__ void gemm_phase(LAS unsigned char* lds, const P& p, const int G, const int c) {
    const int tid = threadIdx.x, wid = __builtin_amdgcn_readfirstlane(tid >> 6), lane = tid & 63, wr = wid >> 2, wc = wid & 3, fr = lane & 15, fq = lane >> 4;
    constexpr int NS = P::NSEG; constexpr int S1 = NS - 1;
    const int nt0 = p.nt0();
    unsigned voffA0, voffA1, voffB0, voffB1;
    { int R, C; stage_rc(tid * 16, R, C); const int Rb = P::PERM ? ((R & ~31) + perm32(R & 31)) : R;
      voffA0 = (unsigned)(p.a_off(0, R, C) - p.a_off(0, 0, 0) + p.a_bias(0)); voffB0 = (unsigned)(p.b_off(0, Rb, C) - p.b_off(0, 0, 0) + p.b_bias(0));
      voffA1 = (unsigned)(p.a_off(S1, R, C) - p.a_off(S1, 0, 0) + p.a_bias(S1)); voffB1 = (unsigned)(p.b_off(S1, Rb, C) - p.b_off(S1, 0, 0) + p.b_bias(S1)); }
    const long r64A0 = p.a_off(0, 64, 0) - p.a_off(0, 0, 0), r64A1 = p.a_off(S1, 64, 0) - p.a_off(S1, 0, 0), r64B0 = p.b_off(0, 64, 0) - p.b_off(0, 0, 0), r64B1 = p.b_off(S1, 64, 0) - p.b_off(S1, 0, 0);
    const long hA0 = p.a_off(0, 128, 0) - p.a_off(0, 0, 0), hA1 = p.a_off(S1, 128, 0) - p.a_off(S1, 0, 0), hB0 = p.b_off(0, 128, 0) - p.b_off(0, 0, 0), hB1 = p.b_off(S1, 128, 0) - p.b_off(S1, 0, 0);
    const long ksA0 = p.a_off(0, 0, 64) - p.a_off(0, 0, 0), ksA1 = p.a_off(S1, 0, 64) - p.a_off(S1, 0, 0), ksB0 = p.b_off(0, 0, 64) - p.b_off(0, 0, 0), ksB1 = p.b_off(S1, 0, 64) - p.b_off(S1, 0, 0);
    const unsigned ldsw = (unsigned)wid * 1024u;
    const int aoff = lds_byte(wr * 64 + fr, fq * 8), boff = lds_byte(wc * 32 + fr, fq * 8);
#define G8_SA(b, h) (((b) * 2 + (h)) * HTB)
#define G8_SB(b, h) ((4 + (b) * 2 + (h)) * HTB)
#define G8_STAGE1(bufoff, gptr, voff, r64) do { \
        __builtin_amdgcn_global_load_lds((const unsigned*)((gptr) + (voff)), (LAS unsigned*)(lds + (bufoff) + ldsw), 16, 0, 0); \
        __builtin_amdgcn_global_load_lds((const unsigned*)((gptr) + (r64) + (voff)), (LAS unsigned*)(lds + (bufoff) + ldsw + 8192), 16, 0, 0); } while (0)
#define G8_STA(bufoff, ptr, sg, h) G8_STAGE1(bufoff, (ptr) + (h) * ((sg) ? hA1 : hA0), ((sg) ? voffA1 : voffA0), ((sg) ? r64A1 : r64A0))
#define G8_STB(bufoff, ptr, sg, h) G8_STAGE1(bufoff, (ptr) + (h) * ((sg) ? hB1 : hB0), ((sg) ? voffB1 : voffB0), ((sg) ? r64B1 : r64B0))
#define G8_LDA(dst, b, h) do { _Pragma("unroll") for (int m = 0; m < 4; ++m) _Pragma("unroll") for (int k = 0; k < 2; ++k) dst[m][k] = *(const LAS bf16x8*)(lds + G8_SA(b, h) + aoff + m * 2048 + k * 1024); } while (0)
#define G8_LDB(dst, b, h) do { _Pragma("unroll") for (int n = 0; n < 2; ++n) _Pragma("unroll") for (int k = 0; k < 2; ++k) dst[n][k] = *(const LAS bf16x8*)(lds + G8_SB(b, h) + boff + n * 2048 + k * 1024); } while (0)
#define G8_MMA(ai, bj, At, Bt) do { __builtin_amdgcn_s_setprio(1); _Pragma("unroll") for (int m = 0; m < 4; ++m) _Pragma("unroll") for (int n = 0; n < 2; ++n) _Pragma("unroll") for (int k = 0; k < 2; ++k) \
        acc[ai][bj][m][n] = __builtin_amdgcn_mfma_f32_16x16x32_bf16(Bt[n][k], At[m][k], acc[ai][bj][m][n], 0, 0, 0); __builtin_amdgcn_s_setprio(0); } while (0)
#define G8_WAIT_V(n) asm volatile("s_waitcnt vmcnt(" #n ")" ::: "memory")
#define G8_WAIT_L(n) asm volatile("s_waitcnt lgkmcnt(" #n ")" ::: "memory")
#define G8_BAR __builtin_amdgcn_s_barrier()
#define G8_SCHED __builtin_amdgcn_sched_barrier(0)
    Unit cur, nxt; int ui = 0;
    if (!p.unit(c, cur)) return;
    Acc acc;
#pragma unroll
    for (int a = 0; a < 2; ++a)
#pragma unroll
        for (int b = 0; b < 2; ++b)
#pragma unroll
            for (int m = 0; m < 4; ++m)
#pragma unroll
                for (int n = 0; n < 2; ++n) acc[a][b][m][n] = (f32x4){0.f, 0.f, 0.f, 0.f};
    bf16x8 At[4][2], B0[2][2], B1[2][2];
    const char* cA0 = p.a_base(cur, 0) - p.a_bias(0); const char* cA1 = p.a_base(cur, S1) - p.a_bias(S1);
    const char* cB0 = p.b_base(cur, 0) - p.b_bias(0); const char* cB1 = p.b_base(cur, S1) - p.b_bias(S1);
    G8_STB(G8_SB(0, 0), cB0, false, 0); G8_STB(G8_SB(0, 1), cB0, false, 1); G8_STA(G8_SA(0, 0), cA0, false, 0); G8_STA(G8_SA(0, 1), cA0, false, 1);
    if (wr == 1) G8_BAR;
    G8_WAIT_V(2); G8_BAR;
    G8_STB(G8_SB(1, 0), cB0 + ksB0, false, 0); G8_STA(G8_SA(1, 0), cA0 + ksA0, false, 0); G8_STB(G8_SB(1, 1), cB0 + ksB0, false, 1);
    G8_WAIT_V(6); G8_BAR;
    for (;;) {
        const bool has_next = p.unit((ui + 1) * G + c, nxt);
        const int nt = p.nt(cur);
        const char* nA0 = has_next ? p.a_base(nxt, 0) - p.a_bias(0) : cA0; const char* nA1 = has_next ? p.a_base(nxt, S1) - p.a_bias(S1) : cA1;
        const char* nB0 = has_next ? p.b_base(nxt, 0) - p.b_bias(0) : cB0; const char* nB1 = has_next ? p.b_base(nxt, S1) - p.b_bias(S1) : cB1;
        for (int t = 0; t < nt; t += 2) {
            const bool last = (t == nt - 2);
            const bool sg1 = (NS > 1) && (t + 1 >= nt0);
            const bool sg2 = (NS > 1) && !last && (t + 2 >= nt0);
            const char* a1 = sg1 ? cA1 + (long)(t + 1 - nt0) * ksA1 : cA0 + (long)(t + 1) * ksA0;
            const char* a2 = last ? nA0 : (sg2 ? cA1 + (long)(t + 2 - nt0) * ksA1 : cA0 + (long)(t + 2) * ksA0);
            const char* b2 = last ? nB0 : (sg2 ? cB1 + (long)(t + 2 - nt0) * ksB1 : cB0 + (long)(t + 2) * ksB0);
            const char* a3 = a2 + (sg2 ? ksA1 : ksA0); const char* b3 = b2 + (sg2 ? ksB1 : ksB0);
            G8_LDB(B0, 0, 0); G8_LDB(B1, 0, 1); G8_SCHED; G8_LDA(At, 0, 0); G8_STA(G8_SA(1, 1), a1, sg1, 1);
            G8_WAIT_V(8); G8_WAIT_L(0); G8_BAR; G8_MMA(0, 0, At, B0); G8_MMA(0, 1, At, B1); G8_BAR; G8_SCHED;
            G8_LDA(At, 0, 1); G8_STB(G8_SB(0, 0), b2, sg2, 0); G8_STB(G8_SB(0, 1), b2, sg2, 1); G8_STA(G8_SA(0, 0), a2, sg2, 0);
            G8_WAIT_V(8); G8_WAIT_L(0); G8_BAR; G8_MMA(1, 0, At, B0); G8_MMA(1, 1, At, B1); G8_BAR; G8_SCHED;
            G8_LDB(B0, 1, 0); G8_LDB(B1, 1, 1); G8_SCHED; G8_LDA(At, 1, 0); G8_STA(G8_SA(0, 1), a2, sg2, 1);
            G8_WAIT_V(8); G8_WAIT_L(0); G8_BAR; G8_MMA(0, 0, At, B0); G8_MMA(0, 1, At, B1); G8_BAR; G8_SCHED;
            G8_LDA(At, 1, 1); G8_STB(G8_SB(1, 0), b3, sg2, 0); G8_STB(G8_SB(1, 1), b3, sg2, 1); G8_STA(G8_SA(1, 0), a3, sg2, 0);
            G8_WAIT_V(8); G8_WAIT_L(0); G8_BAR; G8_MMA(1, 0, At, B0); G8_MMA(1, 1, At, B1); G8_BAR; G8_SCHED;
        }
        if (wr == 0) G8_BAR;
        p.epi(acc, cur, wr, wc, fr, fq, lds);
        if (!has_next) break;
#pragma unroll
        for (int a = 0; a < 2; ++a)
#pragma unroll
            for (int b = 0; b < 2; ++b)
#pragma unroll
                for (int m = 0; m < 4; ++m)
#pragma unroll
                    for (int n = 0; n < 2; ++n) acc[a][b][m][n] = (f32x4){0.f, 0.f, 0.f, 0.f};
        cur = nxt; ++ui; cA0 = nA0; cA1 = nA1; cB0 = nB0; cB1 = nB1;
        if (wr == 1) G8_BAR;
    }
    G8_WAIT_V(0);
    G8_BAR;
#undef G8_SA
#undef G8_SB
#undef G8_STAGE1
#undef G8_STA
#undef G8_STB
#undef G8_LDA
#undef G8_LDB
#undef G8_MMA
#undef G8_WAIT_V
#undef G8_WAIT_L
#undef G8_BAR
#undef G8_SCHED
}

template <class P>
__device__ __forceinline__ void gemm_phase_naive(LAS unsigned char* lds, const P& p, const int G, const int c) {
    const int tid = threadIdx.x, wid = tid >> 6, lane = tid & 63, wr = wid >> 2, wc = wid & 3, fr = lane & 15, fq = lane >> 4;
    LAS float* As = (LAS float*)lds;
    LAS float* Bs = As + 16 * 260;
    const int nt0 = p.nt0();
    Unit u;
    for (int ui = 0; p.unit(ui * G + c, u); ++ui) {
        const int nt = p.nt(u);
        Acc acc;
#pragma unroll
        for (int a = 0; a < 2; ++a)
#pragma unroll
            for (int b = 0; b < 2; ++b)
#pragma unroll
                for (int m = 0; m < 4; ++m)
#pragma unroll
                    for (int n = 0; n < 2; ++n) acc[a][b][m][n] = (f32x4){0.f, 0.f, 0.f, 0.f};
        for (int k0 = 0; k0 < nt * 64; k0 += 16) {
            const int seg = (P::NSEG > 1 && k0 >= nt0 * 64) ? 1 : 0, ks = k0 - (seg ? nt0 * 64 : 0);
            { const int row = tid >> 1, h8 = tid & 1;
              const u32x4 va = *(const u32x4*)(p.a_base(u, seg) + p.a_off(seg, row, ks + 8 * h8));
              const u32x4 vb = *(const u32x4*)(p.b_base(u, seg) + p.b_off(seg, row, ks + 8 * h8));
              __syncthreads();
#pragma unroll
              for (int i = 0; i < 4; ++i) { As[(8 * h8 + 2 * i) * 260 + row] = bf2f(va[i]); As[(8 * h8 + 2 * i + 1) * 260 + row] = bf2f(va[i] >> 16);
                                            Bs[(8 * h8 + 2 * i) * 260 + row] = bf2f(vb[i]); Bs[(8 * h8 + 2 * i + 1) * 260 + row] = bf2f(vb[i] >> 16); }
              __syncthreads(); }
            for (int kk = 0; kk < 16; ++kk) {
                float av[2][4], bv[2][2][4];
#pragma unroll
                for (int ai = 0; ai < 2; ++ai)
#pragma unroll
                    for (int m = 0; m < 4; ++m) av[ai][m] = As[kk * 260 + ai * 128 + wr * 64 + m * 16 + fr];
#pragma unroll
                for (int bj = 0; bj < 2; ++bj)
#pragma unroll
                    for (int n = 0; n < 2; ++n)
#pragma unroll
                        for (int j = 0; j < 4; ++j) bv[bj][n][j] = Bs[kk * 260 + bj * 128 + wc * 32 + (P::PERM ? 8 * fq + 4 * n + j : 16 * n + 4 * fq + j)];
#pragma unroll
                for (int ai = 0; ai < 2; ++ai)
#pragma unroll
                    for (int bj = 0; bj < 2; ++bj)
#pragma unroll
                        for (int m = 0; m < 4; ++m)
#pragma unroll
                            for (int n = 0; n < 2; ++n)
#pragma unroll
                                for (int j = 0; j < 4; ++j) acc[ai][bj][m][n][j] += av[ai][m] * bv[bj][n][j];
            }
        }
        __syncthreads();
        p.epi(acc, u, wr, wc, fr, fq, lds);
        __syncthreads();
    }
}


struct ProbG1 {
    static constexpr bool PERM = false; static constexpr int NSEG = 1;
    const char* HX; const char* HXV; const char* W1; const float* convw; char* A2;
    __host__ __device__ int nt0() const { return 16; } __host__ __device__ int nt(const Unit&) const { return 16; }
    __host__ __device__ long a_bias(int) const { return 0; } __host__ __device__ long b_bias(int) const { return 0; }
    __host__ __device__ bool unit(int L, Unit& u) const { return order_mn(L, RT / 256, 32, u); }
    __host__ __device__ const char* a_base(const Unit& u, int) const { return ((u.pn < 16 || u.pm >= 128) ? HX : HXV) + (size_t)u.pm * 256 * 128; }
    __host__ __device__ long a_off(int, int r, int k) const { return (long)r * 128 + (long)(k >> 6) * (long)HXPLANE + (k & 63) * 2; }
    __host__ __device__ const char* b_base(const Unit& u, int) const { return W1 + (size_t)u.pn * 256 * 2048; }
    __host__ __device__ long b_off(int, int c, int k) const { return (long)c * 2048 + k * 2; }
    __device__ __forceinline__ void epi(Acc& acc, const Unit& u, int wr, int wc, int fr, int fq, LAS unsigned char* lds) const {
        LAS unsigned char* xl = lds + XL_OFF;
        const bool chain = (u.pn >= 16) || (u.pm >= 128);
        const bool vert = (u.pn >= 16) && (u.pm < 128);
        const int ch0 = wc * 16 + fq * 4, chg = u.pn * 64 + ch0;
        const f32x4 w0 = *(const f32x4*)(convw + chg), w1 = *(const f32x4*)(convw + 2048 + chg), w2 = *(const f32x4*)(convw + 4096 + chg);
        const int slot = wc * 4 + fq;
#pragma unroll
        for (int ai = 0; ai < 2; ++ai) {
            f32x4 uu[4];
#pragma unroll
            for (int m = 0; m < 4; ++m) uu[m] = acc[ai][0][m][1] * acc[ai][1][m][0];
            LDS_WAIT(); __builtin_amdgcn_s_barrier();
#pragma unroll
            for (int m = 0; m < 4; ++m) { const int br = 1 + wr * 64 + m * 16 + fr;
                u32x2 w; w.x = pk2(uu[m][0], uu[m][1]); w.y = pk2(uu[m][2], uu[m][3]);
                *(LAS u32x2*)(xl + br * 128 + ((slot ^ (br & 15)) << 3)) = w; }
            if (ai == 0) { if (wr == 0 && fr == 0) { const f32x4 e = acc[1][0][0][1] * acc[1][1][0][0];
                    u32x2 w; w.x = pk2(e[0], e[1]); w.y = pk2(e[2], e[3]); *(LAS u32x2*)(xl + 129 * 128 + ((slot ^ (129 & 15)) << 3)) = w; } }
            else { if (wr == 1 && fr == 15) { const f32x4 e = acc[0][0][3][1] * acc[0][1][3][0];
                    u32x2 w; w.x = pk2(e[0], e[1]); w.y = pk2(e[2], e[3]); *(LAS u32x2*)(xl + 0 * 128 + ((slot ^ 0) << 3)) = w; } }
            LDS_WAIT();
            __builtin_amdgcn_s_barrier();
#pragma unroll
            for (int m = 0; m < 4; ++m) {
                const int rl = wr * 64 + m * 16 + fr, rt = ai * 128 + rl;
                const u32x2 up = *(const LAS u32x2*)(xl + rl * 128 + ((slot ^ (rl & 15)) << 3));
                const u32x2 dn = *(const LAS u32x2*)(xl + (rl + 2) * 128 + ((slot ^ ((rl + 2) & 15)) << 3));
                const bool first = chain ? (rt == 0) : ((rt & 63) == 0), lastr = chain ? (rt == 255) : ((rt & 63) == 63);
                f32x4 upv = {bf2f(up.x), bf2f(up.x >> 16), bf2f(up.y), bf2f(up.y >> 16)}, dnv = {bf2f(dn.x), bf2f(dn.x >> 16), bf2f(dn.y), bf2f(dn.y >> 16)};
                if (first) upv = (f32x4){0.f, 0.f, 0.f, 0.f};
                if (lastr) dnv = (f32x4){0.f, 0.f, 0.f, 0.f};
                const f32x4 yc = w1 * uu[m] + w0 * upv + w2 * dnv;
                const f32x4 bgv = acc[ai][0][m][0], zv = acc[ai][1][m][1];
                f32x4 o;
#pragma unroll
                for (int j = 0; j < 4; ++j) o[j] = bgv[j] * yc[j] * siluf_(zv[j]);
                const int tok = vert ? ((u.pm >> 6) * SEQ + rt * GRIDW + (u.pm & 63)) : (u.pm * 256 + rt);
                u32x2 w; w.x = pk2(o[0], o[1]); w.y = pk2(o[2], o[3]);
                *(u32x2*)(A2 + (size_t)u.pn * HXPLANE + (size_t)tok * 128 + ch0 * 2) = w;
            }
        }
    }
};

struct ProbG2 {
    static constexpr bool PERM = false; static constexpr int NSEG = 1;
    const char* A2; const char* W2; const float* x; const float* mod; float* out; float* y1s;
    __host__ __device__ int nt0() const { return 32; } __host__ __device__ int nt(const Unit& u) const { return u.pm >= 128 ? 4 : 32; }
    __host__ __device__ long a_bias(int) const { return 0; } __host__ __device__ long b_bias(int) const { return 0; }
    __host__ __device__ bool unit(int L, Unit& u) const {
        if (L < 512) return order_mn(L, RL / 256, 4, u);
        const int idx = L - 512; if (idx >= 64) return false;
        u.ks = idx & 7; const int tile = idx >> 3; u.pm = 128 + (tile >> 2); u.pn = tile & 3; u.g = 0; return true; }
    __host__ __device__ const char* a_base(const Unit& u, int) const { return A2 + (size_t)u.pm * 256 * 128 + (size_t)u.ks * 4 * HXPLANE; }
    __host__ __device__ long a_off(int, int r, int k) const { return (long)r * 128 + (long)(k >> 6) * (long)HXPLANE + (k & 63) * 2; }
    __host__ __device__ const char* b_base(const Unit& u, int) const { return W2 + (size_t)u.pn * 256 * 4096 + (size_t)u.ks * 512; }
    __host__ __device__ long b_off(int, int c, int k) const { return (long)c * 4096 + k * 2; }
    __device__ __forceinline__ void epi(Acc& acc, const Unit& u, int wr, int wc, int fr, int fq, LAS unsigned char*) const {
        const int col0 = u.pn * 256 + wc * 32 + 4 * fq;
        if (u.pm >= 128) {
#pragma unroll
            for (int ai = 0; ai < 2; ++ai)
#pragma unroll
                for (int m = 0; m < 4; ++m) { float* rowp = y1s + ((size_t)u.ks * RC + (u.pm - 128) * 256 + ai * 128 + wr * 64 + m * 16 + fr) * D + col0;
#pragma unroll
                    for (int bj = 0; bj < 2; ++bj)
#pragma unroll
                        for (int n = 0; n < 2; ++n) *(f32x4*)(rowp + bj * 128 + n * 16) = acc[ai][bj][m][n]; }
            return; }
        const int rho = u.pm >> 6;
        f32x4 gt[2][2];
#pragma unroll
        for (int bj = 0; bj < 2; ++bj)
#pragma unroll
            for (int n = 0; n < 2; ++n) gt[bj][n] = *(const f32x4*)(mod + rho * 3072 + 2048 + col0 + bj * 128 + n * 16);
#pragma unroll
        for (int ai = 0; ai < 2; ++ai)
#pragma unroll
            for (int m = 0; m < 4; ++m) { const size_t off = (size_t)(u.pm * 256 + ai * 128 + wr * 64 + m * 16 + fr) * D + col0;
#pragma unroll
                for (int bj = 0; bj < 2; ++bj)
#pragma unroll
                    for (int n = 0; n < 2; ++n) { const f32x4 xv = *(const f32x4*)(x + off + bj * 128 + n * 16);
                        *(f32x4*)(out + off + bj * 128 + n * 16) = DN_ALPHA * xv + gt[bj][n] * acc[ai][bj][m][n]; } }
    }
};

struct ProbG3 {
    static constexpr bool PERM = true; static constexpr int NSEG = 1;
    const char* HX; const char* W3; char* X; float* ucs; char* SZ; int zhalf;
    __host__ __device__ int nt0() const { return 16; } __host__ __device__ int nt(const Unit& u) const { return u.pm >= 128 ? 4 : 16; }
    __host__ __device__ long a_bias(int) const { return 0; } __host__ __device__ long b_bias(int) const { return 0; }
    __host__ __device__ bool unit(int L, Unit& u) const {
        if (L < 1024) return order_mn(L, RL / 256, 8, u);
        const int idx = L - 1024; if (zhalf || idx >= 64) return false;
        u.ks = idx & 3; const int tile = idx >> 2; u.pm = 128 + (tile >> 3); u.pn = tile & 7; u.g = 0; return true; }
    __host__ __device__ const char* a_base(const Unit& u, int) const { return HX + (size_t)u.pm * 256 * 128 + (size_t)u.ks * 4 * HXPLANE; }
    __host__ __device__ long a_off(int, int r, int k) const { return (long)r * 128 + (long)(k >> 6) * (long)HXPLANE + (k & 63) * 2; }
    __host__ __device__ const char* b_base(const Unit& u, int) const { return W3 + (size_t)(zhalf * 2048 + u.pn * 256) * 2048 + (size_t)u.ks * 512; }
    __host__ __device__ long b_off(int, int c, int k) const { return (long)c * 2048 + k * 2; }
    __device__ __forceinline__ void epi(Acc& acc, const Unit& u, int wr, int wc, int fr, int fq, LAS unsigned char*) const {
#pragma unroll
        for (int ai = 0; ai < 2; ++ai)
#pragma unroll
            for (int m = 0; m < 4; ++m) { const int tok = u.pm * 256 + ai * 128 + wr * 64 + m * 16 + fr;
#pragma unroll
                for (int bj = 0; bj < 2; ++bj) { const int n0 = u.pn * 256 + bj * 128 + wc * 32 + 8 * fq;
                    f32x4 v0 = acc[ai][bj][m][0], v1 = acc[ai][bj][m][1];
                    if (u.pm >= 128) { float* rp = ucs + ((size_t)u.ks * RC + (tok - RL)) * 2048 + n0; *(f32x4*)rp = v0; *(f32x4*)(rp + 4) = v1; continue; }
                    if (zhalf) {
#pragma unroll
                        for (int j = 0; j < 4; ++j) { v0[j] = siluf_(v0[j]); v1[j] = siluf_(v1[j]); } }
                    u32x4 w; w.x = pk2(v0[0], v0[1]); w.y = pk2(v0[2], v0[3]); w.z = pk2(v1[0], v1[1]); w.w = pk2(v1[2], v1[3]);
                    if (zhalf) *(u32x4*)(SZ + ((size_t)tok * 2048 + n0) * 2) = w;
                    else { const int g = n0 >> 4, p0 = n0 & 15;
                        const int b = tok / SEQ, tt = tok % SEQ, col = b * NCHB + tt / TCH, t = tt % TCH;
                        *(u32x4*)(X + (size_t)g * XPLANE + ((size_t)col * XLD + t * 16 + p0) * 2) = w; } } }
    }
};
__device__ __forceinline__ void reduce_uctx(const float* ucs, char* UCTX, int gtid, int gthreads) {
    for (int idx = gtid; idx < RC * 256; idx += gthreads) { const int row = idx >> 8, n0 = (idx & 255) * 8;
        f32x4 a0 = {0.f, 0.f, 0.f, 0.f}, a1 = a0;
#pragma unroll
        for (int ks = 0; ks < 4; ++ks) { const float* rp = ucs + ((size_t)ks * RC + row) * 2048 + n0; a0 += *(const f32x4*)rp; a1 += *(const f32x4*)(rp + 4); }
        u32x4 w; w.x = pk2(a0[0], a0[1]); w.y = pk2(a0[2], a0[3]); w.z = pk2(a1[0], a1[1]); w.w = pk2(a1[2], a1[3]);
        *(u32x4*)(UCTX + (size_t)(n0 >> 4) * (RC * 32) + (size_t)row * 32 + (n0 & 15) * 2) = w; }
}

struct ProbS {
    static constexpr bool PERM = false; static constexpr int NSEG = 1;
    const char* X; const char* M2; float* S;
    __host__ __device__ int nt0() const { return TP / 64; } __host__ __device__ int nt(const Unit&) const { return TP / 64; }
    __host__ __device__ long a_bias(int) const { return 0; } __host__ __device__ long b_bias(int) const { return 0; }
    __host__ __device__ bool unit(int L, Unit& u) const { return order_g(L, NG, NCOL / 256, 1, u); }
    __host__ __device__ const char* a_base(const Unit& u, int) const { return X + (size_t)u.g * XPLANE + (size_t)u.pm * 256 * XLD * 2; }
    __host__ __device__ long a_off(int, int r, int k) const { return (long)r * XLD * 2 + k * 2; }
    __host__ __device__ const char* b_base(const Unit& u, int) const { return M2 + (size_t)u.g * 256 * TP * 2; }
    __host__ __device__ long b_off(int, int c, int k) const { return (long)c * TP * 2 + k * 2; }
    __device__ __forceinline__ void epi(Acc& acc, const Unit& u, int wr, int wc, int fr, int fq, LAS unsigned char*) const {
#pragma unroll
        for (int ai = 0; ai < 2; ++ai)
#pragma unroll
            for (int m = 0; m < 4; ++m) { const int col = u.pm * 256 + ai * 128 + wr * 64 + m * 16 + fr;
                float* rowp = S + ((size_t)u.g * NCOL + col) * 256 + wc * 32 + 4 * fq;
#pragma unroll
                for (int bj = 0; bj < 2; ++bj)
#pragma unroll
                    for (int n = 0; n < 2; ++n) *(f32x4*)(rowp + bj * 128 + n * 16) = acc[ai][bj][m][n]; }
    }
};

struct ProbY {
    static constexpr bool PERM = true; static constexpr int NSEG = 2;
    const char* X; const char* KR; const char* M4; char* Gout;
    __host__ __device__ int nt0() const { return TP / 64; } __host__ __device__ int nt(const Unit&) const { return XLD / 64; }
    __host__ __device__ long a_bias(int) const { return 0; } __host__ __device__ long b_bias(int seg) const { return seg ? 0 : 96; }
    __host__ __device__ bool unit(int L, Unit& u) const { return order_g(L, NG, NCOL / 256, TP / 256, u); }
    __host__ __device__ const char* a_base(const Unit& u, int seg) const { return X + (size_t)u.g * XPLANE + (size_t)u.pm * 256 * XLD * 2 + (seg ? TP * 2 : 0); }
    __host__ __device__ long a_off(int, int r, int k) const { return (long)r * XLD * 2 + k * 2; }
    __host__ __device__ const char* b_base(const Unit& u, int seg) const {
        return seg ? M4 + (size_t)u.g * TP * 512 + (size_t)u.pn * 256 * 512 : KR + (size_t)u.g * KRG * 2 + (size_t)(TCH - 1 - 16 * u.pn) * 32; }
    __host__ __device__ long b_off(int seg, int c, int k) const { return seg ? (long)c * 512 + k * 2 : ((long)(c & 15) * PSTR - (long)(c >> 4) * 16 + k) * 2; }
    __device__ __forceinline__ void epi(Acc& acc, const Unit& u, int wr, int wc, int fr, int fq, LAS unsigned char*) const {
#pragma unroll
        for (int ai = 0; ai < 2; ++ai)
#pragma unroll
            for (int m = 0; m < 4; ++m) { const int col = u.pm * 256 + ai * 128 + wr * 64 + m * 16 + fr;
#pragma unroll
                for (int bj = 0; bj < 2; ++bj) { const int n0 = u.pn * 256 + bj * 128 + wc * 32 + 8 * fq;
                    const f32x4 v0 = acc[ai][bj][m][0], v1 = acc[ai][bj][m][1];
                    u32x4 w; w.x = pk2(gelu_tanh(v0[0]), gelu_tanh(v0[1])); w.y = pk2(gelu_tanh(v0[2]), gelu_tanh(v0[3]));
                    w.z = pk2(gelu_tanh(v1[0]), gelu_tanh(v1[1])); w.w = pk2(gelu_tanh(v1[2]), gelu_tanh(v1[3]));
                    *(u32x4*)(Gout + (size_t)u.g * GPLANE + ((size_t)col * TP + n0) * 2) = w; } }
    }
};

struct ProbG4 {
    static constexpr bool PERM = true; static constexpr int NSEG = 1;
    const char* Gin; const char* WG; const char* SZ; const float* bglu; char* A4;
    __host__ __device__ int nt0() const { return 32; } __host__ __device__ int nt(const Unit&) const { return 32; }
    __host__ __device__ long a_bias(int) const { return 0; } __host__ __device__ long b_bias(int) const { return 0; }
    __host__ __device__ bool unit(int L, Unit& u) const { return order_mn(L, RL / 256, 8, u); }
    __host__ __device__ const char* a_base(const Unit& u, int) const { return Gin + (size_t)u.pm * 256 * 32; }
    __host__ __device__ long a_off(int, int r, int k) const { return (long)(k >> 4) * (long)GPLANE + (long)r * 32 + (k & 15) * 2; }
    __host__ __device__ const char* b_base(const Unit& u, int) const { return WG + (size_t)u.pn * 256 * 4096; }
    __host__ __device__ long b_off(int, int c, int k) const { return (long)c * 4096 + k * 2; }
    __device__ __forceinline__ void epi(Acc& acc, const Unit& u, int wr, int wc, int fr, int fq, LAS unsigned char*) const {
#pragma unroll
        for (int bj = 0; bj < 2; ++bj) { const int n0 = u.pn * 256 + bj * 128 + wc * 32 + 8 * fq;
            const f32x4 b0 = *(const f32x4*)(bglu + n0), b1 = *(const f32x4*)(bglu + n0 + 4);
#pragma unroll
            for (int ai = 0; ai < 2; ++ai)
#pragma unroll
                for (int m = 0; m < 4; ++m) { const int tok = u.pm * 256 + ai * 128 + wr * 64 + m * 16 + fr;
                    const u32x4 gv = *(const u32x4*)(Gin + (size_t)(n0 >> 4) * GPLANE + (size_t)tok * 32 + (n0 & 15) * 2);
                    const u32x4 sv = *(const u32x4*)(SZ + ((size_t)tok * 2048 + n0) * 2);
                    const f32x4 v0 = acc[ai][bj][m][0] + b0, v1 = acc[ai][bj][m][1] + b1;
                    float o[8];
#pragma unroll
                    for (int i = 0; i < 4; ++i) { const float g0 = bf2f(gv[i]), g1 = bf2f(gv[i] >> 16), s0 = bf2f(sv[i]), s1 = bf2f(sv[i] >> 16);
                        const float a0 = (2 * i < 4) ? v0[2 * i] : v1[2 * i - 4], a1 = (2 * i + 1 < 4) ? v0[2 * i + 1] : v1[2 * i + 1 - 4];
                        o[2 * i] = g0 * sigmoidf_(a0) * s0; o[2 * i + 1] = g1 * sigmoidf_(a1) * s1; }
                    u32x4 w; w.x = pk2(o[0], o[1]); w.y = pk2(o[2], o[3]); w.z = pk2(o[4], o[5]); w.w = pk2(o[6], o[7]);
                    *(u32x4*)(A4 + (size_t)(n0 >> 6) * A4PLANE + (size_t)tok * 128 + (n0 & 63) * 2) = w; } }
    }
};

struct ProbG5 {
    static constexpr bool PERM = false; static constexpr int NSEG = 1;
    const char* A4; const char* W5; const float* mod; float* out;
    __host__ __device__ int nt0() const { return 32; } __host__ __device__ int nt(const Unit&) const { return 32; }
    __host__ __device__ long a_bias(int) const { return 0; } __host__ __device__ long b_bias(int) const { return 0; }
    __host__ __device__ bool unit(int L, Unit& u) const { return order_mn(L, RL / 256, 4, u); }
    __host__ __device__ const char* a_base(const Unit& u, int) const { return A4 + (size_t)u.pm * 256 * 128; }
    __host__ __device__ long a_off(int, int r, int k) const { return (long)r * 128 + (long)(k >> 6) * (long)A4PLANE + (k & 63) * 2; }
    __host__ __device__ const char* b_base(const Unit& u, int) const { return W5 + (size_t)u.pn * 256 * 4096; }
    __host__ __device__ long b_off(int, int c, int k) const { return (long)c * 4096 + k * 2; }
    __device__ __forceinline__ void epi(Acc& acc, const Unit& u, int wr, int wc, int fr, int fq, LAS unsigned char*) const {
        const int rho = u.pm >> 6, col0 = u.pn * 256 + wc * 32 + 4 * fq;
        f32x4 gt[2][2];
#pragma unroll
        for (int bj = 0; bj < 2; ++bj)
#pragma unroll
            for (int n = 0; n < 2; ++n) gt[bj][n] = *(const f32x4*)(mod + (3 + rho) * 3072 + 2048 + col0 + bj * 128 + n * 16);
#pragma unroll
        for (int ai = 0; ai < 2; ++ai)
#pragma unroll
            for (int m = 0; m < 4; ++m) { float* rowp = out + (size_t)(u.pm * 256 + ai * 128 + wr * 64 + m * 16 + fr) * D + col0;
#pragma unroll
                for (int bj = 0; bj < 2; ++bj)
#pragma unroll
                    for (int n = 0; n < 2; ++n) { const f32x4 xv = *(const f32x4*)(rowp + bj * 128 + n * 16);
                        *(f32x4*)(rowp + bj * 128 + n * 16) = DN_ALPHA * xv + gt[bj][n] * acc[ai][bj][m][n]; } }
    }
};
}

struct Frame {
    LAS unsigned char* lds;
    int tid, lane, wave, G, bid;
    const float* in[23]; float* out; unsigned char* ws;
};

template <class RM>
__device__ __forceinline__ void transpose_item(const float* W, int K, int N, bf16* WT, LAS float* scr, int item, int lane, RM rowmap) {
    const int nblk = N / 32, kb = item / nblk, nb = item % nblk, k0 = 64 * kb, n0 = 32 * nb;
#pragma unroll 8
    for (int i = 0; i < 32; ++i) { const int kk = 2 * i + (lane >> 5); scr[kk * 33 + (lane & 31)] = W[(size_t)(k0 + kk) * N + n0 + (lane & 31)]; }
    LDS_WAIT(); asm volatile("" ::: "memory");
    const int c = lane & 7;
#pragma unroll
    for (int j = 0; j < 4; ++j) { const int n = (lane >> 3) + 8 * j; const LAS float* s = scr + (8 * c) * 33 + n;
        u32x4 o; o.x = pk2(s[0 * 33], s[1 * 33]); o.y = pk2(s[2 * 33], s[3 * 33]); o.z = pk2(s[4 * 33], s[5 * 33]); o.w = pk2(s[6 * 33], s[7 * 33]);
        *(u32x4*)(WT + (size_t)rowmap(n0 + n) * K + k0 + 8 * c) = o; }
    LDS_WAIT(); asm volatile("" ::: "memory");
}
struct RowId { __device__ int operator()(int n) const { return n; } };
struct RowW1 { __device__ int operator()(int n) const { const int p = n >> 11, chg = n & 2047, nt = chg >> 6, ch = chg & 63; return nt * 256 + 128 * (p >> 1) + 16 * (p & 1) + 32 * (ch >> 4) + (ch & 15); } };

__device__ __forceinline__ void phase_prep(Frame& F) {
    LAS float* fl = (LAS float*)F.lds;
    const int tid = F.tid;
    for (int item = F.bid; item < 2 * NG; item += F.G) {
        const int g = item >> 1, r = item & 1;
        LAS float* Av = fl; LAS float* Fv = fl + 256; LAS float* BBs = fl + 512; LAS float* Cs = fl + 4608; LAS float* PW = fl + 8768;
        __syncthreads();
        if (tid < 128) { const int rr = tid >> 6, n = tid & 63;
            const float dt = expf(F.in[I_LSTEP][rr * NG + g]);
            const float lre = F.in[I_LRE][(rr * NG + g) * 64 + n], lim = F.in[I_LIM][(rr * NG + g) * 64 + n];
            const float mag = expf(lre * dt); float sn, cs; sincosf(lim * dt, &sn, &cs);
            const float ar = mag * cs, ai = mag * sn, qr = ar - 1.0f, qi = ai, den = lre * lre + lim * lim;
            Av[(rr * 64 + n) * 2] = ar; Av[(rr * 64 + n) * 2 + 1] = ai;
            Fv[(rr * 64 + n) * 2] = (qr * lre + qi * lim) / den; Fv[(rr * 64 + n) * 2 + 1] = (qi * lre - qr * lim) / den;
            if (rr == r) { const float magT = expf(lre * dt * (float)TCH); float snT, csT; sincosf(lim * dt * (float)TCH, &snT, &csT);
                float* za = (float*)(F.ws + WS_ZA) + ((size_t)(r * NG + g) * 64 + n) * 4; za[0] = ar; za[1] = ai; za[2] = magT * csT; za[3] = magT * snT; } }
        __syncthreads();
        for (int e = tid; e < 2 * 64 * 16; e += 512) { const int rr = e >> 10, n = (e >> 4) & 63, q = e & 15;
            const float bre = F.in[I_BRE][((size_t)(rr * NG + g) * 64 + n) * 16 + q], bim = F.in[I_BIM][((size_t)(rr * NG + g) * 64 + n) * 16 + q];
            const float fr_ = Fv[(rr * 64 + n) * 2], fi_ = Fv[(rr * 64 + n) * 2 + 1];
            const float bbr = fr_ * bre - fi_ * bim, bbi = fr_ * bim + fi_ * bre;
            BBs[e * 2] = bbr; BBs[e * 2 + 1] = bbi;
            if (rr == r) { float* bg = (float*)(F.ws + WS_BBG) + (((size_t)(r * NG + g) * 64 + n) * 16 + q) * 2; bg[0] = bbr; bg[1] = bbi; }
            const int p = (e >> 6) & 15, nn = e & 63;
            Cs[((rr * 16 + p) * 65 + nn) * 2] = F.in[I_CRE][((size_t)(rr * NG + g) * 16 + p) * 64 + nn];
            Cs[((rr * 16 + p) * 65 + nn) * 2 + 1] = F.in[I_CIM][((size_t)(rr * NG + g) * 16 + p) * 64 + nn]; }
        { const float dt = expf(F.in[I_LSTEP][r * NG + g]);
          for (int e = tid; e < 64 * 65; e += 512) { const int n = e / 65, ee = e % 65;
            const float lre = F.in[I_LRE][(r * NG + g) * 64 + n], lim = F.in[I_LIM][(r * NG + g) * 64 + n];
            const float mg = expf(lre * dt * (float)ee); float sn, cs; sincosf(lim * dt * (float)ee, &sn, &cs);
            PW[e * 2] = mg * cs; PW[e * 2 + 1] = mg * sn; } }
        __syncthreads();
        { bf16* M2g = (bf16*)(F.ws + WS_M2) + (size_t)g * 256 * TP;
          const int k = tid * 2, s = k >> 4, q = k & 15, e = r ? s : (TCH - 1 - s);
          for (int j = 0; j < 128; ++j) { const int cc = j >> 6, n = j & 63;
            const float pr = PW[(n * 65 + e) * 2], pi = PW[(n * 65 + e) * 2 + 1];
            const float b0r = BBs[((r * 64 + n) * 16 + q) * 2], b0i = BBs[((r * 64 + n) * 16 + q) * 2 + 1], b1r = BBs[((r * 64 + n) * 16 + q + 1) * 2], b1i = BBs[((r * 64 + n) * 16 + q + 1) * 2 + 1];
            const float v0 = cc ? (pr * b0i + pi * b0r) : (pr * b0r - pi * b0i), v1 = cc ? (pr * b1i + pi * b1r) : (pr * b1r - pi * b1i);
            *(unsigned*)(M2g + (size_t)(r * 128 + j) * TP + k) = pk2(v0, v1); } }
        { bf16* M4g = (bf16*)(F.ws + WS_M4) + (size_t)g * TP * 256;
          const int jj = (tid & 63) * 2, cc = jj >> 6, n = jj & 63;
          for (int row = tid >> 6; row < TP; row += 8) { const int t = row >> 4, p = row & 15, e = r ? (TCH - t) : (t + 1);
            float v[2];
#pragma unroll
            for (int i = 0; i < 2; ++i) { const float cr = Cs[((r * 16 + p) * 65 + n + i) * 2], ci = Cs[((r * 16 + p) * 65 + n + i) * 2 + 1], pr = PW[((n + i) * 65 + e) * 2], pi = PW[((n + i) * 65 + e) * 2 + 1];
                v[i] = cc ? -(cr * pi + ci * pr) : (cr * pr - ci * pi); }
            *(unsigned*)(M4g + (size_t)row * 256 + r * 128 + jj) = pk2(v[0], v[1]); } }
        { bf16* KRg = (bf16*)(F.ws + WS_KR) + (size_t)g * KRG;
          const int el = tid >> 6, p = (tid >> 2) & 15, qb = tid & 3;
          for (int jx = el; jx < TCH; jx += 8) {
            int j, e; if (r == 0) { j = jx; e = TCH - 1 - jx; } else { if (jx == 0) continue; j = TCH - 1 + jx; e = jx; }
            float a4[4] = {0.f, 0.f, 0.f, 0.f};
            for (int n = 0; n < 64; ++n) { const float cr = Cs[((r * 16 + p) * 65 + n) * 2], ci = Cs[((r * 16 + p) * 65 + n) * 2 + 1], pr = PW[(n * 65 + e) * 2], pi = PW[(n * 65 + e) * 2 + 1];
                const float wr_ = cr * pr - ci * pi, wi_ = cr * pi + ci * pr;
#pragma unroll
                for (int q = 0; q < 4; ++q) a4[q] += wr_ * BBs[((r * 64 + n) * 16 + qb * 4 + q) * 2] - wi_ * BBs[((r * 64 + n) * 16 + qb * 4 + q) * 2 + 1]; }
            if (r == 0 && e == 0) {
                for (int n = 0; n < 64; ++n) { const float cr = Cs[((16 + p) * 65 + n) * 2], ci = Cs[((16 + p) * 65 + n) * 2 + 1];
#pragma unroll
                    for (int q = 0; q < 4; ++q) a4[q] += cr * BBs[((64 + n) * 16 + qb * 4 + q) * 2] - ci * BBs[((64 + n) * 16 + qb * 4 + q) * 2 + 1]; }
#pragma unroll
                for (int q = 0; q < 4; ++q) if (qb * 4 + q == p) a4[q] += F.in[I_SD][g * 16 + p]; }
            u32x2 w; w.x = pk2(a4[0], a4[1]); w.y = pk2(a4[2], a4[3]);
            *(u32x2*)(KRg + (size_t)p * PSTR + j * 16 + qb * 4) = w; }
          if (r == 1 && tid < 64) { const int p2 = tid >> 2, q4 = tid & 3; *(u32x2*)(KRg + (size_t)p2 * PSTR + (2 * TCH - 1) * 16 + q4 * 4) = (u32x2){0u, 0u}; } }
    }
    __syncthreads();
    {   LAS float* sc = fl;
        for (int e = tid; e < 3 * D; e += 512) { const int rho = e >> 10, k = e & 1023; const float v = rho < 2 ? F.in[I_C][rho * D + k] : F.in[I_CCTX][k]; sc[e] = siluf_(v); }
        __syncthreads();
        LAS float* red = fl + 3 * D;
        for (int item = F.bid; item < 2 * 96; item += F.G) {
            const int layer = item / 96, n0 = (item % 96) * 32, kk = tid >> 5, nn = tid & 31;
            const float* w = F.in[I_ADAW] + (size_t)layer * D * 3072 + n0 + nn;
            float s0 = 0.f, s1 = 0.f, s2 = 0.f;
            for (int k = kk; k < D; k += 16) { const float wv = w[(size_t)k * 3072]; s0 += sc[k] * wv; s1 += sc[D + k] * wv; s2 += sc[2 * D + k] * wv; }
            red[(kk * 32 + nn) * 3] = s0; red[(kk * 32 + nn) * 3 + 1] = s1; red[(kk * 32 + nn) * 3 + 2] = s2;
            __syncthreads();
            if (tid < 96) { const int rho = tid >> 5, n = tid & 31; float s = 0.f;
                for (int k2 = 0; k2 < 16; ++k2) s += red[(k2 * 32 + n) * 3 + rho];
                ((float*)(F.ws + WS_MOD))[(layer * 3 + rho) * 3072 + n0 + n] = s + F.in[I_ADAB][layer * 3072 + n0 + n]; }
            __syncthreads();
        }
    }
    __syncthreads();
    {   LAS float* scr = (LAS float*)(F.lds + F.wave * 16384);
        const int gw = F.bid * 8 + F.wave, NGW = F.G * 8;
        constexpr int I1 = (1024 / 64) * (8192 / 32), I2 = (2048 / 64) * (1024 / 32), I3 = (1024 / 64) * (4096 / 32), I4 = (2048 / 64) * (2048 / 32), I5 = (2048 / 64) * (1024 / 32);
        for (int it = gw; it < I1 + I2 + I3 + I4 + I5; it += NGW) {
            int rI = it;
            if (rI < I1) { transpose_item(F.in[I_CWIN], 1024, 8192, (bf16*)(F.ws + WS_W1), scr, rI, F.lane, RowW1()); continue; } rI -= I1;
            if (rI < I2) { transpose_item(F.in[I_CWOUT], 2048, 1024, (bf16*)(F.ws + WS_W2), scr, rI, F.lane, RowId()); continue; } rI -= I2;
            if (rI < I3) { transpose_item(F.in[I_SWIN], 1024, 4096, (bf16*)(F.ws + WS_W3), scr, rI, F.lane, RowId()); continue; } rI -= I3;
            if (rI < I4) { transpose_item(F.in[I_WGLU], 2048, 2048, (bf16*)(F.ws + WS_WG), scr, rI, F.lane, RowId()); continue; } rI -= I4;
            transpose_item(F.in[I_SWOUT], 2048, 1024, (bf16*)(F.ws + WS_W5), scr, rI, F.lane, RowId());
        }
    }
}

__device__ __forceinline__ void store_row_blk64(char* base, size_t row, int lane, const f32x4 (&v)[4]) {
#pragma unroll
    for (int j = 0; j < 4; ++j) { const int kb = 4 * j + (lane >> 4), col = 4 * (lane & 15);
        u32x2 w; w.x = pk2(v[j][0], v[j][1]); w.y = pk2(v[j][2], v[j][3]);
        *(u32x2*)(base + (size_t)kb * HXPLANE + row * 128 + col * 2) = w; }
}
__device__ __forceinline__ void phase_mod0(Frame& F) {
    const int gw = F.bid * 8 + F.wave, NGW = F.G * 8; const float* mod = (const float*)(F.ws + WS_MOD);
    for (int row = gw; row < RT; row += NGW) {
        const bool isctx = row >= RL; const int rho = isctx ? 2 : row / SEQ;
        const float* src = isctx ? F.in[I_CTX] + (size_t)(row - RL) * D : F.in[I_X] + (size_t)row * D;
        f32x4 v[4];
#pragma unroll
        for (int j = 0; j < 4; ++j) { const int idx = 256 * j + 4 * F.lane; const f32x4 xv = *(const f32x4*)(src + idx);
            const f32x4 sh = *(const f32x4*)(mod + rho * 3072 + idx), sc = *(const f32x4*)(mod + rho * 3072 + 1024 + idx);
            v[j] = xv * (1.0f + sc) + sh; }
        store_row_blk64((char*)F.ws + WS_HX, (size_t)row, F.lane, v);
        if (!isctx) { const int b = row / SEQ, t = row % SEQ; store_row_blk64((char*)F.ws + WS_HXV, (size_t)b * SEQ + (size_t)(t % GRIDW) * 256 + t / GRIDW, F.lane, v); }
    }
}
__device__ __forceinline__ void ln_row(f32x4 (&v)[4], const float* g, const float* b, int lane) {
    float s = 0.f;
#pragma unroll
    for (int j = 0; j < 4; ++j) s += (v[j][0] + v[j][1]) + (v[j][2] + v[j][3]);
    const float mean = wave_sum(s) * (1.f / D); float s2 = 0.f;
#pragma unroll
    for (int j = 0; j < 4; ++j) { v[j] = v[j] - mean; s2 += (v[j][0] * v[j][0] + v[j][1] * v[j][1]) + (v[j][2] * v[j][2] + v[j][3] * v[j][3]); }
    const float rstd = 1.0f / sqrtf(wave_sum(s2) * (1.f / D) + LN_EPS);
#pragma unroll
    for (int j = 0; j < 4; ++j) { const int idx = 256 * j + 4 * lane; v[j] = v[j] * rstd * *(const f32x4*)(g + idx) + *(const f32x4*)(b + idx); }
}
__device__ __forceinline__ void phase_ln_mod1(Frame& F) {
    const int gw = F.bid * 8 + F.wave, NGW = F.G * 8; const float* mod = (const float*)(F.ws + WS_MOD) + 3 * 3072;
    for (int row = gw; row < RT; row += NGW) {
        const bool isctx = row >= RL; const int rho = isctx ? 2 : row / SEQ;
        float* src = F.out + (size_t)row * D;
        f32x4 v[4];
        if (isctx) { const float* mod0 = (const float*)(F.ws + WS_MOD);
#pragma unroll
            for (int j = 0; j < 4; ++j) { const int idx = 256 * j + 4 * F.lane; f32x4 a = {0.f, 0.f, 0.f, 0.f};
#pragma unroll
                for (int ks = 0; ks < 8; ++ks) a += *(const f32x4*)((const float*)(F.ws + WS_Y1S) + ((size_t)ks * RC + (row - RL)) * D + idx);
                v[j] = DN_ALPHA * *(const f32x4*)(F.in[I_CTX] + (size_t)(row - RL) * D + idx) + *(const f32x4*)(mod0 + 2 * 3072 + 2048 + idx) * a; } }
        else {
#pragma unroll
            for (int j = 0; j < 4; ++j) v[j] = *(const f32x4*)(src + 256 * j + 4 * F.lane); }
        ln_row(v, F.in[I_LNG], F.in[I_LNB], F.lane);
        if (!isctx) {
#pragma unroll
            for (int j = 0; j < 4; ++j) *(f32x4*)(src + 256 * j + 4 * F.lane) = v[j]; }
#pragma unroll
        for (int j = 0; j < 4; ++j) { const int idx = 256 * j + 4 * F.lane;
            const f32x4 sh = *(const f32x4*)(mod + rho * 3072 + idx), sc = *(const f32x4*)(mod + rho * 3072 + 1024 + idx);
            v[j] = v[j] * (1.0f + sc) + sh; }
        store_row_blk64((char*)F.ws + WS_HX, (size_t)row, F.lane, v);
    }
}
__device__ __forceinline__ void phase_ln_out(Frame& F) {
    const int gw = F.bid * 8 + F.wave, NGW = F.G * 8;
    for (int row = gw; row < RL; row += NGW) {
        float* src = F.out + (size_t)row * D;
        f32x4 v[4];
#pragma unroll
        for (int j = 0; j < 4; ++j) v[j] = *(const f32x4*)(src + 256 * j + 4 * F.lane);
        ln_row(v, F.in[I_LNG] + D, F.in[I_LNB] + D, F.lane);
#pragma unroll
        for (int j = 0; j < 4; ++j) *(f32x4*)(src + 256 * j + 4 * F.lane) = v[j];
    }
}
__device__ __forceinline__ void cmul_acc(float& hr, float& hi, float ar, float ai, float sr, float si) { const float nr = ar * hr - ai * hi + sr, ni = ar * hi + ai * hr + si; hr = nr; hi = ni; }
__device__ __forceinline__ void phase_scan(Frame& F) {
    const int n = F.lane, wq = F.wave & 3, ih = F.wave >> 2;
    LAS float* ex = (LAS float*)F.lds;
    for (int pair = F.bid; pair < NG * NBATCH; pair += F.G) {
        const int item = pair * 2 + ih, g = item >> 2, b = (item >> 1) & 1, r = item & 1;
        const f32x4 za = *(const f32x4*)((const float*)(F.ws + WS_ZA) + ((size_t)(r * NG + g) * 64 + n) * 4);
        const float ar = za[0], ai = za[1], aTr = za[2], aTi = za[3];
        float hr = 0.f, hi = 0.f;
        {   f32x4 bb[8];
            const f32x4* bp = (const f32x4*)((const float*)(F.ws + WS_BBG) + ((size_t)(r * NG + g) * 64 + n) * 32);
#pragma unroll
            for (int i = 0; i < 8; ++i) bb[i] = bp[i];
            const char* uc = (const char*)F.ws + WS_UCTX + (size_t)g * (RC * 32) + (size_t)b * CTXL * 32;
            for (int s0 = 0; s0 < 64; s0 += 8) {
                u32x4 u0[8], u1[8];
#pragma unroll
                for (int i = 0; i < 8; ++i) { const int s = 64 * wq + s0 + i, t = r ? (CTXL - 1 - s) : s; u0[i] = *(const u32x4*)(uc + t * 32); u1[i] = *(const u32x4*)(uc + t * 32 + 16); }
#pragma unroll
                for (int i = 0; i < 8; ++i) { float sr = 0.f, si = 0.f;
#pragma unroll
                    for (int q = 0; q < 8; ++q) { const unsigned w = q < 4 ? u0[i][q] : u1[i][q - 4]; const float ua = bf2f(w), ub = bf2f(w >> 16);
                        sr += bb[q][0] * ua + bb[q][2] * ub; si += bb[q][1] * ua + bb[q][3] * ub; }
                    cmul_acc(hr, hi, ar, ai, sr, si); } }
        }
        for (int k = wq; k < 3; ++k) cmul_acc(hr, hi, aTr, aTi, 0.f, 0.f);
        __syncthreads();
        ex[((ih * 4 + wq) * 64 + n) * 2] = hr; ex[((ih * 4 + wq) * 64 + n) * 2 + 1] = hi;
        __syncthreads();
        float h0r = 0.f, h0i = 0.f;
#pragma unroll
        for (int k = 0; k < 4; ++k) { h0r += ex[((ih * 4 + k) * 64 + n) * 2]; h0i += ex[((ih * 4 + k) * 64 + n) * 2 + 1]; }
        const float* Sg = (const float*)(F.ws + WS_S) + (size_t)g * NCOL * 256 + r * 128 + n;
        bf16* Xg = (bf16*)(F.ws + WS_X + (size_t)g * XPLANE) + TP + r * 128 + n;
        float sre[64], sim[64];
#pragma unroll
        for (int i = 0; i < 64; ++i) { const int sp = 64 * wq + i, col = b * NCHB + (r ? (NCHB - 1 - sp) : sp); sre[i] = Sg[(size_t)col * 256]; sim[i] = Sg[(size_t)col * 256 + 64]; }
        float er = 0.f, ei = 0.f;
#pragma unroll
        for (int i = 0; i < 64; ++i) cmul_acc(er, ei, aTr, aTi, sre[i], sim[i]);
        float qr = aTr, qi = aTi;
#pragma unroll
        for (int k = 0; k < 6; ++k) { const float nr = qr * qr - qi * qi, ni = 2.f * qr * qi; qr = nr; qi = ni; }
        __syncthreads();
        ex[((ih * 4 + wq) * 64 + n) * 2] = er; ex[((ih * 4 + wq) * 64 + n) * 2 + 1] = ei;
        __syncthreads();
        hr = h0r; hi = h0i;
        for (int k = 0; k < wq; ++k) cmul_acc(hr, hi, qr, qi, ex[((ih * 4 + k) * 64 + n) * 2], ex[((ih * 4 + k) * 64 + n) * 2 + 1]);
#pragma unroll
        for (int i = 0; i < 64; ++i) { const int sp = 64 * wq + i, col = b * NCHB + (r ? (NCHB - 1 - sp) : sp);
            Xg[(size_t)col * XLD] = (bf16)f2bf(hr); Xg[(size_t)col * XLD + 64] = (bf16)f2bf(hi);
            cmul_acc(hr, hi, aTr, aTi, sre[i], sim[i]); }
    }
}

constexpr int N_PHASES = 13;
template <class P> __device__ __forceinline__ void run_gemm(Frame& F, const P& p, int bit) {
    if ((NAIVE_MASK >> bit) & 1) g8::gemm_phase_naive<P>(F.lds, p, F.G, F.bid); else g8::gemm_phase<P>(F.lds, p, F.G, F.bid);
}
__global__ void __launch_bounds__(512, 2) mk_fwd(Args args) {
    extern __shared__ __attribute__((aligned(16))) unsigned char lds_raw[];
    Frame F;
    F.lds = (LAS unsigned char*)lds_raw;
    F.tid = threadIdx.x; F.lane = F.tid & 63; F.wave = __builtin_amdgcn_readfirstlane(F.tid >> 6); F.G = gridDim.x; F.bid = blockIdx.x;
#pragma unroll
    for (int i = 0; i < 23; ++i) F.in[i] = args.in[i];
    F.out = args.out; F.ws = args.ws;
    volatile LAS unsigned* MISC = (volatile LAS unsigned*)(F.lds + MISC_OFF);
    if (F.tid < 32) MISC[F.tid] = 0u;
    __syncthreads();
    XcdBarrier bar; bar.bar = (unsigned*)(F.ws + WS_CTL) + CW_BAR; bar.x = 0; bar.st = nullptr;
    if (MK_N_LAUNCHES == 1) bar = xcd_barrier_post((unsigned*)(F.ws + WS_CTL) + CW_BAR, MISC + 8);
    const int lo = args.ph_lo, hi = args.ph_hi;
#define IN(k) (lo <= (k) && (k) < hi)
#define REP(k) for (int rep_ = 0; rep_ < 1 + ((k) == PROBE_REP_PHASE ? PROBE_REP_N : 0); ++rep_)
#define SEAM(k) do { if (IN(k) && IN((k) + 1)) xcd_barrier(bar); } while (0)
    unsigned char* ws = F.ws; const float* mod = (const float*)(ws + WS_MOD);
    if (IN(0)) REP(0) { phase_prep(F); } SEAM(0);
    if (IN(1)) REP(1) { phase_mod0(F); } SEAM(1);
    if (IN(2)) REP(2) { g8::ProbG1 p{(const char*)ws + WS_HX, (const char*)ws + WS_HXV, (const char*)ws + WS_W1, F.in[I_CW], (char*)ws + WS_A2}; run_gemm(F, p, 0); } SEAM(2);
    if (IN(3)) REP(3) { g8::ProbG2 p{(const char*)ws + WS_A2, (const char*)ws + WS_W2, F.in[I_X], mod, F.out, (float*)(ws + WS_Y1S)}; run_gemm(F, p, 1); } SEAM(3);
    if (IN(4)) REP(4) { phase_ln_mod1(F); } SEAM(4);
    if (IN(5)) REP(5) { g8::ProbG3 p{(const char*)ws + WS_HX, (const char*)ws + WS_W3, (char*)ws + WS_X, (float*)(ws + WS_UCS), (char*)ws + WS_SZ, 0}; run_gemm(F, p, 2); } SEAM(5);
    if (IN(6)) REP(6) { g8::reduce_uctx((const float*)(ws + WS_UCS), (char*)ws + WS_UCTX, F.bid * 512 + F.tid, F.G * 512); g8::ProbS p{(const char*)ws + WS_X, (const char*)ws + WS_M2, (float*)(ws + WS_S)}; run_gemm(F, p, 3); } SEAM(6);
    if (IN(7)) REP(7) { phase_scan(F); } SEAM(7);
    if (IN(8)) REP(8) { g8::ProbY p{(const char*)ws + WS_X, (const char*)ws + WS_KR, (const char*)ws + WS_M4, (char*)ws + WS_G}; run_gemm(F, p, 4); } SEAM(8);
    if (IN(9)) REP(9) { g8::ProbG3 p{(const char*)ws + WS_HX, (const char*)ws + WS_W3, (char*)ws + WS_X, (float*)(ws + WS_UCS), (char*)ws + WS_SZ, 1}; run_gemm(F, p, 5); } SEAM(9);
    if (IN(10)) REP(10) { g8::ProbG4 p{(const char*)ws + WS_G, (const char*)ws + WS_WG, (const char*)ws + WS_SZ, F.in[I_BGLU], (char*)ws + WS_A4}; run_gemm(F, p, 6); } SEAM(10);
    if (IN(11)) REP(11) { g8::ProbG5 p{(const char*)ws + WS_A4, (const char*)ws + WS_W5, mod, F.out}; run_gemm(F, p, 7); } SEAM(11);
    if (IN(12)) REP(12) { phase_ln_out(F); }
#undef IN
#undef SEAM
}

extern "C" void kernel_launch(void* const* d_in, const int* in_sizes, int n_in, void* d_out, int out_size, void* d_ws, size_t ws_size, hipStream_t stream) {
    static int grid = 0;
    if (grid == 0) {
        if (n_in != 23 || in_sizes[0] != RL * D || out_size != RL * D || ws_size < WS_END) { fprintf(stderr, "kernel_launch: unexpected shapes (n_in %d, in0 %d, out %d, ws %zu); nothing launched\n", n_in, n_in > 0 ? in_sizes[0] : -1, out_size, ws_size); grid = -1; return; }
        int dev = 0, cus = 0, per_cu = 0;
        if (hipGetDevice(&dev) != hipSuccess || hipDeviceGetAttribute(&cus, hipDeviceAttributeMultiprocessorCount, dev) != hipSuccess) { grid = -1; return; }
        if (hipFuncSetAttribute((const void*)mk_fwd, hipFuncAttributeMaxDynamicSharedMemorySize, LDS_BYTES) != hipSuccess) { fprintf(stderr, "kernel_launch: hipFuncSetAttribute failed\n"); grid = -1; return; }
        if (hipOccupancyMaxActiveBlocksPerMultiprocessor(&per_cu, (const void*)mk_fwd, 512, LDS_BYTES) != hipSuccess || per_cu < 1) { fprintf(stderr, "kernel_launch: occupancy query says %d\n", per_cu); per_cu = 1; }
        (void)hipGetLastError();
        grid = cus * 1;
        if (per_cu < 1) grid = -1;
    }
    if (grid < 0) return;
    (void)hipMemsetAsync((char*)d_ws + WS_CTL, 0, CTL_ZERO_BYTES, stream);
    Args a{};
    for (int i = 0; i < 23; ++i) a.in[i] = (const float*)d_in[i];
    a.out = (float*)d_out; a.ws = (unsigned char*)d_ws;
    if (MK_N_LAUNCHES == 1) {
        a.ph_lo = 0; a.ph_hi = N_PHASES;
        void* kargs[] = {&a};
        hipError_t e = hipLaunchCooperativeKernel((const void*)mk_fwd, dim3(grid), dim3(512), kargs, LDS_BYTES, stream);
        if (e != hipSuccess) fprintf(stderr, "kernel_launch: cooperative launch failed: %s (grid %d)\n", hipGetErrorString(e), grid);
    } else {
        for (int ph = 0; ph < N_PHASES; ++ph) { a.ph_lo = ph; a.ph_hi = ph + 1; hipLaunchKernelGGL(mk_fwd, dim3(grid), dim3(512), LDS_BYTES, stream, a); }
    }
}
```

```cpp
#include <hip/hip_runtime.h>
#include <cstdio>
#include <cstdint>

#ifndef MK_N_LAUNCHES
#define MK_N_LAUNCHES 1
#endif
#ifndef NAIVE_MASK
#define NAIVE_MASK 0
#endif

#ifndef PROBE_REP_PHASE
#define PROBE_REP_PHASE -1
#define PROBE_REP_N 0
#endif
#ifndef PROBE_PREP_PART
#define PROBE_PREP_PART -1
#endif
#ifndef PROBE_SSM_PART
#define PROBE_SSM_PART -1
#endif
#ifndef PROBE_T_LO
#define PROBE_T_LO -1
#define PROBE_T_HI -1
#define PROBE_T_MULT 4
#endif
#define GAS __attribute__((address_space(1)))
#define LAS __attribute__((address_space(3)))
typedef unsigned short bf16;
typedef short bf16x8 __attribute__((ext_vector_type(8)));
typedef float f32x4 __attribute__((ext_vector_type(4)));
typedef float f32x2 __attribute__((ext_vector_type(2)));
typedef unsigned u32x4 __attribute__((ext_vector_type(4)));
typedef unsigned u32x2 __attribute__((ext_vector_type(2)));

constexpr int D = 1024, NBATCH = 2, SEQ = 16384, CTXL = 256, GRIDW = 64, EW = 2048, NG = 128, NST = 64, PG = 16;
constexpr int RL = NBATCH * SEQ;
constexpr int RC = NBATCH * CTXL;
constexpr int RT = RL + RC;
constexpr int TCH = 32;
constexpr int TP = TCH * PG;
constexpr int XLD = TP + 4 * NST;
constexpr int NCHB = SEQ / TCH;
constexpr int NCOL = NBATCH * NCHB;
constexpr int PSTR = 2 * TCH * PG;
constexpr int KRG = PG * PSTR;
constexpr float LN_EPS = 1e-5f;
constexpr float DN_ALPHA = 1.41421356237f;

constexpr size_t MiB = 1u << 20;
constexpr size_t WS_CTL = 0, CTL_ZERO_BYTES = 1 * MiB;
constexpr size_t WS_MOD = 1 * MiB;
constexpr size_t WS_ZA = 1 * MiB + 256 * 1024;
constexpr size_t WS_BBG = 2 * MiB;
constexpr size_t WS_WG = 6 * MiB, WS_W5 = 14 * MiB, WS_W3 = 18 * MiB;
constexpr size_t WS_KR = 26 * MiB;
constexpr size_t WS_M4 = 34 * MiB;
constexpr size_t WS_HX = 98 * MiB;
constexpr size_t WS_X = 163 * MiB;
constexpr size_t WS_A2 = 163 * MiB;
constexpr size_t WS_SZ = 195 * MiB;
constexpr size_t WS_M2 = 355 * MiB;
constexpr size_t WS_G = 355 * MiB;
constexpr size_t WS_S = 355 * MiB + 256 * 1024;
constexpr size_t WS_UCTX = 483 * MiB;
constexpr size_t WS_W1 = 484 * MiB, WS_W2 = 500 * MiB;
constexpr size_t WS_Y1S = 294 * MiB;
constexpr size_t WS_UCS = 484 * MiB;
constexpr size_t WS_FO = 163 * MiB;
constexpr size_t WS_A4 = 34 * MiB;
constexpr size_t WS_END = 504 * MiB;
constexpr size_t HXPLANE = (size_t)RT * 128;
constexpr size_t A4PLANE = (size_t)RL * 128;
constexpr size_t GPLANE = (size_t)RL * 32;
constexpr size_t XPLANE = (size_t)NCOL * XLD * 2;
static_assert(WS_X + (size_t)NG * XPLANE <= WS_M2 && WS_A2 + 32 * HXPLANE <= WS_M2 && WS_Y1S + 8 * (size_t)RC * D * 4 <= WS_M2, "map");
static_assert(WS_HX + 16 * HXPLANE <= WS_X && 16 * HXPLANE <= (size_t)RL * D * 4, "map");
static_assert(WS_G + (size_t)NG * GPLANE <= WS_UCTX && WS_SZ + (size_t)RL * 2048 * 2 <= WS_X + (size_t)NG * XPLANE && WS_A4 + 32 * A4PLANE <= WS_X, "map");
static_assert(WS_M4 + (size_t)NG * TP * 256 * 2 <= WS_HX && WS_KR + (size_t)NG * KRG * 2 <= WS_M4 && (size_t)256 * TP * 2 == 256 * 1024 && (size_t)NCOL * 256 * 2 == 512 * 1024 && GPLANE == MiB && WS_W2 + 4 * MiB <= WS_END, "map");
constexpr int CW_BAR = 4096, CW_MOD = 8000, CW_PAIR = 8192;

constexpr int RING_BYTES = 131072;
constexpr int XL_OFF = RING_BYTES;
constexpr int XL_BYTES = 2048;
constexpr int CWL_OFF = XL_OFF + XL_BYTES;
constexpr int MISC_OFF = CWL_OFF + 3 * 2048 * 4;
constexpr int LDS_BYTES = MISC_OFF + 128;

#define RLX_AGENT __ATOMIC_RELAXED, __HIP_MEMORY_SCOPE_AGENT
#define LDS_WAIT() asm volatile("s_waitcnt lgkmcnt(0)" ::: "memory")
#define VM_WAIT() asm volatile("s_waitcnt vmcnt(0)" ::: "memory")
__host__ __device__ __forceinline__ unsigned f2bf(float f) { unsigned u = __builtin_bit_cast(unsigned, f); return (u + 0x7fffu + ((u >> 16) & 1u)) >> 16; }
typedef __bf16 bf16x2_t __attribute__((ext_vector_type(2)));
__host__ __device__ __forceinline__ unsigned pk2(float lo, float hi) {
#if defined(__HIP_DEVICE_COMPILE__)
    const f32x2 v = {lo, hi}; return __builtin_bit_cast(unsigned, __builtin_convertvector(v, bf16x2_t));
#else
    return f2bf(lo) | (f2bf(hi) << 16);
#endif
}
__host__ __device__ __forceinline__ float bf2f(unsigned b) { return __builtin_bit_cast(float, (b & 0xffffu) << 16); }
__device__ __forceinline__ float sigmoidf_(float x) { return __builtin_amdgcn_rcpf(1.0f + __expf(-x)); }
__device__ __forceinline__ float siluf_(float x) { return x * sigmoidf_(x); }
__device__ __forceinline__ float gelu_tanh(float x) { return x * sigmoidf_(1.5957691216f * (x + 0.044715f * x * x * x)); }
__device__ __forceinline__ float wave_sum(float v) {
#pragma unroll
    for (int o = 1; o < 64; o <<= 1) v += __shfl_xor(v, o);
    return v;
}

__device__ __forceinline__ float dpp_from_prev(float carry, float v) { return __builtin_bit_cast(float, __builtin_amdgcn_update_dpp(__builtin_bit_cast(int, carry), __builtin_bit_cast(int, v), 0x111, 0xf, 0xf, false)); }
__device__ __forceinline__ float dpp_from_next(float carry, float v) { return __builtin_bit_cast(float, __builtin_amdgcn_update_dpp(__builtin_bit_cast(int, carry), __builtin_bit_cast(int, v), 0x101, 0xf, 0xf, false)); }
__device__ __forceinline__ float dpp_ror1(float v) { return __builtin_bit_cast(float, __builtin_amdgcn_update_dpp(0, __builtin_bit_cast(int, v), 0x121, 0xf, 0xf, false)); }
__device__ __forceinline__ float dpp_ror15(float v) { return __builtin_bit_cast(float, __builtin_amdgcn_update_dpp(0, __builtin_bit_cast(int, v), 0x12F, 0xf, 0xf, false)); }
#define XB_TMO      128
#define XB_XCNT(j)  (256  + 64 * (j))
#define XB_XSUB(j)  (1280 + 64 * (j))
#define XB_XGEN(j)  (2304 + 64 * (j))
#define XB_TOP      3328
#define XB_TOPGEN   3392
#define XCD_BAR_WORDS 3456
#define XB_SPIN_CAP (1u << 20)
__device__ __forceinline__ unsigned xb_ld(unsigned* p)              { return __hip_atomic_load(p, __ATOMIC_RELAXED, __HIP_MEMORY_SCOPE_AGENT); }
__device__ __forceinline__ unsigned xb_add(unsigned* p, unsigned v) { return __hip_atomic_fetch_add(p, v, __ATOMIC_RELAXED, __HIP_MEMORY_SCOPE_AGENT); }
__device__ __forceinline__ unsigned xb_xcc_id() { return (unsigned)__builtin_amdgcn_s_getreg((3 << 11) | 20) & 0xFu; }
#define XB_SPIN(cond, bar) do { unsigned _sp = 0; while (cond) { __builtin_amdgcn_s_sleep(1); \
    if ((++_sp & 255u) == 0u) { if (xb_ld(&(bar)[XB_TMO])) break; if (_sp > XB_SPIN_CAP) { atomicAdd(&(bar)[XB_TMO], 1u); break; } } } } while (0)
struct XcdBarrier { unsigned* bar; unsigned x; volatile LAS unsigned* st; };
__device__ __forceinline__ XcdBarrier xcd_barrier_post(unsigned* bar, volatile LAS unsigned* st) {
    XcdBarrier b; b.bar = bar; b.x = xb_xcc_id(); b.st = st;
    if (threadIdx.x == 0) (void)xb_add(&bar[XB_XCNT(b.x)], 1u);
    return b;
}
__device__ __forceinline__ void xcd_barrier_complete(unsigned* bar, unsigned x, unsigned& nloc, unsigned& nx) {
    const unsigned G = gridDim.x * gridDim.y * gridDim.z;
    unsigned sum, cnt, mine, sp = 0u;
    for (;;) {
        sum = 0u; cnt = 0u; mine = 0u;
#pragma unroll
        for (unsigned j = 0; j < 16; ++j) { const unsigned c = xb_ld(&bar[XB_XCNT(j)]); sum += c; cnt += (c > 0u) ? 1u : 0u; mine = (j == x) ? c : mine; }
        if (sum == G) break;
        __builtin_amdgcn_s_sleep(1);
        if ((++sp & 255u) == 0u) { if (xb_ld(&bar[XB_TMO])) break; if (sp > XB_SPIN_CAP) { atomicAdd(&bar[XB_TMO], 1u); break; } }
    }
    nloc = mine > 0u ? mine : 1u; nx = cnt > 0u ? cnt : 1u;
}
__device__ __forceinline__ void xcd_barrier(const XcdBarrier& b) {
    asm volatile("s_waitcnt vmcnt(0)" ::: "memory");
    __syncthreads();
    if (threadIdx.x == 0) {
        unsigned* bar = b.bar;
        __builtin_amdgcn_s_waitcnt(0);
        unsigned nloc = b.st[0], nx = b.st[1];
        if (nloc == 0u) { xcd_barrier_complete(bar, b.x, nloc, nx); b.st[0] = nloc; b.st[1] = nx; }
        const unsigned old = xb_add(&bar[XB_XSUB(b.x)], 1u);
        const unsigned gen = old / nloc;
        if (old + 1u == (gen + 1u) * nloc) {
            __builtin_amdgcn_fence(__ATOMIC_RELEASE, "agent");
            asm volatile("s_waitcnt vmcnt(0)" ::: "memory");
            const unsigned og = xb_add(&bar[XB_TOP], 1u);
            const unsigned tg = og / nx;
            if (og + 1u == (tg + 1u) * nx) xb_add(&bar[XB_TOPGEN], 1u);
            else XB_SPIN(xb_ld(&bar[XB_TOPGEN]) == tg, bar);
            __builtin_amdgcn_fence(__ATOMIC_ACQUIRE, "agent");
            xb_add(&bar[XB_XGEN(b.x)], 1u);
            asm volatile("s_waitcnt vmcnt(0)" ::: "memory");
        } else {
            XB_SPIN(xb_ld(&bar[XB_XGEN(b.x)]) == gen, bar);
            __builtin_amdgcn_fence(__ATOMIC_ACQUIRE, "agent");
            asm volatile("s_waitcnt vmcnt(0)" ::: "memory");
        }
    }
    __syncthreads();
}

struct Args {
    const float* in[23];
    float* out; unsigned char* ws;
    int ph_lo, ph_hi;
};
enum { I_X = 0, I_C, I_CTX, I_CCTX, I_ADAW, I_ADAB, I_LNG, I_LNB, I_CWIN, I_CW, I_CWOUT, I_SWIN, I_LRE, I_LIM, I_LSTEP, I_BRE, I_BIM, I_CRE, I_CIM, I_SD, I_WGLU, I_BGLU, I_SWOUT };

namespace g8 {
constexpr int BM = 256, BK = 64, HALF = 128, HTB = HALF * BK * 2, NXCD = 8, WGM = 8;
__host__ __device__ __forceinline__ int lds_byte(int r, int c) { const int st = (r >> 4) * 2 + (c >> 5), rr = r & 15, cc = c & 31, ob = rr * 64 + cc * 2; return st * 1024 + (ob ^ (((ob >> 9) & 1) << 5)); }
__host__ __device__ __forceinline__ void stage_rc(int b, int& R, int& C) { const int st = b / 1024, sb = b % 1024, swz = sb ^ (((sb >> 9) & 1) << 5); R = (st >> 1) * 16 + swz / 64; C = (st & 1) * 32 + (swz % 64) / 2; }
__host__ __device__ __forceinline__ int perm32(int rho) { const int n = rho >> 4, i = rho & 15; return 8 * (i >> 2) + 4 * n + (i & 3); }

struct Unit { int pm, pn, g, ks; };
__host__ __device__ __forceinline__ int xcd_remap(int L, int nwg) { const int q = nwg / NXCD, r = nwg % NXCD, xcd = L % NXCD, off = L / NXCD; return (xcd < r ? xcd * (q + 1) : r * (q + 1) + (xcd - r) * q) + off; }
__host__ __device__ __forceinline__ bool order_mn(int L, int nM, int nN, Unit& u) {
    const int nwg = nM * nN; if (L >= nwg) return false;
    const int wgid = xcd_remap(L, nwg);
    const int nig = WGM * nN, gid = wgid / nig, fm = gid * WGM, gsz = (nM - fm) < WGM ? (nM - fm) : WGM;
    u.pm = fm + ((wgid % nig) % gsz); u.pn = (wgid % nig) / gsz; u.g = 0; u.ks = 0; return true;
}
__host__ __device__ __forceinline__ bool order_g(int L, int ng, int nM, int nN, Unit& u) {
    const int per = nM * nN, nwg = ng * per; if (L >= nwg) return false;
    const int wgid = xcd_remap(L, nwg);
    u.g = wgid / per; const int rem = wgid % per; u.pm = rem / nN; u.pn = rem % nN; u.ks = 0; return true;
}

__device__ __forceinline__ unsigned cvt_pk_bf16(float lo, float hi) { unsigned r; asm volatile("v_cvt_pk_bf16_f32 %0, %1, %2" : "=v"(r) : "v"(lo), "v"(hi)); return r; }

typedef f32x4 Acc[2][2][4][2];

template <class P>
__device__ __forceinline__ void gemm_phase(LAS unsigned char* lds, const P& p, const int G, const int c) {
    int tid = threadIdx.x; asm volatile("" : "+v"(tid));
    const int wid = __builtin_amdgcn_readfirstlane(tid >> 6), lane = tid & 63, wr = wid >> 2, wc = wid & 3, fr = lane & 15, fq = lane >> 4;
    constexpr int NS = P::NSEG; constexpr int S1 = NS - 1;
    const int nt0 = p.nt0();
    unsigned voffA0, voffA1, voffB0, voffB1;
    { int R, C; stage_rc(tid * 16, R, C); const int Rb = P::PERM ? ((R & ~31) + perm32(R & 31)) : R;
      voffA0 = (unsigned)(p.a_off(0, R, C) - p.a_off(0, 0, 0) + p.a_bias(0)); voffB0 = (unsigned)(p.b_off(0, Rb, C) - p.b_off(0, 0, 0) + p.b_bias(0));
      voffA1 = (unsigned)(p.a_off(S1, R, C) - p.a_off(S1, 0, 0) + p.a_bias(S1)); voffB1 = (unsigned)(p.b_off(S1, Rb, C) - p.b_off(S1, 0, 0) + p.b_bias(S1)); }
    const long r64A0 = p.a_off(0, 64, 0) - p.a_off(0, 0, 0), r64A1 = p.a_off(S1, 64, 0) - p.a_off(S1, 0, 0), r64B0 = p.b_off(0, 64, 0) - p.b_off(0, 0, 0), r64B1 = p.b_off(S1, 64, 0) - p.b_off(S1, 0, 0);
    const long hA0 = p.a_off(0, 128, 0) - p.a_off(0, 0, 0), hA1 = p.a_off(S1, 128, 0) - p.a_off(S1, 0, 0), hB0 = p.b_off(0, 128, 0) - p.b_off(0, 0, 0), hB1 = p.b_off(S1, 128, 0) - p.b_off(S1, 0, 0);
    const long ksA0 = p.a_off(0, 0, 64) - p.a_off(0, 0, 0), ksA1 = p.a_off(S1, 0, 64) - p.a_off(S1, 0, 0), ksB0 = p.b_off(0, 0, 64) - p.b_off(0, 0, 0), ksB1 = p.b_off(S1, 0, 64) - p.b_off(S1, 0, 0);
    const unsigned ldsw = (unsigned)wid * 1024u;
    const int aoff = lds_byte(wr * 64 + fr, fq * 8), boff = lds_byte(wc * 32 + fr, fq * 8);
#define G8_SA(b, h) (((b) * 2 + (h)) * HTB)
#define G8_SB(b, h) ((4 + (b) * 2 + (h)) * HTB)
#define G8_STAGE1(bufoff, gptr, voff, r64) do { \
        __builtin_amdgcn_global_load_lds((const unsigned*)((gptr) + (voff)), (LAS unsigned*)(lds + (bufoff) + ldsw), 16, 0, 0); \
        __builtin_amdgcn_global_load_lds((const unsigned*)((gptr) + (r64) + (voff)), (LAS unsigned*)(lds + (bufoff) + ldsw + 8192), 16, 0, 0); } while (0)
#define G8_STA(bufoff, ptr, sg, h) G8_STAGE1(bufoff, (ptr) + (h) * ((sg) ? hA1 : hA0), ((sg) ? voffA1 : voffA0), ((sg) ? r64A1 : r64A0))
#define G8_STB(bufoff, ptr, sg, h) G8_STAGE1(bufoff, (ptr) + (h) * ((sg) ? hB1 : hB0), ((sg) ? voffB1 : voffB0), ((sg) ? r64B1 : r64B0))
#define G8_LDA(dst, b, h) do { _Pragma("unroll") for (int m = 0; m < 4; ++m) _Pragma("unroll") for (int k = 0; k < 2; ++k) dst[m][k] = *(const LAS bf16x8*)(lds + G8_SA(b, h) + aoff + m * 2048 + k * 1024); } while (0)
#define G8_LDB(dst, b, h) do { _Pragma("unroll") for (int n = 0; n < 2; ++n) _Pragma("unroll") for (int k = 0; k < 2; ++k) dst[n][k] = *(const LAS bf16x8*)(lds + G8_SB(b, h) + boff + n * 2048 + k * 1024); } while (0)
#define G8_MMA(ai, bj, At, Bt) do { __builtin_amdgcn_s_setprio(1); _Pragma("unroll") for (int m = 0; m < 4; ++m) _Pragma("unroll") for (int n = 0; n < 2; ++n) _Pragma("unroll") for (int k = 0; k < 2; ++k) \
        acc[ai][bj][m][n] = __builtin_amdgcn_mfma_f32_16x16x32_bf16(Bt[n][k], At[m][k], acc[ai][bj][m][n], 0, 0, 0); __builtin_amdgcn_s_setprio(0); } while (0)
#define G8_WAIT_V(n) asm volatile("s_waitcnt vmcnt(" #n ")" ::: "memory")
#define G8_WAIT_L(n) asm volatile("s_waitcnt lgkmcnt(" #n ")" ::: "memory")
#define G8_BAR __builtin_amdgcn_s_barrier()
#define G8_SCHED __builtin_amdgcn_sched_barrier(0)
    Unit cur, nxt; int ui = 0;
    if (!p.unit(c, cur)) return;
    Acc acc;
#pragma unroll
    for (int a = 0; a < 2; ++a)
#pragma unroll
        for (int b = 0; b < 2; ++b)
#pragma unroll
            for (int m = 0; m < 4; ++m)
#pragma unroll
                for (int n = 0; n < 2; ++n) acc[a][b][m][n] = (f32x4){0.f, 0.f, 0.f, 0.f};
    bf16x8 At[4][2], B0[2][2], B1[2][2];
    const char* cA0 = p.a_base(cur, 0) - p.a_bias(0); const char* cA1 = p.a_base(cur, S1) - p.a_bias(S1);
    const char* cB0 = p.b_base(cur, 0) - p.b_bias(0); const char* cB1 = p.b_base(cur, S1) - p.b_bias(S1);
    G8_STB(G8_SB(0, 0), cB0, false, 0); G8_STB(G8_SB(0, 1), cB0, false, 1); G8_STA(G8_SA(0, 0), cA0, false, 0); G8_STA(G8_SA(0, 1), cA0, false, 1);
    if (wr == 1) G8_BAR;
    G8_WAIT_V(2); G8_BAR;
    G8_STB(G8_SB(1, 0), cB0 + ksB0, false, 0); G8_STA(G8_SA(1, 0), cA0 + ksA0, false, 0); G8_STB(G8_SB(1, 1), cB0 + ksB0, false, 1);
    G8_WAIT_V(6); G8_BAR;
    for (;;) {
        const bool has_next = p.unit((ui + 1) * G + c, nxt);
        const int nt = p.nt(cur);
        const char* nA0 = has_next ? p.a_base(nxt, 0) - p.a_bias(0) : cA0; const char* nA1 = has_next ? p.a_base(nxt, S1) - p.a_bias(S1) : cA1;
        const char* nB0 = has_next ? p.b_base(nxt, 0) - p.b_bias(0) : cB0; const char* nB1 = has_next ? p.b_base(nxt, S1) - p.b_bias(S1) : cB1;
        for (int t = 0; t < nt; t += 2) {
            const bool last = (t == nt - 2);
            const bool sg1 = (NS > 1) && (t + 1 >= nt0);
            const bool sg2 = (NS > 1) && !last && (t + 2 >= nt0);
            const char* a1 = sg1 ? cA1 + (long)(t + 1 - nt0) * ksA1 : cA0 + (long)(t + 1) * ksA0;
            const char* a2 = last ? nA0 : (sg2 ? cA1 + (long)(t + 2 - nt0) * ksA1 : cA0 + (long)(t + 2) * ksA0);
            const char* b2 = last ? nB0 : (sg2 ? cB1 + (long)(t + 2 - nt0) * ksB1 : cB0 + (long)(t + 2) * ksB0);
            const char* a3 = a2 + (sg2 ? ksA1 : ksA0); const char* b3 = b2 + (sg2 ? ksB1 : ksB0);
            G8_LDB(B0, 0, 0); G8_LDB(B1, 0, 1); G8_SCHED; G8_LDA(At, 0, 0); G8_STA(G8_SA(1, 1), a1, sg1, 1);
            G8_WAIT_V(8); G8_WAIT_L(0); G8_BAR; G8_MMA(0, 0, At, B0); G8_MMA(0, 1, At, B1); G8_BAR; G8_SCHED;
            G8_LDA(At, 0, 1); G8_STB(G8_SB(0, 0), b2, sg2, 0); G8_STB(G8_SB(0, 1), b2, sg2, 1); G8_STA(G8_SA(0, 0), a2, sg2, 0);
            G8_WAIT_V(8); G8_WAIT_L(0); G8_BAR; G8_MMA(1, 0, At, B0); G8_MMA(1, 1, At, B1); G8_BAR; G8_SCHED;
            G8_LDB(B0, 1, 0); G8_LDB(B1, 1, 1); G8_SCHED; G8_LDA(At, 1, 0); G8_STA(G8_SA(0, 1), a2, sg2, 1);
            G8_WAIT_V(8); G8_WAIT_L(0); G8_BAR; G8_MMA(0, 0, At, B0); G8_MMA(0, 1, At, B1); G8_BAR; G8_SCHED;
            G8_LDA(At, 1, 1); G8_STB(G8_SB(1, 0), b3, sg2, 0); G8_STB(G8_SB(1, 1), b3, sg2, 1); G8_STA(G8_SA(1, 0), a3, sg2, 0);
            G8_WAIT_V(8); G8_WAIT_L(0); G8_BAR; G8_MMA(1, 0, At, B0); G8_MMA(1, 1, At, B1); G8_BAR; G8_SCHED;
        }
        if (wr == 0) G8_BAR;
        p.epi(acc, cur, wr, wc, fr, fq, lds);
        if (!has_next) break;
#pragma unroll
        for (int a = 0; a < 2; ++a)
#pragma unroll
            for (int b = 0; b < 2; ++b)
#pragma unroll
                for (int m = 0; m < 4; ++m)
#pragma unroll
                    for (int n = 0; n < 2; ++n) acc[a][b][m][n] = (f32x4){0.f, 0.f, 0.f, 0.f};
        cur = nxt; ++ui; cA0 = nA0; cA1 = nA1; cB0 = nB0; cB1 = nB1;
        if (wr == 1) G8_BAR;
    }
    G8_WAIT_V(0);
    G8_BAR;
#undef G8_SA
#undef G8_SB
#undef G8_STAGE1
#undef G8_STA
#undef G8_STB
#undef G8_LDA
#undef G8_LDB
#undef G8_MMA
#undef G8_WAIT_V
#undef G8_WAIT_L
#undef G8_BAR
#undef G8_SCHED
}

template <class P>
__device__ __forceinline__ void gemm_phase_naive(LAS unsigned char* lds, const P& p, const int G, const int c) {
    const int tid = threadIdx.x, wid = tid >> 6, lane = tid & 63, wr = wid >> 2, wc = wid & 3, fr = lane & 15, fq = lane >> 4;
    LAS float* As = (LAS float*)lds;
    LAS float* Bs = As + 16 * 260;
    const int nt0 = p.nt0();
    Unit u;
    for (int ui = 0; p.unit(ui * G + c, u); ++ui) {
        const int nt = p.nt(u);
        Acc acc;
#pragma unroll
        for (int a = 0; a < 2; ++a)
#pragma unroll
            for (int b = 0; b < 2; ++b)
#pragma unroll
                for (int m = 0; m < 4; ++m)
#pragma unroll
                    for (int n = 0; n < 2; ++n) acc[a][b][m][n] = (f32x4){0.f, 0.f, 0.f, 0.f};
        for (int k0 = 0; k0 < nt * 64; k0 += 16) {
            const int seg = (P::NSEG > 1 && k0 >= nt0 * 64) ? 1 : 0, ks = k0 - (seg ? nt0 * 64 : 0);
            { const int row = tid >> 1, h8 = tid & 1;
              const u32x4 va = *(const u32x4*)(p.a_base(u, seg) + p.a_off(seg, row, ks + 8 * h8));
              const u32x4 vb = *(const u32x4*)(p.b_base(u, seg) + p.b_off(seg, row, ks + 8 * h8));
              __syncthreads();
#pragma unroll
              for (int i = 0; i < 4; ++i) { As[(8 * h8 + 2 * i) * 260 + row] = bf2f(va[i]); As[(8 * h8 + 2 * i + 1) * 260 + row] = bf2f(va[i] >> 16);
                                            Bs[(8 * h8 + 2 * i) * 260 + row] = bf2f(vb[i]); Bs[(8 * h8 + 2 * i + 1) * 260 + row] = bf2f(vb[i] >> 16); }
              __syncthreads(); }
            for (int kk = 0; kk < 16; ++kk) {
                float av[2][4], bv[2][2][4];
#pragma unroll
                for (int ai = 0; ai < 2; ++ai)
#pragma unroll
                    for (int m = 0; m < 4; ++m) av[ai][m] = As[kk * 260 + ai * 128 + wr * 64 + m * 16 + fr];
#pragma unroll
                for (int bj = 0; bj < 2; ++bj)
#pragma unroll
                    for (int n = 0; n < 2; ++n)
#pragma unroll
                        for (int j = 0; j < 4; ++j) bv[bj][n][j] = Bs[kk * 260 + bj * 128 + wc * 32 + (P::PERM ? 8 * fq + 4 * n + j : 16 * n + 4 * fq + j)];
#pragma unroll
                for (int ai = 0; ai < 2; ++ai)
#pragma unroll
                    for (int bj = 0; bj < 2; ++bj)
#pragma unroll
                        for (int m = 0; m < 4; ++m)
#pragma unroll
                            for (int n = 0; n < 2; ++n)
#pragma unroll
                                for (int j = 0; j < 4; ++j) acc[ai][bj][m][n][j] += av[ai][m] * bv[bj][n][j];
            }
        }
        __syncthreads();
        p.epi(acc, u, wr, wc, fr, fq, lds);
        __syncthreads();
    }
}


struct ProbG1 {
    static constexpr bool PERM = false; static constexpr int NSEG = 1;
    const char* HX; const char* HXV; const char* W1; const float* convw; char* A2;
    __host__ __device__ int nt0() const { return 16; } __host__ __device__ int nt(const Unit&) const { return 16; }
    __host__ __device__ long a_bias(int) const { return 0; } __host__ __device__ long b_bias(int) const { return 0; }
    __host__ __device__ bool unit(int L, Unit& u) const { return order_mn(L, RT / 256, 32, u); }
    __host__ __device__ const char* a_base(const Unit& u, int) const { return ((u.pn < 16 || u.pm >= 128) ? HX : HXV) + (size_t)u.pm * 256 * 128; }
    __host__ __device__ long a_off(int, int r, int k) const { return (long)r * 128 + (long)(k >> 6) * (long)HXPLANE + (k & 63) * 2; }
    __host__ __device__ const char* b_base(const Unit& u, int) const { return W1 + (size_t)u.pn * 256 * 128; }
    __host__ __device__ long b_off(int, int c, int k) const { return (long)c * 128 + (long)(k >> 6) * (8192L * 128) + (k & 63) * 2; }
    __device__ __forceinline__ void epi(Acc& acc, const Unit& u, int wr, int wc, int fr, int fq, LAS unsigned char* lds) const {
        LAS float* xb = (LAS float*)(lds + XL_OFF); const LAS float* cw = (const LAS float*)(lds + CWL_OFF);
        const bool chain = (u.pn >= 16) || (u.pm >= 128);
        const bool vert = (u.pn >= 16) && (u.pm < 128);
        const int ch0 = wc * 16 + fq * 4, chg = u.pn * 64 + ch0;
        const f32x4 w0 = *(const LAS f32x4*)(cw + chg), w1 = *(const LAS f32x4*)(cw + 2048 + chg), w2 = *(const LAS f32x4*)(cw + 4096 + chg);
        f32x4 uu[2][4];
#pragma unroll
        for (int ai = 0; ai < 2; ++ai)
#pragma unroll
            for (int m = 0; m < 4; ++m) uu[ai][m] = acc[ai][0][m][1] * acc[ai][1][m][0];
        f32x4 bu[2] = {{0.f, 0.f, 0.f, 0.f}, {0.f, 0.f, 0.f, 0.f}}, bd[2] = {{0.f, 0.f, 0.f, 0.f}, {0.f, 0.f, 0.f, 0.f}};
        if (chain) {
            const int sl = ch0;
#pragma unroll
            for (int ai = 0; ai < 2; ++ai) { const int bi = 2 * ai + wr;
                if (fr == 0) *(LAS f32x4*)(xb + (bi * 2 + 0) * 64 + sl) = uu[ai][0];
                if (fr == 15) *(LAS f32x4*)(xb + (bi * 2 + 1) * 64 + sl) = uu[ai][3]; }
            LDS_WAIT(); __builtin_amdgcn_s_barrier();
#pragma unroll
            for (int ai = 0; ai < 2; ++ai) { const int bi = 2 * ai + wr;
                if (bi > 0) bu[ai] = *(const LAS f32x4*)(xb + ((bi - 1) * 2 + 1) * 64 + sl);
                if (bi < 3) bd[ai] = *(const LAS f32x4*)(xb + ((bi + 1) * 2 + 0) * 64 + sl); }
        }
#pragma unroll
        for (int ai = 0; ai < 2; ++ai)
#pragma unroll
            for (int m = 0; m < 4; ++m) {
                const int rt = ai * 128 + wr * 64 + m * 16 + fr;
                f32x4 upv, dnv;
#pragma unroll
                for (int j = 0; j < 4; ++j) {
                    const float cu = (m == 0) ? bu[ai][j] : dpp_ror1(uu[ai][m > 0 ? m - 1 : 0][j]);
                    upv[j] = dpp_from_prev(cu, uu[ai][m][j]);
                    const float cd = (m == 3) ? bd[ai][j] : dpp_ror15(uu[ai][m < 3 ? m + 1 : 3][j]);
                    dnv[j] = dpp_from_next(cd, uu[ai][m][j]); }
                const f32x4 yc = w1 * uu[ai][m] + w0 * upv + w2 * dnv;
                const f32x4 bgv = acc[ai][0][m][0], zv = acc[ai][1][m][1];
                f32x4 o;
#pragma unroll
                for (int j = 0; j < 4; ++j) o[j] = bgv[j] * yc[j] * siluf_(zv[j]);
                const int tok = vert ? ((u.pm >> 6) * SEQ + rt * GRIDW + (u.pm & 63)) : (u.pm * 256 + rt);
                u32x2 w; w.x = pk2(o[0], o[1]); w.y = pk2(o[2], o[3]);
                *(u32x2*)(A2 + (size_t)u.pn * HXPLANE + (size_t)tok * 128 + ch0 * 2) = w;
            }
    }
};

struct ProbG2 {
    static constexpr bool PERM = true; static constexpr int NSEG = 1;
    const char* A2; const char* W2; const float* mod; char* f1; float* y1s;
    __host__ __device__ int nt0() const { return 32; } __host__ __device__ int nt(const Unit& u) const { return u.pm >= 128 ? 4 : 32; }
    __host__ __device__ long a_bias(int) const { return 0; } __host__ __device__ long b_bias(int) const { return 0; }
    __host__ __device__ bool unit(int L, Unit& u) const {
        if (L < 512) return order_mn(L, RL / 256, 4, u);
        const int idx = L - 512; if (idx >= 64) return false;
        u.ks = idx & 7; const int tile = idx >> 3; u.pm = 128 + (tile >> 2); u.pn = tile & 3; u.g = 0; return true; }
    __host__ __device__ const char* a_base(const Unit& u, int) const { return A2 + (size_t)u.pm * 256 * 128 + (size_t)u.ks * 4 * HXPLANE; }
    __host__ __device__ long a_off(int, int r, int k) const { return (long)r * 128 + (long)(k >> 6) * (long)HXPLANE + (k & 63) * 2; }
    __host__ __device__ const char* b_base(const Unit& u, int) const { return W2 + (size_t)u.pn * 256 * 128 + (size_t)u.ks * 4 * (1024 * 128); }
    __host__ __device__ long b_off(int, int c, int k) const { return (long)c * 128 + (long)(k >> 6) * (1024L * 128) + (k & 63) * 2; }
    __device__ __forceinline__ void epi(Acc& acc, const Unit& u, int wr, int wc, int fr, int fq, LAS unsigned char*) const {
        const int col0 = u.pn * 256 + wc * 32 + 8 * fq;
        if (u.pm >= 128) {
#pragma unroll
            for (int ai = 0; ai < 2; ++ai)
#pragma unroll
                for (int m = 0; m < 4; ++m) { float* rowp = y1s + ((size_t)u.ks * RC + (u.pm - 128) * 256 + ai * 128 + wr * 64 + m * 16 + fr) * D + col0;
#pragma unroll
                    for (int bj = 0; bj < 2; ++bj)
#pragma unroll
                        for (int n = 0; n < 2; ++n) *(f32x4*)(rowp + bj * 128 + n * 4) = acc[ai][bj][m][n]; }
            return; }
        const int rho = u.pm >> 6;
        f32x4 gt[2][2];
#pragma unroll
        for (int bj = 0; bj < 2; ++bj)
#pragma unroll
            for (int n = 0; n < 2; ++n) gt[bj][n] = *(const f32x4*)(mod + rho * 3072 + 2048 + col0 + bj * 128 + n * 4);
#pragma unroll
        for (int ai = 0; ai < 2; ++ai)
#pragma unroll
            for (int m = 0; m < 4; ++m) { char* rowp = f1 + (size_t)(u.pm * 256 + ai * 128 + wr * 64 + m * 16 + fr) * 4096 + 2048 + col0 * 2;
#pragma unroll
                for (int bj = 0; bj < 2; ++bj) { const f32x4 v0 = gt[bj][0] * acc[ai][bj][m][0], v1 = gt[bj][1] * acc[ai][bj][m][1];
                    u32x4 w; w.x = pk2(v0[0], v0[1]); w.y = pk2(v0[2], v0[3]); w.z = pk2(v1[0], v1[1]); w.w = pk2(v1[2], v1[3]);
                    *(u32x4*)(rowp + bj * 256) = w; } }
    }
};

struct ProbG3 {
    static constexpr bool PERM = true; static constexpr int NSEG = 1;
    const char* HX; const char* W3; char* X; float* ucs; char* SZ; int zhalf;
    __host__ __device__ int nt0() const { return 16; } __host__ __device__ int nt(const Unit& u) const { return u.pm >= 128 ? 4 : 16; }
    __host__ __device__ long a_bias(int) const { return 0; } __host__ __device__ long b_bias(int) const { return 0; }
    __host__ __device__ bool unit(int L, Unit& u) const {
        if (L < 1024) return order_mn(L, RL / 256, 8, u);
        const int idx = L - 1024; if (zhalf || idx >= 64) return false;
        u.ks = idx & 3; const int tile = idx >> 2; u.pm = 128 + (tile >> 3); u.pn = tile & 7; u.g = 0; return true; }
    __host__ __device__ const char* a_base(const Unit& u, int) const { return HX + (size_t)u.pm * 256 * 128 + (size_t)u.ks * 4 * HXPLANE; }
    __host__ __device__ long a_off(int, int r, int k) const { return (long)r * 128 + (long)(k >> 6) * (long)HXPLANE + (k & 63) * 2; }
    __host__ __device__ const char* b_base(const Unit& u, int) const { return W3 + (size_t)(zhalf * 2048 + u.pn * 256) * 128 + (size_t)u.ks * 4 * (4096 * 128); }
    __host__ __device__ long b_off(int, int c, int k) const { return (long)c * 128 + (long)(k >> 6) * (4096L * 128) + (k & 63) * 2; }
    __device__ __forceinline__ void epi(Acc& acc, const Unit& u, int wr, int wc, int fr, int fq, LAS unsigned char*) const {
#pragma unroll
        for (int ai = 0; ai < 2; ++ai)
#pragma unroll
            for (int m = 0; m < 4; ++m) { const int tok = u.pm * 256 + ai * 128 + wr * 64 + m * 16 + fr;
#pragma unroll
                for (int bj = 0; bj < 2; ++bj) { const int n0 = u.pn * 256 + bj * 128 + wc * 32 + 8 * fq;
                    f32x4 v0 = acc[ai][bj][m][0], v1 = acc[ai][bj][m][1];
                    if (u.pm >= 128) { float* rp = ucs + ((size_t)u.ks * RC + (tok - RL)) * 2048 + n0; *(f32x4*)rp = v0; *(f32x4*)(rp + 4) = v1; continue; }
                    if (zhalf) {
#pragma unroll
                        for (int j = 0; j < 4; ++j) { v0[j] = siluf_(v0[j]); v1[j] = siluf_(v1[j]); } }
                    u32x4 w; w.x = pk2(v0[0], v0[1]); w.y = pk2(v0[2], v0[3]); w.z = pk2(v1[0], v1[1]); w.w = pk2(v1[2], v1[3]);
                    if (zhalf) *(u32x4*)(SZ + ((size_t)tok * 2048 + n0) * 2) = w;
                    else { const int g = n0 >> 4, p0 = n0 & 15;
                        const int b = tok / SEQ, tt = tok % SEQ, col = b * NCHB + tt / TCH, t = tt % TCH;
                        *(u32x4*)(X + (size_t)g * XPLANE + ((size_t)col * XLD + t * 16 + p0) * 2) = w; } } }
    }
};
__device__ __forceinline__ void reduce_uctx(const float* ucs, char* UCTX, int gtid, int gthreads) {
    for (int idx = gtid; idx < RC * 256; idx += gthreads) { const int row = idx >> 8, n0 = (idx & 255) * 8;
        f32x4 a0 = {0.f, 0.f, 0.f, 0.f}, a1 = a0;
#pragma unroll
        for (int ks = 0; ks < 4; ++ks) { const float* rp = ucs + ((size_t)ks * RC + row) * 2048 + n0; a0 += *(const f32x4*)rp; a1 += *(const f32x4*)(rp + 4); }
        u32x4 w; w.x = pk2(a0[0], a0[1]); w.y = pk2(a0[2], a0[3]); w.z = pk2(a1[0], a1[1]); w.w = pk2(a1[2], a1[3]);
        *(u32x4*)(UCTX + (size_t)(n0 >> 4) * (RC * 32) + (size_t)row * 32 + (n0 & 15) * 2) = w; }
}

struct ProbS {
    static constexpr bool PERM = true; static constexpr int NSEG = 1;
    const char* X; const char* M2; char* S; int g, b;
    __host__ __device__ int nt0() const { return TP / 64; } __host__ __device__ int nt(const Unit&) const { return TP / 64; }
    __host__ __device__ long a_bias(int) const { return 0; } __host__ __device__ long b_bias(int) const { return 0; }
    __host__ __device__ bool unit(int L, Unit& u) const { if (L >= NCHB / 256) return false; u.g = g; u.pm = 0; u.pn = b * (NCHB / 256) + L; u.ks = 0; return true; }
    __host__ __device__ const char* a_base(const Unit& u, int) const { return M2 + (size_t)u.g * MiB; }
    __host__ __device__ long a_off(int, int r, int k) const { return (long)r * TP * 2 + k * 2; }
    __host__ __device__ const char* b_base(const Unit& u, int) const { return X + (size_t)u.g * XPLANE + (size_t)u.pn * 256 * XLD * 2; }
    __host__ __device__ long b_off(int, int c, int k) const { return (long)c * XLD * 2 + k * 2; }
    __device__ __forceinline__ void epi(Acc& acc, const Unit& u, int wr, int wc, int fr, int fq, LAS unsigned char*) const {
#pragma unroll
        for (int ai = 0; ai < 2; ++ai)
#pragma unroll
            for (int m = 0; m < 4; ++m) { const int j = ai * 128 + wr * 64 + m * 16 + fr;
                char* rowp = S + (size_t)u.g * MiB + ((size_t)j * NCOL + u.pn * 256 + wc * 32 + 8 * fq) * 2;
#pragma unroll
                for (int bj = 0; bj < 2; ++bj) { const f32x4 v0 = acc[ai][bj][m][0], v1 = acc[ai][bj][m][1];
                    u32x4 w; w.x = pk2(v0[0], v0[1]); w.y = pk2(v0[2], v0[3]); w.z = pk2(v1[0], v1[1]); w.w = pk2(v1[2], v1[3]);
                    *(u32x4*)(rowp + bj * 256) = w; } }
    }
};

struct ProbY {
    static constexpr bool PERM = true; static constexpr int NSEG = 2;
    const char* X; const char* KR; const char* M4; char* Gout; int g, b;
    __host__ __device__ int nt0() const { return TP / 64; } __host__ __device__ int nt(const Unit&) const { return XLD / 64; }
    __host__ __device__ long a_bias(int) const { return 0; } __host__ __device__ long b_bias(int seg) const { return seg ? 0 : 96; }
    __host__ __device__ bool unit(int L, Unit& u) const { constexpr int nN = TP / 256, nM = NCHB / 256; if (L >= nN * nM) return false; u.g = g; u.pm = b * nM + L / nN; u.pn = L % nN; u.ks = 0; return true; }
    __host__ __device__ const char* a_base(const Unit& u, int seg) const { return X + (size_t)u.g * XPLANE + (size_t)u.pm * 256 * XLD * 2 + (seg ? TP * 2 : 0); }
    __host__ __device__ long a_off(int, int r, int k) const { return (long)r * XLD * 2 + k * 2; }
    __host__ __device__ const char* b_base(const Unit& u, int seg) const {
        return seg ? M4 + (size_t)u.g * TP * 512 + (size_t)u.pn * 256 * 512 : KR + (size_t)u.g * KRG * 2 + (size_t)(TCH - 1 - 16 * u.pn) * 32; }
    __host__ __device__ long b_off(int seg, int c, int k) const { return seg ? (long)c * 512 + k * 2 : ((long)(c & 15) * PSTR - (long)(c >> 4) * 16 + k) * 2; }
    __device__ __forceinline__ void epi(Acc& acc, const Unit& u, int wr, int wc, int fr, int fq, LAS unsigned char*) const {
#pragma unroll
        for (int ai = 0; ai < 2; ++ai)
#pragma unroll
            for (int m = 0; m < 4; ++m) { const int col = u.pm * 256 + ai * 128 + wr * 64 + m * 16 + fr;
#pragma unroll
                for (int bj = 0; bj < 2; ++bj) { const int n0 = u.pn * 256 + bj * 128 + wc * 32 + 8 * fq;
                    const f32x4 v0 = acc[ai][bj][m][0], v1 = acc[ai][bj][m][1];
                    u32x4 w; w.x = pk2(gelu_tanh(v0[0]), gelu_tanh(v0[1])); w.y = pk2(gelu_tanh(v0[2]), gelu_tanh(v0[3]));
                    w.z = pk2(gelu_tanh(v1[0]), gelu_tanh(v1[1])); w.w = pk2(gelu_tanh(v1[2]), gelu_tanh(v1[3]));
                    *(u32x4*)(Gout + (size_t)u.g * GPLANE + ((size_t)col * TP + n0) * 2) = w; } }
    }
};

struct ProbG4 {
    static constexpr bool PERM = true; static constexpr int NSEG = 1;
    const char* Gin; const char* WG; const char* SZ; const float* bglu; char* A4;
    __host__ __device__ int nt0() const { return 32; } __host__ __device__ int nt(const Unit&) const { return 32; }
    __host__ __device__ long a_bias(int) const { return 0; } __host__ __device__ long b_bias(int) const { return 0; }
    __host__ __device__ bool unit(int L, Unit& u) const { return order_mn(L, RL / 256, 8, u); }
    __host__ __device__ const char* a_base(const Unit& u, int) const { return Gin + (size_t)u.pm * 256 * 32; }
    __host__ __device__ long a_off(int, int r, int k) const { return (long)(k >> 4) * (long)GPLANE + (long)r * 32 + (k & 15) * 2; }
    __host__ __device__ const char* b_base(const Unit& u, int) const { return WG + (size_t)u.pn * 256 * 128; }
    __host__ __device__ long b_off(int, int c, int k) const { return (long)c * 128 + (long)(k >> 6) * (2048L * 128) + (k & 63) * 2; }
    __device__ __forceinline__ void epi(Acc& acc, const Unit& u, int wr, int wc, int fr, int fq, LAS unsigned char*) const {
        f32x4 b0[2], b1[2];
#pragma unroll
        for (int bj = 0; bj < 2; ++bj) { const int n0 = u.pn * 256 + bj * 128 + wc * 32 + 8 * fq; b0[bj] = *(const f32x4*)(bglu + n0); b1[bj] = *(const f32x4*)(bglu + n0 + 4); }
#pragma unroll
        for (int ai = 0; ai < 2; ++ai) {
            u32x4 gv[4][2], sv[4][2];
#pragma unroll
            for (int m = 0; m < 4; ++m) { const int tok = u.pm * 256 + ai * 128 + wr * 64 + m * 16 + fr;
#pragma unroll
                for (int bj = 0; bj < 2; ++bj) { const int n0 = u.pn * 256 + bj * 128 + wc * 32 + 8 * fq;
                    gv[m][bj] = *(const u32x4*)(Gin + (size_t)(n0 >> 4) * GPLANE + (size_t)tok * 32 + (n0 & 15) * 2);
                    sv[m][bj] = *(const u32x4*)(SZ + ((size_t)tok * 2048 + n0) * 2); } }
#pragma unroll
            for (int m = 0; m < 4; ++m) { const int tok = u.pm * 256 + ai * 128 + wr * 64 + m * 16 + fr;
#pragma unroll
                for (int bj = 0; bj < 2; ++bj) { const int n0 = u.pn * 256 + bj * 128 + wc * 32 + 8 * fq;
                    const f32x4 v0 = acc[ai][bj][m][0] + b0[bj], v1 = acc[ai][bj][m][1] + b1[bj];
                    float o[8];
#pragma unroll
                    for (int i = 0; i < 4; ++i) { const float g0 = bf2f(gv[m][bj][i]), g1 = bf2f(gv[m][bj][i] >> 16), s0 = bf2f(sv[m][bj][i]), s1 = bf2f(sv[m][bj][i] >> 16);
                        const float a0 = (2 * i < 4) ? v0[2 * i] : v1[2 * i - 4], a1 = (2 * i + 1 < 4) ? v0[2 * i + 1] : v1[2 * i + 1 - 4];
                        o[2 * i] = g0 * sigmoidf_(a0) * s0; o[2 * i + 1] = g1 * sigmoidf_(a1) * s1; }
                    u32x4 w; w.x = pk2(o[0], o[1]); w.y = pk2(o[2], o[3]); w.z = pk2(o[4], o[5]); w.w = pk2(o[6], o[7]);
                    *(u32x4*)(A4 + (size_t)(n0 >> 6) * A4PLANE + (size_t)tok * 128 + (n0 & 63) * 2) = w; } } }
    }
};

struct ProbG5 {
    static constexpr bool PERM = true; static constexpr int NSEG = 1;
    const char* A4; const char* W5; const float* mod; char* fo;
    __host__ __device__ int nt0() const { return 32; } __host__ __device__ int nt(const Unit&) const { return 32; }
    __host__ __device__ long a_bias(int) const { return 0; } __host__ __device__ long b_bias(int) const { return 0; }
    __host__ __device__ bool unit(int L, Unit& u) const { return order_mn(L, RL / 256, 4, u); }
    __host__ __device__ const char* a_base(const Unit& u, int) const { return A4 + (size_t)u.pm * 256 * 128; }
    __host__ __device__ long a_off(int, int r, int k) const { return (long)r * 128 + (long)(k >> 6) * (long)A4PLANE + (k & 63) * 2; }
    __host__ __device__ const char* b_base(const Unit& u, int) const { return W5 + (size_t)u.pn * 256 * 128; }
    __host__ __device__ long b_off(int, int c, int k) const { return (long)c * 128 + (long)(k >> 6) * (1024L * 128) + (k & 63) * 2; }
    __device__ __forceinline__ void epi(Acc& acc, const Unit& u, int wr, int wc, int fr, int fq, LAS unsigned char*) const {
        const int rho = u.pm >> 6, col0 = u.pn * 256 + wc * 32 + 8 * fq;
        f32x4 gt[2][2];
#pragma unroll
        for (int bj = 0; bj < 2; ++bj)
#pragma unroll
            for (int n = 0; n < 2; ++n) gt[bj][n] = *(const f32x4*)(mod + (3 + rho) * 3072 + 2048 + col0 + bj * 128 + n * 4);
#pragma unroll
        for (int ai = 0; ai < 2; ++ai)
#pragma unroll
            for (int m = 0; m < 4; ++m) { char* rowp = fo + ((size_t)(u.pm * 256 + ai * 128 + wr * 64 + m * 16 + fr) * D + col0) * 2;
#pragma unroll
                for (int bj = 0; bj < 2; ++bj) { const f32x4 v0 = gt[bj][0] * acc[ai][bj][m][0], v1 = gt[bj][1] * acc[ai][bj][m][1];
                    u32x4 w; w.x = pk2(v0[0], v0[1]); w.y = pk2(v0[2], v0[3]); w.z = pk2(v1[0], v1[1]); w.w = pk2(v1[2], v1[3]);
                    *(u32x4*)(rowp + bj * 256) = w; } }
    }
};
}

struct Frame {
    LAS unsigned char* lds;
    int tid, lane, wave, G, bid;
    const float* in[23]; float* out; unsigned char* ws;
};

template <class RM>
__device__ __forceinline__ void transpose_item(const float* W, int K, int N, bf16* WT, LAS float* scr, int item, int lane, RM rowmap) {
    const int nblk = N / 64, kb = item / nblk, nb = item % nblk, k0 = 64 * kb, n0 = 64 * nb;
    f32x4 v[16];
#pragma unroll
    for (int i = 0; i < 16; ++i) v[i] = *(const f32x4*)(W + (size_t)(k0 + 4 * i + (lane >> 4)) * N + n0 + 4 * (lane & 15));
#pragma unroll
    for (int i = 0; i < 16; ++i) { LAS float* d = scr + (4 * i + (lane >> 4)) * 65 + 4 * (lane & 15); d[0] = v[i][0]; d[1] = v[i][1]; d[2] = v[i][2]; d[3] = v[i][3]; }
    LDS_WAIT(); asm volatile("" ::: "memory");
    const int c = lane & 7;
#pragma unroll
    for (int j = 0; j < 8; ++j) { const int n = (lane >> 3) + 8 * j; const LAS float* sp = scr + (8 * c) * 65 + n;
        u32x4 o; o.x = pk2(sp[0 * 65], sp[1 * 65]); o.y = pk2(sp[2 * 65], sp[3 * 65]); o.z = pk2(sp[4 * 65], sp[5 * 65]); o.w = pk2(sp[6 * 65], sp[7 * 65]);
        *(u32x4*)(WT + (size_t)kb * N * 64 + (size_t)rowmap(n0 + n) * 64 + 8 * c) = o; }
    LDS_WAIT(); asm volatile("" ::: "memory");
}
struct RowId { __device__ int operator()(int n) const { return n; } };
struct RowW1 { __device__ int operator()(int n) const { const int p = n >> 11, chg = n & 2047, nt = chg >> 6, ch = chg & 63; return nt * 256 + 128 * (p >> 1) + 16 * (p & 1) + 32 * (ch >> 4) + (ch & 15); } };

__device__ __forceinline__ void prep_ssm(Frame& F) {
    LAS float* fl = (LAS float*)F.lds;
    const int tid = F.tid;
    for (int prep_ = 0; prep_ < (PROBE_PREP_PART == 0 ? 2 : 1); ++prep_)
    for (int item = F.bid; item < 2 * NG; item += F.G) {
        const int g = item >> 1, r = item & 1;
        LAS float* Av = fl; LAS float* Fv = fl + 256; LAS float* BBs = fl + 512; LAS float* Cs = fl + 4608; LAS float* PW = fl + 8768;
        __syncthreads();
        if (tid < 128) { const int rr = tid >> 6, n = tid & 63;
            const float dt = expf(F.in[I_LSTEP][rr * NG + g]);
            const float lre = F.in[I_LRE][(rr * NG + g) * 64 + n], lim = F.in[I_LIM][(rr * NG + g) * 64 + n];
            const float mag = expf(lre * dt); float sn, cs; sincosf(lim * dt, &sn, &cs);
            const float ar = mag * cs, ai = mag * sn, qr = ar - 1.0f, qi = ai, den = lre * lre + lim * lim;
            Av[(rr * 64 + n) * 2] = ar; Av[(rr * 64 + n) * 2 + 1] = ai;
            Fv[(rr * 64 + n) * 2] = (qr * lre + qi * lim) / den; Fv[(rr * 64 + n) * 2 + 1] = (qi * lre - qr * lim) / den;
        }
        __syncthreads();
        for (int e = tid; e < 2 * 64 * 16; e += 512) { const int rr = e >> 10, n = (e >> 4) & 63, q = e & 15;
            const float bre = F.in[I_BRE][((size_t)(rr * NG + g) * 64 + n) * 16 + q], bim = F.in[I_BIM][((size_t)(rr * NG + g) * 64 + n) * 16 + q];
            const float fr_ = Fv[(rr * 64 + n) * 2], fi_ = Fv[(rr * 64 + n) * 2 + 1];
            const float bbr = fr_ * bre - fi_ * bim, bbi = fr_ * bim + fi_ * bre;
            BBs[e * 2] = bbr; BBs[e * 2 + 1] = bbi;
            if (rr == r) { float* bg = (float*)(F.ws + WS_BBG) + (((size_t)(r * NG + g) * 64 + n) * 16 + q) * 2; bg[0] = bbr; bg[1] = bbi; }
            const int p = (e >> 6) & 15, nn = e & 63;
            Cs[((rr * 16 + p) * 65 + nn) * 2] = F.in[I_CRE][((size_t)(rr * NG + g) * 16 + p) * 64 + nn];
            Cs[((rr * 16 + p) * 65 + nn) * 2 + 1] = F.in[I_CIM][((size_t)(rr * NG + g) * 16 + p) * 64 + nn]; }
        __syncthreads();
        if (tid < 64) { const int n = tid; const float ar = Av[(r * 64 + n) * 2], ai = Av[(r * 64 + n) * 2 + 1]; float pr = 1.f, pi = 0.f;
            for (int e = 0; e <= TCH; ++e) { PW[(n * 65 + e) * 2] = pr; PW[(n * 65 + e) * 2 + 1] = pi; const float nr = pr * ar - pi * ai, ni = pr * ai + pi * ar; pr = nr; pi = ni; }
            float* za = (float*)(F.ws + WS_ZA) + ((size_t)(r * NG + g) * 64 + n) * 4; za[0] = ar; za[1] = ai; za[2] = PW[(n * 65 + TCH) * 2]; za[3] = PW[(n * 65 + TCH) * 2 + 1]; }
        __syncthreads();
        { bf16* M2g = (bf16*)(F.ws + WS_M2 + (size_t)g * MiB);
          constexpr int TPR = TP / 8;
          const int k8 = (tid % TPR) * 8, s_ = k8 >> 4, q0 = k8 & 15, e = r ? s_ : (TCH - 1 - s_);
          for (int j = tid / TPR; j < 128; j += 512 / TPR) { const int cc = j >> 6, n = j & 63;
            const float pr = PW[(n * 65 + e) * 2], pi = PW[(n * 65 + e) * 2 + 1];
            float v[8];
#pragma unroll
            for (int i = 0; i < 8; ++i) { const float br_ = BBs[((r * 64 + n) * 16 + q0 + i) * 2], bi_ = BBs[((r * 64 + n) * 16 + q0 + i) * 2 + 1]; v[i] = cc ? (pr * bi_ + pi * br_) : (pr * br_ - pi * bi_); }
            u32x4 w; w.x = pk2(v[0], v[1]); w.y = pk2(v[2], v[3]); w.z = pk2(v[4], v[5]); w.w = pk2(v[6], v[7]);
            *(u32x4*)(M2g + (size_t)(r * 128 + j) * TP + k8) = w; } }
        { bf16* M4g = (bf16*)(F.ws + WS_M4) + (size_t)g * TP * 256;
          const int jj0 = (tid & 15) * 8, cc = jj0 >> 6, n0 = jj0 & 63;
          for (int row = tid >> 4; row < TP; row += 32) { const int t = row >> 4, p = row & 15, e = r ? (TCH - t) : (t + 1);
            float v[8];
#pragma unroll
            for (int i = 0; i < 8; ++i) { const float cr = Cs[((r * 16 + p) * 65 + n0 + i) * 2], ci = Cs[((r * 16 + p) * 65 + n0 + i) * 2 + 1], pr = PW[((n0 + i) * 65 + e) * 2], pi = PW[((n0 + i) * 65 + e) * 2 + 1];
                v[i] = cc ? -(cr * pi + ci * pr) : (cr * pr - ci * pi); }
            u32x4 w; w.x = pk2(v[0], v[1]); w.y = pk2(v[2], v[3]); w.z = pk2(v[4], v[5]); w.w = pk2(v[6], v[7]);
            *(u32x4*)(M4g + (size_t)row * 256 + r * 128 + jj0) = w; } }
        { bf16* KRg = (bf16*)(F.ws + WS_KR) + (size_t)g * KRG;
          const int p = tid & 15, es = tid >> 4;
          for (int jx = es; jx < TCH; jx += 32) {
            int j, e; if (r == 0) { j = jx; e = TCH - 1 - jx; } else { if (jx == 0) continue; j = TCH - 1 + jx; e = jx; }
            float a16[16];
#pragma unroll
            for (int q = 0; q < 16; ++q) a16[q] = 0.f;
#pragma unroll 2
            for (int n = 0; n < 64; ++n) { const float cr = Cs[((r * 16 + p) * 65 + n) * 2], ci = Cs[((r * 16 + p) * 65 + n) * 2 + 1], pr = PW[(n * 65 + e) * 2], pi = PW[(n * 65 + e) * 2 + 1];
                const float wr_ = cr * pr - ci * pi, wi_ = cr * pi + ci * pr;
                const LAS f32x4* bq = (const LAS f32x4*)(BBs + ((r * 64 + n) * 16) * 2);
#pragma unroll
                for (int q2 = 0; q2 < 8; ++q2) { const f32x4 bv = bq[q2]; a16[2 * q2] += wr_ * bv[0] - wi_ * bv[1]; a16[2 * q2 + 1] += wr_ * bv[2] - wi_ * bv[3]; } }
            if (r == 0 && e == 0) {
                for (int n = 0; n < 64; ++n) { const float cr = Cs[((16 + p) * 65 + n) * 2], ci = Cs[((16 + p) * 65 + n) * 2 + 1];
                    const LAS f32x4* bq = (const LAS f32x4*)(BBs + ((64 + n) * 16) * 2);
#pragma unroll
                    for (int q2 = 0; q2 < 8; ++q2) { const f32x4 bv = bq[q2]; a16[2 * q2] += cr * bv[0] - ci * bv[1]; a16[2 * q2 + 1] += cr * bv[2] - ci * bv[3]; } }
                const float dv = F.in[I_SD][g * 16 + p];
#pragma unroll
                for (int q = 0; q < 16; ++q) if (q == p) a16[q] += dv; }
            u32x4 w0, w1; w0.x = pk2(a16[0], a16[1]); w0.y = pk2(a16[2], a16[3]); w0.z = pk2(a16[4], a16[5]); w0.w = pk2(a16[6], a16[7]);
            w1.x = pk2(a16[8], a16[9]); w1.y = pk2(a16[10], a16[11]); w1.z = pk2(a16[12], a16[13]); w1.w = pk2(a16[14], a16[15]);
            *(u32x4*)(KRg + (size_t)p * PSTR + j * 16) = w0; *(u32x4*)(KRg + (size_t)p * PSTR + j * 16 + 8) = w1; } }
    }
    __syncthreads();
}
__device__ __forceinline__ void prep_mod(Frame& F) {
    LAS float* fl = (LAS float*)F.lds;
    const int tid = F.tid;
    for (int prep_ = 0; prep_ < (PROBE_PREP_PART == 1 ? 2 : 1); ++prep_)
    {   LAS float* sc = fl;
        for (int e = tid; e < 3 * D; e += 512) { const int rho = e >> 10, k = e & 1023; const float v = rho < 2 ? F.in[I_C][rho * D + k] : F.in[I_CCTX][k]; sc[e] = siluf_(v); }
        __syncthreads();
        LAS float* red = fl + 3 * D;
        for (int item = F.bid; item < 2 * 96; item += F.G) {
            const int layer = item / 96, n0 = (item % 96) * 32, kk = tid >> 5, nn = tid & 31;
            const float* w = F.in[I_ADAW] + (size_t)layer * D * 3072 + n0 + nn;
            float s0 = 0.f, s1 = 0.f, s2 = 0.f;
            for (int k = kk; k < D; k += 256) { float wv[16];
#pragma unroll
                for (int i = 0; i < 16; ++i) wv[i] = w[(size_t)(k + 16 * i) * 3072];
#pragma unroll
                for (int i = 0; i < 16; ++i) { s0 += sc[k + 16 * i] * wv[i]; s1 += sc[D + k + 16 * i] * wv[i]; s2 += sc[2 * D + k + 16 * i] * wv[i]; } }
            red[(kk * 32 + nn) * 3] = s0; red[(kk * 32 + nn) * 3 + 1] = s1; red[(kk * 32 + nn) * 3 + 2] = s2;
            __syncthreads();
            if (tid < 96) { const int rho = tid >> 5, n = tid & 31; float s = 0.f;
                for (int k2 = 0; k2 < 16; ++k2) s += red[(k2 * 32 + n) * 3 + rho];
                ((float*)(F.ws + WS_MOD))[(layer * 3 + rho) * 3072 + n0 + n] = s + F.in[I_ADAB][layer * 3072 + n0 + n]; }
            __syncthreads();
        }
    }
    __syncthreads();
}
__device__ __forceinline__ void prep_tr(Frame& F) {
    {   LAS float* scr = (LAS float*)(F.lds + F.wave * 16640);
        const int gw = F.bid * 8 + F.wave, NGW = F.G * 8;
        constexpr int I1 = (1024 / 64) * (8192 / 64), I2 = (2048 / 64) * (1024 / 64);
        for (int it = gw; it < I1 + I2; it += NGW) {
            int rI = it;
            if (rI < I1) { transpose_item(F.in[I_CWIN], 1024, 8192, (bf16*)(F.ws + WS_W1), scr, rI, F.lane, RowW1()); continue; } rI -= I1;
            transpose_item(F.in[I_CWOUT], 2048, 1024, (bf16*)(F.ws + WS_W2), scr, rI, F.lane, RowId());
        }
    }
}
__device__ __forceinline__ void prep_tr_late(Frame& F, int first_bid, int nblocks) {
    LAS float* scr = (LAS float*)(F.lds + F.wave * 16640);
    const int gw = (F.bid - first_bid) * 8 + F.wave, NGW = nblocks * 8;
    constexpr int I3 = (1024 / 64) * (4096 / 64), I4 = (2048 / 64) * (2048 / 64), I5 = (2048 / 64) * (1024 / 64);
    for (int it = gw; it < I3 + I4 + I5; it += NGW) {
        int rI = it;
        if (rI < I3) { transpose_item(F.in[I_SWIN], 1024, 4096, (bf16*)(F.ws + WS_W3), scr, rI, F.lane, RowId()); continue; } rI -= I3;
        if (rI < I4) { transpose_item(F.in[I_WGLU], 2048, 2048, (bf16*)(F.ws + WS_WG), scr, rI, F.lane, RowId()); continue; } rI -= I4;
        transpose_item(F.in[I_SWOUT], 2048, 1024, (bf16*)(F.ws + WS_W5), scr, rI, F.lane, RowId());
    }
}
__device__ __forceinline__ void phase_prep(Frame& F) {
    prep_mod(F);
    { VM_WAIT(); __syncthreads();
      if (F.tid == 0) { int mine = 0; for (int item = F.bid; item < 2 * 96; item += F.G) ++mine;
          if (mine) { __builtin_amdgcn_fence(__ATOMIC_RELEASE, "agent"); asm volatile("s_waitcnt vmcnt(0)" ::: "memory"); (void)xb_add((unsigned*)(F.ws + WS_CTL) + CW_MOD, (unsigned)mine); } } }
    if (F.bid & 1) { prep_tr(F); __syncthreads(); prep_ssm(F); } else { prep_ssm(F); prep_tr(F); }
}
__device__ __forceinline__ void store_row_blk64(char* base, size_t row, int lane, const f32x4 (&v)[4]) {
#pragma unroll
    for (int j = 0; j < 4; ++j) { const int kb = 4 * j + (lane >> 4), col = 4 * (lane & 15);
        u32x2 w; w.x = pk2(v[j][0], v[j][1]); w.y = pk2(v[j][2], v[j][3]);
        *(u32x2*)(base + (size_t)kb * HXPLANE + row * 128 + col * 2) = w; }
}
__device__ __forceinline__ void phase_mod0(Frame& F) {
    { if (F.tid == 0) { unsigned* cnt = (unsigned*)(F.ws + WS_CTL) + CW_MOD; unsigned sp = 0; while (xb_ld(cnt) < 2u * 96u && ++sp < (1u << 22)) __builtin_amdgcn_s_sleep(2);
          __builtin_amdgcn_fence(__ATOMIC_ACQUIRE, "agent"); asm volatile("s_waitcnt vmcnt(0)" ::: "memory"); }
      __syncthreads(); }
    const int gw = F.bid * 8 + F.wave, NGW = F.G * 8; const float* mod = (const float*)(F.ws + WS_MOD);
    for (int row = gw; row < RT; row += NGW) {
        const bool isctx = row >= RL; const int rho = isctx ? 2 : row / SEQ;
        const float* src = isctx ? F.in[I_CTX] + (size_t)(row - RL) * D : F.in[I_X] + (size_t)row * D;
        f32x4 v[4];
#pragma unroll
        for (int j = 0; j < 4; ++j) { const int idx = 256 * j + 4 * F.lane; const f32x4 xv = *(const f32x4*)(src + idx);
            const f32x4 sh = *(const f32x4*)(mod + rho * 3072 + idx), sc = *(const f32x4*)(mod + rho * 3072 + 1024 + idx);
            v[j] = xv * (1.0f + sc) + sh; }
        store_row_blk64((char*)F.ws + WS_HX, (size_t)row, F.lane, v);
        if (!isctx) { const int b = row / SEQ, t = row % SEQ; store_row_blk64((char*)F.out, (size_t)b * SEQ + (size_t)(t % GRIDW) * 256 + t / GRIDW, F.lane, v); }
    }
}
__device__ __forceinline__ void ln_row(f32x4 (&v)[4], const float* g, const float* b, int lane) {
    float s = 0.f;
#pragma unroll
    for (int j = 0; j < 4; ++j) s += (v[j][0] + v[j][1]) + (v[j][2] + v[j][3]);
    const float mean = wave_sum(s) * (1.f / D); float s2 = 0.f;
#pragma unroll
    for (int j = 0; j < 4; ++j) { v[j] = v[j] - mean; s2 += (v[j][0] * v[j][0] + v[j][1] * v[j][1]) + (v[j][2] * v[j][2] + v[j][3] * v[j][3]); }
    const float rstd = 1.0f / sqrtf(wave_sum(s2) * (1.f / D) + LN_EPS);
#pragma unroll
    for (int j = 0; j < 4; ++j) { const int idx = 256 * j + 4 * lane; v[j] = v[j] * rstd * *(const f32x4*)(g + idx) + *(const f32x4*)(b + idx); }
}
__device__ __forceinline__ void phase_ln_mod1(Frame& F) {
    const int gw = F.bid * 8 + F.wave, NGW = F.G * 8; const float* mod = (const float*)(F.ws + WS_MOD) + 3 * 3072;
    for (int row = gw; row < RT; row += NGW) {
        const bool isctx = row >= RL; const int rho = isctx ? 2 : row / SEQ;
        float* src = F.out + (size_t)row * D;
        f32x4 v[4];
        if (isctx) { const float* mod0 = (const float*)(F.ws + WS_MOD);
#pragma unroll
            for (int j = 0; j < 4; ++j) { const int idx = 256 * j + 4 * F.lane; f32x4 a = {0.f, 0.f, 0.f, 0.f};
#pragma unroll
                for (int ks = 0; ks < 8; ++ks) a += *(const f32x4*)((const float*)(F.ws + WS_Y1S) + ((size_t)ks * RC + (row - RL)) * D + idx);
                v[j] = DN_ALPHA * *(const f32x4*)(F.in[I_CTX] + (size_t)(row - RL) * D + idx) + *(const f32x4*)(mod0 + 2 * 3072 + 2048 + idx) * a; } }
        else {
#pragma unroll
            for (int j = 0; j < 4; ++j) { const int idx = 256 * j + 4 * F.lane; const u32x2 f = *(const u32x2*)((const char*)src + 2048 + idx * 2);
                const f32x4 fv = {bf2f(f.x), bf2f(f.x >> 16), bf2f(f.y), bf2f(f.y >> 16)};
                v[j] = DN_ALPHA * *(const f32x4*)(F.in[I_X] + (size_t)row * D + idx) + fv; } }
        ln_row(v, F.in[I_LNG], F.in[I_LNB], F.lane);
        if (!isctx) {
#pragma unroll
            for (int j = 0; j < 4; ++j) { u32x2 w; w.x = pk2(v[j][0], v[j][1]); w.y = pk2(v[j][2], v[j][3]); *(u32x2*)((char*)src + 2048 + (256 * j + 4 * F.lane) * 2) = w; } }
#pragma unroll
        for (int j = 0; j < 4; ++j) { const int idx = 256 * j + 4 * F.lane;
            const f32x4 sh = *(const f32x4*)(mod + rho * 3072 + idx), sc = *(const f32x4*)(mod + rho * 3072 + 1024 + idx);
            v[j] = v[j] * (1.0f + sc) + sh; }
        store_row_blk64((char*)F.ws + WS_HX, (size_t)row, F.lane, v);
    }
}
__device__ __forceinline__ void phase_ln_out(Frame& F) {
    const int gw = F.bid * 8 + F.wave, NGW = F.G * 8;
    for (int row = gw; row < RL; row += NGW) {
        float* src = F.out + (size_t)row * D;
        f32x4 v[4];
#pragma unroll
        for (int j = 0; j < 4; ++j) { const int idx = 256 * j + 4 * F.lane; const u32x2 f = *(const u32x2*)((const char*)F.ws + WS_FO + ((size_t)row * D + idx) * 2);
            const f32x4 fv = {bf2f(f.x), bf2f(f.x >> 16), bf2f(f.y), bf2f(f.y >> 16)};
            const u32x2 xb = *(const u32x2*)((const char*)src + 2048 + idx * 2);
            const f32x4 xv = {bf2f(xb.x), bf2f(xb.x >> 16), bf2f(xb.y), bf2f(xb.y >> 16)};
            v[j] = DN_ALPHA * xv + fv; }
        ln_row(v, F.in[I_LNG] + D, F.in[I_LNB] + D, F.lane);
#pragma unroll
        for (int j = 0; j < 4; ++j) *(f32x4*)(src + 256 * j + 4 * F.lane) = v[j];
    }
}
__device__ __forceinline__ void cmul_acc(float& hr, float& hi, float ar, float ai, float sr, float si) { const float nr = ar * hr - ai * hi + sr, ni = ar * hi + ai * hr + si; hr = nr; hi = ni; }
__device__ __forceinline__ void scan_pair(Frame& F, const int g, const int b) {
    int n = F.lane; asm volatile("" : "+v"(n));
    const int wq = F.wave & 3, r = F.wave >> 2;
    LAS float* ex = (LAS float*)F.lds;
    const f32x4 za = *(const f32x4*)((const float*)(F.ws + WS_ZA) + ((size_t)(r * NG + g) * 64 + n) * 4);
    const float ar = za[0], ai = za[1], aTr = za[2], aTi = za[3];
    float hr = 0.f, hi = 0.f;
    {   f32x4 bb[8];
        const f32x4* bp = (const f32x4*)((const float*)(F.ws + WS_BBG) + ((size_t)(r * NG + g) * 64 + n) * 32);
#pragma unroll
        for (int i = 0; i < 8; ++i) bb[i] = bp[i];
        const int s_own = 64 * wq + n, t_own = r ? (CTXL - 1 - s_own) : s_own;
        float us[16];
#pragma unroll
        for (int j = 0; j < 16; ++j) us[j] = 0.f;
#pragma unroll
        for (int ks = 0; ks < 4; ++ks) { const f32x4* rp = (const f32x4*)((const float*)(F.ws + WS_UCS) + ((size_t)ks * RC + b * CTXL + t_own) * 2048 + g * 16);
#pragma unroll
            for (int i = 0; i < 4; ++i) { const f32x4 v = rp[i]; us[4 * i] += v[0]; us[4 * i + 1] += v[1]; us[4 * i + 2] += v[2]; us[4 * i + 3] += v[3]; } }
        for (int i = 0; i < 64; ++i) { float sr = 0.f, si = 0.f;
#pragma unroll
            for (int q = 0; q < 8; ++q) { const float ua = __builtin_bit_cast(float, __builtin_amdgcn_readlane(__builtin_bit_cast(int, us[2 * q]), i));
                const float ub = __builtin_bit_cast(float, __builtin_amdgcn_readlane(__builtin_bit_cast(int, us[2 * q + 1]), i));
                sr += bb[q][0] * ua + bb[q][2] * ub; si += bb[q][1] * ua + bb[q][3] * ub; }
            cmul_acc(hr, hi, ar, ai, sr, si); }
    }
    for (int k = wq; k < 3; ++k)
#pragma unroll
        for (int z = 0; z < 64 / TCH; ++z) cmul_acc(hr, hi, aTr, aTi, 0.f, 0.f);
    __syncthreads();
    ex[((r * 4 + wq) * 64 + n) * 2] = hr; ex[((r * 4 + wq) * 64 + n) * 2 + 1] = hi;
    __syncthreads();
    float h0r = 0.f, h0i = 0.f;
#pragma unroll
    for (int k = 0; k < 4; ++k) { h0r += ex[((r * 4 + k) * 64 + n) * 2]; h0i += ex[((r * 4 + k) * 64 + n) * 2 + 1]; }
    constexpr int CPW = NCHB / 4; static_assert(CPW == 128, "scan register blocking");
    const int cb = b * NCHB + (r ? NCHB - CPW * (wq + 1) : CPW * wq);
    const bf16* re_row = (const bf16*)(F.ws + WS_S + (size_t)g * MiB) + (size_t)(r * 128 + n) * NCOL + cb;
    const bf16* im_row = re_row + (size_t)64 * NCOL;
    bf16* Xg = (bf16*)(F.ws + WS_X + (size_t)g * XPLANE) + TP + r * 128 + n;
#define SCAN_LOAD(HALF) do { _Pragma("unroll") for (int k = 0; k < 8; ++k) { const int kk = r ? (15 - 8 * (HALF) - k) : (8 * (HALF) + k); pre[k] = *(const u32x4*)(re_row + 8 * kk); pim[k] = *(const u32x4*)(im_row + 8 * kk); } } while (0)
#define SCAN_RE(i) bf2f(pre[(i) >> 3][((r ? 7 - ((i) & 7) : ((i) & 7)) >> 1)] >> (16 * ((r ? 7 - ((i) & 7) : ((i) & 7)) & 1)))
#define SCAN_IM(i) bf2f(pim[(i) >> 3][((r ? 7 - ((i) & 7) : ((i) & 7)) >> 1)] >> (16 * ((r ? 7 - ((i) & 7) : ((i) & 7)) & 1)))
    u32x4 pre[8], pim[8];
    float er = 0.f, ei = 0.f;
#pragma unroll
    for (int half = 0; half < 2; ++half) { SCAN_LOAD(half);
        if (r == 0) {
#pragma unroll
            for (int i = 0; i < 64; ++i) cmul_acc(er, ei, aTr, aTi, bf2f(pre[i >> 3][(i & 7) >> 1] >> (16 * (i & 1))), bf2f(pim[i >> 3][(i & 7) >> 1] >> (16 * (i & 1))));
        } else {
#pragma unroll
            for (int i = 0; i < 64; ++i) { const int e = 7 - (i & 7); cmul_acc(er, ei, aTr, aTi, bf2f(pre[i >> 3][e >> 1] >> (16 * (e & 1))), bf2f(pim[i >> 3][e >> 1] >> (16 * (e & 1)))); }
        }
        asm volatile("" ::: "memory"); }
    float qr = aTr, qi = aTi;
    for (int k = 1; k < CPW; k <<= 1) { const float nr = qr * qr - qi * qi, ni = 2.f * qr * qi; qr = nr; qi = ni; }
    __syncthreads();
    ex[((r * 4 + wq) * 64 + n) * 2] = er; ex[((r * 4 + wq) * 64 + n) * 2 + 1] = ei;
    __syncthreads();
    hr = h0r; hi = h0i;
    for (int k = 0; k < wq; ++k) cmul_acc(hr, hi, qr, qi, ex[((r * 4 + k) * 64 + n) * 2], ex[((r * 4 + k) * 64 + n) * 2 + 1]);
    LAS bf16* tile = (LAS bf16*)(F.lds + 8192 + F.wave * 1024);
    GAS char* hp = (GAS char*)(F.ws + WS_X + (size_t)g * XPLANE) + ((size_t)(cb + (r ? CPW - 1 - (n >> 4) : (n >> 4))) * XLD + TP + r * 128) * 2 + (n & 15) * 16;
    const long hstep4 = (r ? -4L : 4L) * XLD * 2;
#pragma unroll
    for (int half = 0; half < 2; ++half) { SCAN_LOAD(half);
        if (r == 0) {
#pragma unroll
            for (int i = 0; i < 64; ++i) {
                tile[(i & 3) * 128 + n] = (bf16)f2bf(hr); tile[(i & 3) * 128 + 64 + n] = (bf16)f2bf(hi);
                if ((i & 3) == 3) { const u32x4 w = *(const LAS u32x4*)((const LAS char*)tile + n * 16); *(GAS u32x4*)hp = w; hp += hstep4; asm volatile("" : "+v"(hp)); }
                cmul_acc(hr, hi, aTr, aTi, bf2f(pre[i >> 3][(i & 7) >> 1] >> (16 * (i & 1))), bf2f(pim[i >> 3][(i & 7) >> 1] >> (16 * (i & 1)))); }
        } else {
#pragma unroll
            for (int i = 0; i < 64; ++i) { const int e = 7 - (i & 7);
                tile[(i & 3) * 128 + n] = (bf16)f2bf(hr); tile[(i & 3) * 128 + 64 + n] = (bf16)f2bf(hi);
                if ((i & 3) == 3) { const u32x4 w = *(const LAS u32x4*)((const LAS char*)tile + n * 16); *(GAS u32x4*)hp = w; hp += hstep4; asm volatile("" : "+v"(hp)); }
                cmul_acc(hr, hi, aTr, aTi, bf2f(pre[i >> 3][e >> 1] >> (16 * (e & 1))), bf2f(pim[i >> 3][e >> 1] >> (16 * (e & 1)))); }
        }
        asm volatile("" ::: "memory"); }
#undef SCAN_LOAD
#undef SCAN_RE
#undef SCAN_IM
}

constexpr int N_PHASES = 11;
template <class P> __device__ __forceinline__ void run_gemm(Frame& F, const P& p, int bit) {
    if ((NAIVE_MASK >> bit) & 1) g8::gemm_phase_naive<P>(F.lds, p, F.G, F.bid); else g8::gemm_phase<P>(F.lds, p, F.G, F.bid);
}
__global__ void __launch_bounds__(512, 2) mk_fwd(Args args) {
    extern __shared__ __attribute__((aligned(16))) unsigned char lds_raw[];
    Frame F;
    F.lds = (LAS unsigned char*)lds_raw;
    F.tid = threadIdx.x; F.lane = F.tid & 63; F.wave = __builtin_amdgcn_readfirstlane(F.tid >> 6); F.G = gridDim.x; F.bid = blockIdx.x;
#pragma unroll
    for (int i = 0; i < 23; ++i) F.in[i] = args.in[i];
    F.out = args.out; F.ws = args.ws;
    volatile LAS unsigned* MISC = (volatile LAS unsigned*)(F.lds + MISC_OFF);
    if (F.tid < 32) MISC[F.tid] = 0u;
    __syncthreads();
    XcdBarrier bar; bar.bar = (unsigned*)(F.ws + WS_CTL) + CW_BAR; bar.x = 0; bar.st = nullptr;
    if (MK_N_LAUNCHES == 1) bar = xcd_barrier_post((unsigned*)(F.ws + WS_CTL) + CW_BAR, MISC + 8);
    const int lo = args.ph_lo, hi = args.ph_hi;
#define IN(k) (lo <= (k) && (k) < hi)
#define REP(k) for (int rep_ = 0; rep_ < 1 + ((k) == PROBE_REP_PHASE ? PROBE_REP_N : 0); ++rep_)
#define SEAM(k) do { if (IN(k) && IN((k) + 1)) xcd_barrier(bar); if ((k) + 1 == PROBE_T_LO) pt0 = __builtin_amdgcn_s_memrealtime(); if ((k) == PROBE_T_HI) pt1 = __builtin_amdgcn_s_memrealtime(); } while (0)
    unsigned long long pt0 = (PROBE_T_LO == 0) ? __builtin_amdgcn_s_memrealtime() : 0ull, pt1 = 0ull;
    unsigned char* ws = F.ws; const float* mod = (const float*)(ws + WS_MOD);
    if (IN(0)) REP(0) { phase_prep(F); }
    if (IN(1)) REP(1) { phase_mod0(F); } SEAM(1);
    if (IN(2)) REP(2) { { LAS float* cwl = (LAS float*)(F.lds + CWL_OFF); for (int e = F.tid; e < 3 * 2048; e += 512) cwl[e] = F.in[I_CW][e]; __syncthreads(); } g8::ProbG1 p{(const char*)ws + WS_HX, (const char*)F.out, (const char*)ws + WS_W1, F.in[I_CW], (char*)ws + WS_A2}; run_gemm(F, p, 0);
        { const int nun = (RT / 256) * 32, full = nun / F.G, rem = nun - full * F.G;
          __syncthreads();
          if (rem > 0 && rem < F.G) { if (F.bid >= rem) prep_tr_late(F, rem, F.G - rem); } else prep_tr_late(F, 0, F.G); } } SEAM(2);
    if (IN(3)) REP(3) { g8::ProbG2 p{(const char*)ws + WS_A2, (const char*)ws + WS_W2, mod, (char*)F.out, (float*)(ws + WS_Y1S)}; run_gemm(F, p, 1); } SEAM(3);
    if (IN(4)) REP(4) { phase_ln_mod1(F); } SEAM(4);
    if (IN(5)) REP(5) { g8::ProbG3 p{(const char*)ws + WS_HX, (const char*)ws + WS_W3, (char*)ws + WS_X, (float*)(ws + WS_UCS), (char*)ws + WS_SZ, 0}; run_gemm(F, p, 2); } SEAM(5);
    if (IN(6)) REP(6) {
        for (int pl = F.bid; pl < NG * NBATCH; pl += F.G) { const int wg = g8::xcd_remap(pl, NG * NBATCH), g = wg >> 1, b = wg & 1;
            if (PROBE_SSM_PART == 0) pt0 = __builtin_amdgcn_s_memrealtime();
            { g8::ProbS p{(const char*)ws + WS_X, (const char*)ws + WS_M2, (char*)ws + WS_S, g, b}; if ((NAIVE_MASK >> 3) & 1) g8::gemm_phase_naive(F.lds, p, 1, 0); else g8::gemm_phase(F.lds, p, 1, 0); }
            VM_WAIT(); __syncthreads();
            if (PROBE_SSM_PART == 0) pt1 = __builtin_amdgcn_s_memrealtime(); if (PROBE_SSM_PART == 1) pt0 = __builtin_amdgcn_s_memrealtime();
            scan_pair(F, g, b);
            VM_WAIT(); __syncthreads();
            if (PROBE_SSM_PART == 1) pt1 = __builtin_amdgcn_s_memrealtime(); if (PROBE_SSM_PART == 2) pt0 = __builtin_amdgcn_s_memrealtime();
            if (F.tid == 0) { unsigned* cnt = (unsigned*)(ws + WS_CTL) + CW_PAIR + g; (void)xb_add(cnt, 1u);
                unsigned sp = 0; while (xb_ld(cnt) < 2u && ++sp < (1u << 22)) __builtin_amdgcn_s_sleep(2); }
            __syncthreads();
            { g8::ProbY p{(const char*)ws + WS_X, (const char*)ws + WS_KR, (const char*)ws + WS_M4, (char*)ws + WS_G, g, b}; if ((NAIVE_MASK >> 4) & 1) g8::gemm_phase_naive(F.lds, p, 1, 0); else g8::gemm_phase(F.lds, p, 1, 0); }
            VM_WAIT(); __syncthreads(); if (PROBE_SSM_PART == 2) pt1 = __builtin_amdgcn_s_memrealtime(); } } SEAM(6);
    if (IN(7)) REP(7) { g8::ProbG3 p{(const char*)ws + WS_HX, (const char*)ws + WS_W3, (char*)ws + WS_X, (float*)(ws + WS_UCS), (char*)ws + WS_SZ, 1}; run_gemm(F, p, 5); VM_WAIT(); __syncthreads(); }
    if (IN(8)) REP(8) { g8::ProbG4 p{(const char*)ws + WS_G, (const char*)ws + WS_WG, (const char*)ws + WS_SZ, F.in[I_BGLU], (char*)ws + WS_A4}; run_gemm(F, p, 6); } SEAM(8);
    if (IN(9)) REP(9) { g8::ProbG5 p{(const char*)ws + WS_A4, (const char*)ws + WS_W5, mod, (char*)ws + WS_FO}; run_gemm(F, p, 7); } SEAM(9);
    if (IN(10)) REP(10) { phase_ln_out(F); }
    if (PROBE_T_LO >= 0 || PROBE_SSM_PART >= 0) { if (PROBE_T_HI == 10) { VM_WAIT(); pt1 = __builtin_amdgcn_s_memrealtime(); }
        if (F.bid == 0 && F.tid == 0) { const unsigned long long tgt = __builtin_amdgcn_s_memrealtime() + (unsigned long long)PROBE_T_MULT * (pt1 - pt0);
            while (__builtin_amdgcn_s_memrealtime() < tgt) __builtin_amdgcn_s_sleep(8); } }
#undef IN
#undef SEAM
}

extern "C" void kernel_launch(void* const* d_in, const int* in_sizes, int n_in, void* d_out, int out_size, void* d_ws, size_t ws_size, hipStream_t stream) {
    static int grid = 0;
    if (grid == 0) {
        if (n_in != 23 || in_sizes[0] != RL * D || out_size != RL * D || ws_size < WS_END) { fprintf(stderr, "kernel_launch: unexpected shapes (n_in %d, in0 %d, out %d, ws %zu); nothing launched\n", n_in, n_in > 0 ? in_sizes[0] : -1, out_size, ws_size); grid = -1; return; }
        int dev = 0, cus = 0, per_cu = 0;
        if (hipGetDevice(&dev) != hipSuccess || hipDeviceGetAttribute(&cus, hipDeviceAttributeMultiprocessorCount, dev) != hipSuccess) { grid = -1; return; }
        if (hipFuncSetAttribute((const void*)mk_fwd, hipFuncAttributeMaxDynamicSharedMemorySize, LDS_BYTES) != hipSuccess) { fprintf(stderr, "kernel_launch: hipFuncSetAttribute failed\n"); grid = -1; return; }
        if (hipOccupancyMaxActiveBlocksPerMultiprocessor(&per_cu, (const void*)mk_fwd, 512, LDS_BYTES) != hipSuccess || per_cu < 1) { fprintf(stderr, "kernel_launch: occupancy query says %d\n", per_cu); per_cu = 1; }
        (void)hipGetLastError();
        grid = cus * 1;
        if (per_cu < 1) grid = -1;
    }
    if (grid < 0) return;
    (void)hipMemsetAsync((char*)d_ws + WS_CTL, 0, CTL_ZERO_BYTES, stream);
    Args a{};
    for (int i = 0; i < 23; ++i) a.in[i] = (const float*)d_in[i];
    a.out = (float*)d_out; a.ws = (unsigned char*)d_ws;
    if (MK_N_LAUNCHES == 1) {
        a.ph_lo = 0; a.ph_hi = N_PHASES;
        void* kargs[] = {&a};
        hipError_t e = hipLaunchCooperativeKernel((const void*)mk_fwd, dim3(grid), dim3(512), kargs, LDS_BYTES, stream);
        if (e != hipSuccess) fprintf(stderr, "kernel_launch: cooperative launch failed: %s (grid %d)\n", hipGetErrorString(e), grid);
    } else {
        for (int ph = 0; ph < N_PHASES; ++ph) { a.ph_lo = ph; a.ph_hi = ph + 1; hipLaunchKernelGGL(mk_fwd, dim3(grid), dim3(512), LDS_BYTES, stream, a); }
    }
}
```

```cpp
#include <hip/hip_runtime.h>
#include <cstdio>
#include <cstdint>

#ifndef MK_N_LAUNCHES
#define MK_N_LAUNCHES 1
#endif
#ifndef NAIVE_MASK
#define NAIVE_MASK 0
#endif

#ifndef PROBE_REP_PHASE
#define PROBE_REP_PHASE -1
#define PROBE_REP_N 0
#endif
#ifndef PROBE_PREP_PART
#define PROBE_PREP_PART -1
#endif
#ifndef PROBE_SSM_PART
#define PROBE_SSM_PART -1
#endif
#ifndef PROBE_T_LO
#define PROBE_T_LO -1
#define PROBE_T_HI -1
#define PROBE_T_MULT 4
#endif
#define GAS __attribute__((address_space(1)))
#define LAS __attribute__((address_space(3)))
typedef unsigned short bf16;
typedef short bf16x8 __attribute__((ext_vector_type(8)));
typedef float f32x4 __attribute__((ext_vector_type(4)));
typedef float f32x2 __attribute__((ext_vector_type(2)));
typedef unsigned u32x4 __attribute__((ext_vector_type(4)));
typedef unsigned u32x2 __attribute__((ext_vector_type(2)));

constexpr int D = 1024, NBATCH = 2, SEQ = 16384, CTXL = 256, GRIDW = 64, EW = 2048, NG = 128, NST = 64, PG = 16;
constexpr int RL = NBATCH * SEQ;
constexpr int RC = NBATCH * CTXL;
constexpr int RT = RL + RC;
constexpr int TCH = 32;
constexpr int TP = TCH * PG;
constexpr int XLD = TP + 4 * NST;
constexpr int NCHB = SEQ / TCH;
constexpr int NCOL = NBATCH * NCHB;
constexpr int PSTR = 2 * TCH * PG;
constexpr int KRG = PG * PSTR;
constexpr float LN_EPS = 1e-5f;
constexpr float DN_ALPHA = 1.41421356237f;

constexpr size_t MiB = 1u << 20;
constexpr size_t WS_CTL = 0, CTL_ZERO_BYTES = 128 * 1024;
constexpr size_t WS_MOD = 1 * MiB;
constexpr size_t WS_ZA = 1 * MiB + 256 * 1024;
constexpr size_t WS_BBG = 2 * MiB;
constexpr size_t WS_WG = 6 * MiB, WS_W5 = 14 * MiB, WS_W3 = 18 * MiB;
constexpr size_t WS_KR = 26 * MiB;
constexpr size_t WS_M4 = 34 * MiB;
constexpr size_t WS_HX = 98 * MiB;
constexpr size_t WS_X = 163 * MiB;
constexpr size_t WS_A2 = 163 * MiB;
constexpr size_t WS_SZ = 195 * MiB;
constexpr size_t WS_M2 = 355 * MiB;
constexpr size_t WS_G = 355 * MiB;
constexpr size_t WS_S = 355 * MiB + 256 * 1024;
constexpr size_t WS_UCTX = 483 * MiB;
constexpr size_t WS_W1 = 484 * MiB, WS_W2 = 500 * MiB;
constexpr size_t WS_Y1S = 294 * MiB;
constexpr size_t WS_UCS = 484 * MiB;
constexpr size_t WS_FO = 163 * MiB;
constexpr size_t WS_A4 = 34 * MiB;
constexpr size_t WS_END = 504 * MiB;
constexpr size_t HXPLANE = (size_t)RT * 128;
constexpr size_t A4PLANE = (size_t)RL * 128;
constexpr size_t GPLANE = (size_t)RL * 32;
constexpr size_t XPLANE = (size_t)NCOL * XLD * 2;
static_assert(WS_X + (size_t)NG * XPLANE <= WS_M2 && WS_A2 + 32 * HXPLANE <= WS_M2 && WS_Y1S + 8 * (size_t)RC * D * 4 <= WS_M2, "map");
static_assert(WS_HX + 16 * HXPLANE <= WS_X && 16 * HXPLANE <= (size_t)RL * D * 4, "map");
static_assert(WS_G + (size_t)NG * GPLANE <= WS_UCTX && WS_SZ + (size_t)RL * 2048 * 2 <= WS_X + (size_t)NG * XPLANE && WS_A4 + 32 * A4PLANE <= WS_X, "map");
static_assert(WS_M4 + (size_t)NG * TP * 256 * 2 <= WS_HX && WS_KR + (size_t)NG * KRG * 2 <= WS_M4 && (size_t)256 * TP * 2 == 256 * 1024 && (size_t)NCOL * 256 * 2 == 512 * 1024 && GPLANE == MiB && WS_W2 + 4 * MiB <= WS_END, "map");
constexpr int CW_BAR = 4096, CW_MOD = 8000, CW_PAIR = 8192;

constexpr int RING_BYTES = 131072;
constexpr int XL_OFF = RING_BYTES;
constexpr int XL_BYTES = 2048;
constexpr int CWL_OFF = XL_OFF + XL_BYTES;
constexpr int MISC_OFF = CWL_OFF + 3 * 2048 * 4;
constexpr int LDS_BYTES = MISC_OFF + 128;

#define RLX_AGENT __ATOMIC_RELAXED, __HIP_MEMORY_SCOPE_AGENT
#define LDS_WAIT() asm volatile("s_waitcnt lgkmcnt(0)" ::: "memory")
#define VM_WAIT() asm volatile("s_waitcnt vmcnt(0)" ::: "memory")
__host__ __device__ __forceinline__ unsigned f2bf(float f) { unsigned u = __builtin_bit_cast(unsigned, f); return (u + 0x7fffu + ((u >> 16) & 1u)) >> 16; }
typedef __bf16 bf16x2_t __attribute__((ext_vector_type(2)));
__host__ __device__ __forceinline__ unsigned pk2(float lo, float hi) {
#if defined(__HIP_DEVICE_COMPILE__)
    const f32x2 v = {lo, hi}; return __builtin_bit_cast(unsigned, __builtin_convertvector(v, bf16x2_t));
#else
    return f2bf(lo) | (f2bf(hi) << 16);
#endif
}
__host__ __device__ __forceinline__ float bf2f(unsigned b) { return __builtin_bit_cast(float, (b & 0xffffu) << 16); }
__device__ __forceinline__ float sigmoidf_(float x) { return __builtin_amdgcn_rcpf(1.0f + __expf(-x)); }
__device__ __forceinline__ float siluf_(float x) { return x * sigmoidf_(x); }
__device__ __forceinline__ float gelu_tanh(float x) { return x * sigmoidf_(1.5957691216f * (x + 0.044715f * x * x * x)); }
__device__ __forceinline__ float wave_sum(float v) {
#pragma unroll
    for (int o = 1; o < 64; o <<= 1) v += __shfl_xor(v, o);
    return v;
}

__device__ __forceinline__ float dpp_from_prev(float carry, float v) { return __builtin_bit_cast(float, __builtin_amdgcn_update_dpp(__builtin_bit_cast(int, carry), __builtin_bit_cast(int, v), 0x111, 0xf, 0xf, false)); }
__device__ __forceinline__ float dpp_from_next(float carry, float v) { return __builtin_bit_cast(float, __builtin_amdgcn_update_dpp(__builtin_bit_cast(int, carry), __builtin_bit_cast(int, v), 0x101, 0xf, 0xf, false)); }
__device__ __forceinline__ float dpp_ror1(float v) { return __builtin_bit_cast(float, __builtin_amdgcn_update_dpp(0, __builtin_bit_cast(int, v), 0x121, 0xf, 0xf, false)); }
__device__ __forceinline__ float dpp_ror15(float v) { return __builtin_bit_cast(float, __builtin_amdgcn_update_dpp(0, __builtin_bit_cast(int, v), 0x12F, 0xf, 0xf, false)); }
#define XB_TMO      128
#define XB_XCNT(j)  (256  + 64 * (j))
#define XB_XSUB(j)  (1280 + 64 * (j))
#define XB_XGEN(j)  (2304 + 64 * (j))
#define XB_TOP      3328
#define XB_TOPGEN   3392
#define XCD_BAR_WORDS 3456
#define XB_SPIN_CAP (1u << 20)
__device__ __forceinline__ unsigned xb_ld(unsigned* p)              { return __hip_atomic_load(p, __ATOMIC_RELAXED, __HIP_MEMORY_SCOPE_AGENT); }
__device__ __forceinline__ unsigned xb_add(unsigned* p, unsigned v) { return __hip_atomic_fetch_add(p, v, __ATOMIC_RELAXED, __HIP_MEMORY_SCOPE_AGENT); }
__device__ __forceinline__ unsigned xb_xcc_id() { return (unsigned)__builtin_amdgcn_s_getreg((3 << 11) | 20) & 0xFu; }
#define XB_SPIN(cond, bar) do { unsigned _sp = 0; while (cond) { __builtin_amdgcn_s_sleep(1); \
    if ((++_sp & 255u) == 0u) { if (xb_ld(&(bar)[XB_TMO])) break; if (_sp > XB_SPIN_CAP) { atomicAdd(&(bar)[XB_TMO], 1u); break; } } } } while (0)
struct XcdBarrier { unsigned* bar; unsigned x; volatile LAS unsigned* st; };
__device__ __forceinline__ XcdBarrier xcd_barrier_post(unsigned* bar, volatile LAS unsigned* st) {
    XcdBarrier b; b.bar = bar; b.x = xb_xcc_id(); b.st = st;
    if (threadIdx.x == 0) (void)xb_add(&bar[XB_XCNT(b.x)], 1u);
    return b;
}
__device__ __forceinline__ void xcd_barrier_complete(unsigned* bar, unsigned x, unsigned& nloc, unsigned& nx) {
    const unsigned G = gridDim.x * gridDim.y * gridDim.z;
    unsigned sum, cnt, mine, sp = 0u;
    for (;;) {
        sum = 0u; cnt = 0u; mine = 0u;
#pragma unroll
        for (unsigned j = 0; j < 16; ++j) { const unsigned c = xb_ld(&bar[XB_XCNT(j)]); sum += c; cnt += (c > 0u) ? 1u : 0u; mine = (j == x) ? c : mine; }
        if (sum == G) break;
        __builtin_amdgcn_s_sleep(1);
        if ((++sp & 255u) == 0u) { if (xb_ld(&bar[XB_TMO])) break; if (sp > XB_SPIN_CAP) { atomicAdd(&bar[XB_TMO], 1u); break; } }
    }
    nloc = mine > 0u ? mine : 1u; nx = cnt > 0u ? cnt : 1u;
}
__device__ __forceinline__ void xcd_barrier(const XcdBarrier& b) {
    asm volatile("s_waitcnt vmcnt(0)" ::: "memory");
    __syncthreads();
    if (threadIdx.x == 0) {
        unsigned* bar = b.bar;
        __builtin_amdgcn_s_waitcnt(0);
        unsigned nloc = b.st[0], nx = b.st[1];
        if (nloc == 0u) { xcd_barrier_complete(bar, b.x, nloc, nx); b.st[0] = nloc; b.st[1] = nx; }
        const unsigned old = xb_add(&bar[XB_XSUB(b.x)], 1u);
        const unsigned gen = old / nloc;
        if (old + 1u == (gen + 1u) * nloc) {
            __builtin_amdgcn_fence(__ATOMIC_RELEASE, "agent");
            asm volatile("s_waitcnt vmcnt(0)" ::: "memory");
            const unsigned og = xb_add(&bar[XB_TOP], 1u);
            const unsigned tg = og / nx;
            if (og + 1u == (tg + 1u) * nx) xb_add(&bar[XB_TOPGEN], 1u);
            else XB_SPIN(xb_ld(&bar[XB_TOPGEN]) == tg, bar);
            __builtin_amdgcn_fence(__ATOMIC_ACQUIRE, "agent");
            xb_add(&bar[XB_XGEN(b.x)], 1u);
            asm volatile("s_waitcnt vmcnt(0)" ::: "memory");
        } else {
            XB_SPIN(xb_ld(&bar[XB_XGEN(b.x)]) == gen, bar);
            __builtin_amdgcn_fence(__ATOMIC_ACQUIRE, "agent");
            asm volatile("s_waitcnt vmcnt(0)" ::: "memory");
        }
    }
    __syncthreads();
}

struct Args {
    const float* in[23];
    float* out; unsigned char* ws;
    int ph_lo, ph_hi;
};
enum { I_X = 0, I_C, I_CTX, I_CCTX, I_ADAW, I_ADAB, I_LNG, I_LNB, I_CWIN, I_CW, I_CWOUT, I_SWIN, I_LRE, I_LIM, I_LSTEP, I_BRE, I_BIM, I_CRE, I_CIM, I_SD, I_WGLU, I_BGLU, I_SWOUT };

namespace g8 {
constexpr int BM = 256, BK = 64, HALF = 128, HTB = HALF * BK * 2, NXCD = 8, WGM = 8;
__host__ __device__ __forceinline__ int lds_byte(int r, int c) { const int st = (r >> 4) * 2 + (c >> 5), rr = r & 15, cc = c & 31, ob = rr * 64 + cc * 2; return st * 1024 + (ob ^ (((ob >> 9) & 1) << 5)); }
__host__ __device__ __forceinline__ void stage_rc(int b, int& R, int& C) { const int st = b / 1024, sb = b % 1024, swz = sb ^ (((sb >> 9) & 1) << 5); R = (st >> 1) * 16 + swz / 64; C = (st & 1) * 32 + (swz % 64) / 2; }
__host__ __device__ __forceinline__ int perm32(int rho) { const int n = rho >> 4, i = rho & 15; return 8 * (i >> 2) + 4 * n + (i & 3); }

struct Unit { int pm, pn, g, ks; };
__host__ __device__ __forceinline__ int xcd_remap(int L, int nwg) { const int q = nwg / NXCD, r = nwg % NXCD, xcd = L % NXCD, off = L / NXCD; return (xcd < r ? xcd * (q + 1) : r * (q + 1) + (xcd - r) * q) + off; }
__host__ __device__ __forceinline__ bool order_mn(int L, int nM, int nN, Unit& u) {
    const int nwg = nM * nN; if (L >= nwg) return false;
    const int wgid = xcd_remap(L, nwg);
    const int nig = WGM * nN, gid = wgid / nig, fm = gid * WGM, gsz = (nM - fm) < WGM ? (nM - fm) : WGM;
    u.pm = fm + ((wgid % nig) % gsz); u.pn = (wgid % nig) / gsz; u.g = 0; u.ks = 0; return true;
}
__host__ __device__ __forceinline__ bool order_g(int L, int ng, int nM, int nN, Unit& u) {
    const int per = nM * nN, nwg = ng * per; if (L >= nwg) return false;
    const int wgid = xcd_remap(L, nwg);
    u.g = wgid / per; const int rem = wgid % per; u.pm = rem / nN; u.pn = rem % nN; u.ks = 0; return true;
}

__device__ __forceinline__ unsigned cvt_pk_bf16(float lo, float hi) { unsigned r; asm volatile("v_cvt_pk_bf16_f32 %0, %1, %2" : "=v"(r) : "v"(lo), "v"(hi)); return r; }

typedef f32x4 Acc[2][2][4][2];

template <class P>
__device__ __forceinline__ void gemm_phase(LAS unsigned char* lds, const P& p, const int G, const int c) {
    int tid = threadIdx.x; asm volatile("" : "+v"(tid));
    const int wid = __builtin_amdgcn_readfirstlane(tid >> 6), lane = tid & 63, wr = wid >> 2, wc = wid & 3, fr = lane & 15, fq = lane >> 4;
    constexpr int NS = P::NSEG; constexpr int S1 = NS - 1;
    const int nt0 = p.nt0();
    unsigned voffA0, voffA1, voffB0, voffB1;
    { int R, C; stage_rc(tid * 16, R, C); const int Rb = P::PERM ? ((R & ~31) + perm32(R & 31)) : R;
      voffA0 = (unsigned)(p.a_off(0, R, C) - p.a_off(0, 0, 0) + p.a_bias(0)); voffB0 = (unsigned)(p.b_off(0, Rb, C) - p.b_off(0, 0, 0) + p.b_bias(0));
      voffA1 = (unsigned)(p.a_off(S1, R, C) - p.a_off(S1, 0, 0) + p.a_bias(S1)); voffB1 = (unsigned)(p.b_off(S1, Rb, C) - p.b_off(S1, 0, 0) + p.b_bias(S1)); }
    const long r64A0 = p.a_off(0, 64, 0) - p.a_off(0, 0, 0), r64A1 = p.a_off(S1, 64, 0) - p.a_off(S1, 0, 0), r64B0 = p.b_off(0, 64, 0) - p.b_off(0, 0, 0), r64B1 = p.b_off(S1, 64, 0) - p.b_off(S1, 0, 0);
    const long hA0 = p.a_off(0, 128, 0) - p.a_off(0, 0, 0), hA1 = p.a_off(S1, 128, 0) - p.a_off(S1, 0, 0), hB0 = p.b_off(0, 128, 0) - p.b_off(0, 0, 0), hB1 = p.b_off(S1, 128, 0) - p.b_off(S1, 0, 0);
    const long ksA0 = p.a_off(0, 0, 64) - p.a_off(0, 0, 0), ksA1 = p.a_off(S1, 0, 64) - p.a_off(S1, 0, 0), ksB0 = p.b_off(0, 0, 64) - p.b_off(0, 0, 0), ksB1 = p.b_off(S1, 0, 64) - p.b_off(S1, 0, 0);
    const unsigned ldsw = (unsigned)wid * 1024u;
    const int aoff = lds_byte(wr * 64 + fr, fq * 8), boff = lds_byte(wc * 32 + fr, fq * 8);
#define G8_SA(b, h) (((b) * 2 + (h)) * HTB)
#define G8_SB(b, h) ((4 + (b) * 2 + (h)) * HTB)
#define G8_STAGE1(bufoff, gptr, voff, r64) do { \
        __builtin_amdgcn_global_load_lds((const unsigned*)((gptr) + (voff)), (LAS unsigned*)(lds + (bufoff) + ldsw), 16, 0, 0); \
        __builtin_amdgcn_global_load_lds((const unsigned*)((gptr) + (r64) + (voff)), (LAS unsigned*)(lds + (bufoff) + ldsw + 8192), 16, 0, 0); } while (0)
#define G8_STA(bufoff, ptr, sg, h) G8_STAGE1(bufoff, (ptr) + (h) * ((sg) ? hA1 : hA0), ((sg) ? voffA1 : voffA0), ((sg) ? r64A1 : r64A0))
#define G8_STB(bufoff, ptr, sg, h) G8_STAGE1(bufoff, (ptr) + (h) * ((sg) ? hB1 : hB0), ((sg) ? voffB1 : voffB0), ((sg) ? r64B1 : r64B0))
#define G8_LDA(dst, b, h) do { _Pragma("unroll") for (int m = 0; m < 4; ++m) _Pragma("unroll") for (int k = 0; k < 2; ++k) dst[m][k] = *(const LAS bf16x8*)(lds + G8_SA(b, h) + aoff + m * 2048 + k * 1024); } while (0)
#define G8_LDB(dst, b, h) do { _Pragma("unroll") for (int n = 0; n < 2; ++n) _Pragma("unroll") for (int k = 0; k < 2; ++k) dst[n][k] = *(const LAS bf16x8*)(lds + G8_SB(b, h) + boff + n * 2048 + k * 1024); } while (0)
#define G8_MMA(ai, bj, At, Bt) do { __builtin_amdgcn_s_setprio(1); _Pragma("unroll") for (int m = 0; m < 4; ++m) _Pragma("unroll") for (int n = 0; n < 2; ++n) _Pragma("unroll") for (int k = 0; k < 2; ++k) \
        acc[ai][bj][m][n] = __builtin_amdgcn_mfma_f32_16x16x32_bf16(Bt[n][k], At[m][k], acc[ai][bj][m][n], 0, 0, 0); __builtin_amdgcn_s_setprio(0); } while (0)
#define G8_WAIT_V(n) asm volatile("s_waitcnt vmcnt(" #n ")" ::: "memory")
#define G8_WAIT_L(n) asm volatile("s_waitcnt lgkmcnt(" #n ")" ::: "memory")
#define G8_BAR __builtin_amdgcn_s_barrier()
#define G8_SCHED __builtin_amdgcn_sched_barrier(0)
    Unit cur, nxt; int ui = 0;
    if (!p.unit(c, cur)) return;
    Acc acc;
#pragma unroll
    for (int a = 0; a < 2; ++a)
#pragma unroll
        for (int b = 0; b < 2; ++b)
#pragma unroll
            for (int m = 0; m < 4; ++m)
#pragma unroll
                for (int n = 0; n < 2; ++n) acc[a][b][m][n] = (f32x4){0.f, 0.f, 0.f, 0.f};
    bf16x8 At[4][2], B0[2][2], B1[2][2];
    const char* cA0 = p.a_base(cur, 0) - p.a_bias(0); const char* cA1 = p.a_base(cur, S1) - p.a_bias(S1);
    const char* cB0 = p.b_base(cur, 0) - p.b_bias(0); const char* cB1 = p.b_base(cur, S1) - p.b_bias(S1);
    G8_STB(G8_SB(0, 0), cB0, false, 0); G8_STB(G8_SB(0, 1), cB0, false, 1); G8_STA(G8_SA(0, 0), cA0, false, 0); G8_STA(G8_SA(0, 1), cA0, false, 1);
    if (wr == 1) G8_BAR;
    G8_WAIT_V(2); G8_BAR;
    G8_STB(G8_SB(1, 0), cB0 + ksB0, false, 0); G8_STA(G8_SA(1, 0), cA0 + ksA0, false, 0); G8_STB(G8_SB(1, 1), cB0 + ksB0, false, 1);
    G8_WAIT_V(6); G8_BAR;
    for (;;) {
        const bool has_next = p.unit((ui + 1) * G + c, nxt);
        const int nt = p.nt(cur);
        const char* nA0 = has_next ? p.a_base(nxt, 0) - p.a_bias(0) : cA0; const char* nA1 = has_next ? p.a_base(nxt, S1) - p.a_bias(S1) : cA1;
        const char* nB0 = has_next ? p.b_base(nxt, 0) - p.b_bias(0) : cB0; const char* nB1 = has_next ? p.b_base(nxt, S1) - p.b_bias(S1) : cB1;
        for (int t = 0; t < nt; t += 2) {
            const bool last = (t == nt - 2);
            const bool sg1 = (NS > 1) && (t + 1 >= nt0);
            const bool sg2 = (NS > 1) && !last && (t + 2 >= nt0);
            const char* a1 = sg1 ? cA1 + (long)(t + 1 - nt0) * ksA1 : cA0 + (long)(t + 1) * ksA0;
            const char* a2 = last ? nA0 : (sg2 ? cA1 + (long)(t + 2 - nt0) * ksA1 : cA0 + (long)(t + 2) * ksA0);
            const char* b2 = last ? nB0 : (sg2 ? cB1 + (long)(t + 2 - nt0) * ksB1 : cB0 + (long)(t + 2) * ksB0);
            const char* a3 = a2 + (sg2 ? ksA1 : ksA0); const char* b3 = b2 + (sg2 ? ksB1 : ksB0);
            G8_LDB(B0, 0, 0); G8_LDB(B1, 0, 1); G8_SCHED; G8_LDA(At, 0, 0); G8_STA(G8_SA(1, 1), a1, sg1, 1);
            G8_WAIT_V(8); G8_WAIT_L(0); G8_BAR; G8_MMA(0, 0, At, B0); G8_MMA(0, 1, At, B1); G8_BAR; G8_SCHED;
            G8_LDA(At, 0, 1); G8_STB(G8_SB(0, 0), b2, sg2, 0); G8_STB(G8_SB(0, 1), b2, sg2, 1); G8_STA(G8_SA(0, 0), a2, sg2, 0);
            G8_WAIT_V(8); G8_WAIT_L(0); G8_BAR; G8_MMA(1, 0, At, B0); G8_MMA(1, 1, At, B1); G8_BAR; G8_SCHED;
            G8_LDB(B0, 1, 0); G8_LDB(B1, 1, 1); G8_SCHED; G8_LDA(At, 1, 0); G8_STA(G8_SA(0, 1), a2, sg2, 1);
            G8_WAIT_V(8); G8_WAIT_L(0); G8_BAR; G8_MMA(0, 0, At, B0); G8_MMA(0, 1, At, B1); G8_BAR; G8_SCHED;
            G8_LDA(At, 1, 1); G8_STB(G8_SB(1, 0), b3, sg2, 0); G8_STB(G8_SB(1, 1), b3, sg2, 1); G8_STA(G8_SA(1, 0), a3, sg2, 0);
            G8_WAIT_V(8); G8_WAIT_L(0); G8_BAR; G8_MMA(1, 0, At, B0); G8_MMA(1, 1, At, B1); G8_BAR; G8_SCHED;
        }
        if (wr == 0) G8_BAR;
        p.epi(acc, cur, wr, wc, fr, fq, lds);
        if (!has_next) break;
#pragma unroll
        for (int a = 0; a < 2; ++a)
#pragma unroll
            for (int b = 0; b < 2; ++b)
#pragma unroll
                for (int m = 0; m < 4; ++m)
#pragma unroll
                    for (int n = 0; n < 2; ++n) acc[a][b][m][n] = (f32x4){0.f, 0.f, 0.f, 0.f};
        cur = nxt; ++ui; cA0 = nA0; cA1 = nA1; cB0 = nB0; cB1 = nB1;
        if (wr == 1) G8_BAR;
    }
    G8_WAIT_V(0);
    G8_BAR;
#undef G8_SA
#undef G8_SB
#undef G8_STAGE1
#undef G8_STA
#undef G8_STB
#undef G8_LDA
#undef G8_LDB
#undef G8_MMA
#undef G8_WAIT_V
#undef G8_WAIT_L
#undef G8_BAR
#undef G8_SCHED
}

template <class P>
__device__ __forceinline__ void gemm_phase_naive(LAS unsigned char* lds, const P& p, const int G, const int c) {
    const int tid = threadIdx.x, wid = tid >> 6, lane = tid & 63, wr = wid >> 2, wc = wid & 3, fr = lane & 15, fq = lane >> 4;
    LAS float* As = (LAS float*)lds;
    LAS float* Bs = As + 16 * 260;
    const int nt0 = p.nt0();
    Unit u;
    for (int ui = 0; p.unit(ui * G + c, u); ++ui) {
        const int nt = p.nt(u);
        Acc acc;
#pragma unroll
        for (int a = 0; a < 2; ++a)
#pragma unroll
            for (int b = 0; b < 2; ++b)
#pragma unroll
                for (int m = 0; m < 4; ++m)
#pragma unroll
                    for (int n = 0; n < 2; ++n) acc[a][b][m][n] = (f32x4){0.f, 0.f, 0.f, 0.f};
        for (int k0 = 0; k0 < nt * 64; k0 += 16) {
            const int seg = (P::NSEG > 1 && k0 >= nt0 * 64) ? 1 : 0, ks = k0 - (seg ? nt0 * 64 : 0);
            { const int row = tid >> 1, h8 = tid & 1;
              const u32x4 va = *(const u32x4*)(p.a_base(u, seg) + p.a_off(seg, row, ks + 8 * h8));
              const u32x4 vb = *(const u32x4*)(p.b_base(u, seg) + p.b_off(seg, row, ks + 8 * h8));
              __syncthreads();
#pragma unroll
              for (int i = 0; i < 4; ++i) { As[(8 * h8 + 2 * i) * 260 + row] = bf2f(va[i]); As[(8 * h8 + 2 * i + 1) * 260 + row] = bf2f(va[i] >> 16);
                                            Bs[(8 * h8 + 2 * i) * 260 + row] = bf2f(vb[i]); Bs[(8 * h8 + 2 * i + 1) * 260 + row] = bf2f(vb[i] >> 16); }
              __syncthreads(); }
            for (int kk = 0; kk < 16; ++kk) {
                float av[2][4], bv[2][2][4];
#pragma unroll
                for (int ai = 0; ai < 2; ++ai)
#pragma unroll
                    for (int m = 0; m < 4; ++m) av[ai][m] = As[kk * 260 + ai * 128 + wr * 64 + m * 16 + fr];
#pragma unroll
                for (int bj = 0; bj < 2; ++bj)
#pragma unroll
                    for (int n = 0; n < 2; ++n)
#pragma unroll
                        for (int j = 0; j < 4; ++j) bv[bj][n][j] = Bs[kk * 260 + bj * 128 + wc * 32 + (P::PERM ? 8 * fq + 4 * n + j : 16 * n + 4 * fq + j)];
#pragma unroll
                for (int ai = 0; ai < 2; ++ai)
#pragma unroll
                    for (int bj = 0; bj < 2; ++bj)
#pragma unroll
                        for (int m = 0; m < 4; ++m)
#pragma unroll
                            for (int n = 0; n < 2; ++n)
#pragma unroll
                                for (int j = 0; j < 4; ++j) acc[ai][bj][m][n][j] += av[ai][m] * bv[bj][n][j];
            }
        }
        __syncthreads();
        p.epi(acc, u, wr, wc, fr, fq, lds);
        __syncthreads();
    }
}


struct ProbG1 {
    static constexpr bool PERM = false; static constexpr int NSEG = 1;
    const char* HX; const char* HXV; const char* W1; const float* convw; char* A2;
    __host__ __device__ int nt0() const { return 16; } __host__ __device__ int nt(const Unit&) const { return 16; }
    __host__ __device__ long a_bias(int) const { return 0; } __host__ __device__ long b_bias(int) const { return 0; }
    __host__ __device__ bool unit(int L, Unit& u) const { return order_mn(L, RT / 256, 32, u); }
    __host__ __device__ const char* a_base(const Unit& u, int) const { return ((u.pn < 16 || u.pm >= 128) ? HX : HXV) + (size_t)u.pm * 256 * 128; }
    __host__ __device__ long a_off(int, int r, int k) const { return (long)r * 128 + (long)(k >> 6) * (long)HXPLANE + (k & 63) * 2; }
    __host__ __device__ const char* b_base(const Unit& u, int) const { return W1 + (size_t)u.pn * 256 * 128; }
    __host__ __device__ long b_off(int, int c, int k) const { return (long)c * 128 + (long)(k >> 6) * (8192L * 128) + (k & 63) * 2; }
    __device__ __forceinline__ void epi(Acc& acc, const Unit& u, int wr, int wc, int fr, int fq, LAS unsigned char* lds) const {
        LAS float* xb = (LAS float*)(lds + XL_OFF); const LAS float* cw = (const LAS float*)(lds + CWL_OFF);
        const bool chain = (u.pn >= 16) || (u.pm >= 128);
        const bool vert = (u.pn >= 16) && (u.pm < 128);
        const int ch0 = wc * 16 + fq * 4, chg = u.pn * 64 + ch0;
        const f32x4 w0 = *(const LAS f32x4*)(cw + chg), w1 = *(const LAS f32x4*)(cw + 2048 + chg), w2 = *(const LAS f32x4*)(cw + 4096 + chg);
        f32x4 uu[2][4];
#pragma unroll
        for (int ai = 0; ai < 2; ++ai)
#pragma unroll
            for (int m = 0; m < 4; ++m) uu[ai][m] = acc[ai][0][m][1] * acc[ai][1][m][0];
        f32x4 bu[2] = {{0.f, 0.f, 0.f, 0.f}, {0.f, 0.f, 0.f, 0.f}}, bd[2] = {{0.f, 0.f, 0.f, 0.f}, {0.f, 0.f, 0.f, 0.f}};
        if (chain) {
            const int sl = ch0;
#pragma unroll
            for (int ai = 0; ai < 2; ++ai) { const int bi = 2 * ai + wr;
                if (fr == 0) *(LAS f32x4*)(xb + (bi * 2 + 0) * 64 + sl) = uu[ai][0];
                if (fr == 15) *(LAS f32x4*)(xb + (bi * 2 + 1) * 64 + sl) = uu[ai][3]; }
            LDS_WAIT(); __builtin_amdgcn_s_barrier();
#pragma unroll
            for (int ai = 0; ai < 2; ++ai) { const int bi = 2 * ai + wr;
                if (bi > 0) bu[ai] = *(const LAS f32x4*)(xb + ((bi - 1) * 2 + 1) * 64 + sl);
                if (bi < 3) bd[ai] = *(const LAS f32x4*)(xb + ((bi + 1) * 2 + 0) * 64 + sl); }
        }
#pragma unroll
        for (int ai = 0; ai < 2; ++ai)
#pragma unroll
            for (int m = 0; m < 4; ++m) {
                const int rt = ai * 128 + wr * 64 + m * 16 + fr;
                f32x4 upv, dnv;
#pragma unroll
                for (int j = 0; j < 4; ++j) {
                    const float cu = (m == 0) ? bu[ai][j] : dpp_ror1(uu[ai][m > 0 ? m - 1 : 0][j]);
                    upv[j] = dpp_from_prev(cu, uu[ai][m][j]);
                    const float cd = (m == 3) ? bd[ai][j] : dpp_ror15(uu[ai][m < 3 ? m + 1 : 3][j]);
                    dnv[j] = dpp_from_next(cd, uu[ai][m][j]); }
                const f32x4 yc = w1 * uu[ai][m] + w0 * upv + w2 * dnv;
                const f32x4 bgv = acc[ai][0][m][0], zv = acc[ai][1][m][1];
                f32x4 o;
#pragma unroll
                for (int j = 0; j < 4; ++j) o[j] = bgv[j] * yc[j] * siluf_(zv[j]);
                const int tok = vert ? ((u.pm >> 6) * SEQ + rt * GRIDW + (u.pm & 63)) : (u.pm * 256 + rt);
                u32x2 w; w.x = pk2(o[0], o[1]); w.y = pk2(o[2], o[3]);
                *(u32x2*)(A2 + (size_t)u.pn * HXPLANE + (size_t)tok * 128 + ch0 * 2) = w;
            }
    }
};

struct ProbG2 {
    static constexpr bool PERM = true; static constexpr int NSEG = 1;
    const char* A2; const char* W2; const float* mod; char* f1; float* y1s;
    __host__ __device__ int nt0() const { return 32; } __host__ __device__ int nt(const Unit& u) const { return u.pm >= 128 ? 4 : 32; }
    __host__ __device__ long a_bias(int) const { return 0; } __host__ __device__ long b_bias(int) const { return 0; }
    __host__ __device__ bool unit(int L, Unit& u) const {
        if (L < 512) return order_mn(L, RL / 256, 4, u);
        const int idx = L - 512; if (idx >= 64) return false;
        u.ks = idx & 7; const int tile = idx >> 3; u.pm = 128 + (tile >> 2); u.pn = tile & 3; u.g = 0; return true; }
    __host__ __device__ const char* a_base(const Unit& u, int) const { return A2 + (size_t)u.pm * 256 * 128 + (size_t)u.ks * 4 * HXPLANE; }
    __host__ __device__ long a_off(int, int r, int k) const { return (long)r * 128 + (long)(k >> 6) * (long)HXPLANE + (k & 63) * 2; }
    __host__ __device__ const char* b_base(const Unit& u, int) const { return W2 + (size_t)u.pn * 256 * 128 + (size_t)u.ks * 4 * (1024 * 128); }
    __host__ __device__ long b_off(int, int c, int k) const { return (long)c * 128 + (long)(k >> 6) * (1024L * 128) + (k & 63) * 2; }
    __device__ __forceinline__ void epi(Acc& acc, const Unit& u, int wr, int wc, int fr, int fq, LAS unsigned char*) const {
        const int col0 = u.pn * 256 + wc * 32 + 8 * fq;
        if (u.pm >= 128) {
#pragma unroll
            for (int ai = 0; ai < 2; ++ai)
#pragma unroll
                for (int m = 0; m < 4; ++m) { float* rowp = y1s + ((size_t)u.ks * RC + (u.pm - 128) * 256 + ai * 128 + wr * 64 + m * 16 + fr) * D + col0;
#pragma unroll
                    for (int bj = 0; bj < 2; ++bj)
#pragma unroll
                        for (int n = 0; n < 2; ++n) *(f32x4*)(rowp + bj * 128 + n * 4) = acc[ai][bj][m][n]; }
            return; }
        const int rho = u.pm >> 6;
        f32x4 gt[2][2];
#pragma unroll
        for (int bj = 0; bj < 2; ++bj)
#pragma unroll
            for (int n = 0; n < 2; ++n) gt[bj][n] = *(const f32x4*)(mod + rho * 3072 + 2048 + col0 + bj * 128 + n * 4);
#pragma unroll
        for (int ai = 0; ai < 2; ++ai)
#pragma unroll
            for (int m = 0; m < 4; ++m) { char* rowp = f1 + (size_t)(u.pm * 256 + ai * 128 + wr * 64 + m * 16 + fr) * 4096 + 2048 + col0 * 2;
#pragma unroll
                for (int bj = 0; bj < 2; ++bj) { const f32x4 v0 = gt[bj][0] * acc[ai][bj][m][0], v1 = gt[bj][1] * acc[ai][bj][m][1];
                    u32x4 w; w.x = pk2(v0[0], v0[1]); w.y = pk2(v0[2], v0[3]); w.z = pk2(v1[0], v1[1]); w.w = pk2(v1[2], v1[3]);
                    *(u32x4*)(rowp + bj * 256) = w; } }
    }
};

struct ProbG3 {
    static constexpr bool PERM = true; static constexpr int NSEG = 1;
    const char* HX; const char* W3; char* X; float* ucs; char* SZ; int zhalf;
    __host__ __device__ int nt0() const { return 16; } __host__ __device__ int nt(const Unit& u) const { return u.pm >= 128 ? 4 : 16; }
    __host__ __device__ long a_bias(int) const { return 0; } __host__ __device__ long b_bias(int) const { return 0; }
    __host__ __device__ bool unit(int L, Unit& u) const {
        if (L < 1024) return order_mn(L, RL / 256, 8, u);
        const int idx = L - 1024; if (zhalf || idx >= 64) return false;
        u.ks = idx & 3; const int tile = idx >> 2; u.pm = 128 + (tile >> 3); u.pn = tile & 7; u.g = 0; return true; }
    __host__ __device__ const char* a_base(const Unit& u, int) const { return HX + (size_t)u.pm * 256 * 128 + (size_t)u.ks * 4 * HXPLANE; }
    __host__ __device__ long a_off(int, int r, int k) const { return (long)r * 128 + (long)(k >> 6) * (long)HXPLANE + (k & 63) * 2; }
    __host__ __device__ const char* b_base(const Unit& u, int) const { return W3 + (size_t)(zhalf * 2048 + u.pn * 256) * 128 + (size_t)u.ks * 4 * (4096 * 128); }
    __host__ __device__ long b_off(int, int c, int k) const { return (long)c * 128 + (long)(k >> 6) * (4096L * 128) + (k & 63) * 2; }
    __device__ __forceinline__ void epi(Acc& acc, const Unit& u, int wr, int wc, int fr, int fq, LAS unsigned char*) const {
#pragma unroll
        for (int ai = 0; ai < 2; ++ai)
#pragma unroll
            for (int m = 0; m < 4; ++m) { const int tok = u.pm * 256 + ai * 128 + wr * 64 + m * 16 + fr;
#pragma unroll
                for (int bj = 0; bj < 2; ++bj) { const int n0 = u.pn * 256 + bj * 128 + wc * 32 + 8 * fq;
                    f32x4 v0 = acc[ai][bj][m][0], v1 = acc[ai][bj][m][1];
                    if (u.pm >= 128) { float* rp = ucs + ((size_t)u.ks * RC + (tok - RL)) * 2048 + n0; *(f32x4*)rp = v0; *(f32x4*)(rp + 4) = v1; continue; }
                    if (zhalf) {
#pragma unroll
                        for (int j = 0; j < 4; ++j) { v0[j] = siluf_(v0[j]); v1[j] = siluf_(v1[j]); } }
                    u32x4 w; w.x = pk2(v0[0], v0[1]); w.y = pk2(v0[2], v0[3]); w.z = pk2(v1[0], v1[1]); w.w = pk2(v1[2], v1[3]);
                    if (zhalf) *(u32x4*)(SZ + ((size_t)tok * 2048 + n0) * 2) = w;
                    else { const int g = n0 >> 4, p0 = n0 & 15;
                        const int b = tok / SEQ, tt = tok % SEQ, col = b * NCHB + tt / TCH, t = tt % TCH;
                        *(u32x4*)(X + (size_t)g * XPLANE + ((size_t)col * XLD + t * 16 + p0) * 2) = w; } } }
    }
};
__device__ __forceinline__ void reduce_uctx(const float* ucs, char* UCTX, int gtid, int gthreads) {
    for (int idx = gtid; idx < RC * 256; idx += gthreads) { const int row = idx >> 8, n0 = (idx & 255) * 8;
        f32x4 a0 = {0.f, 0.f, 0.f, 0.f}, a1 = a0;
#pragma unroll
        for (int ks = 0; ks < 4; ++ks) { const float* rp = ucs + ((size_t)ks * RC + row) * 2048 + n0; a0 += *(const f32x4*)rp; a1 += *(const f32x4*)(rp + 4); }
        u32x4 w; w.x = pk2(a0[0], a0[1]); w.y = pk2(a0[2], a0[3]); w.z = pk2(a1[0], a1[1]); w.w = pk2(a1[2], a1[3]);
        *(u32x4*)(UCTX + (size_t)(n0 >> 4) * (RC * 32) + (size_t)row * 32 + (n0 & 15) * 2) = w; }
}

struct ProbS {
    static constexpr bool PERM = true; static constexpr int NSEG = 1;
    const char* X; const char* M2; char* S; int g, b;
    __host__ __device__ int nt0() const { return TP / 64; } __host__ __device__ int nt(const Unit&) const { return TP / 64; }
    __host__ __device__ long a_bias(int) const { return 0; } __host__ __device__ long b_bias(int) const { return 0; }
    __host__ __device__ bool unit(int L, Unit& u) const { if (L >= NCHB / 256) return false; u.g = g; u.pm = 0; u.pn = b * (NCHB / 256) + L; u.ks = 0; return true; }
    __host__ __device__ const char* a_base(const Unit& u, int) const { return M2 + (size_t)u.g * MiB; }
    __host__ __device__ long a_off(int, int r, int k) const { return (long)r * TP * 2 + k * 2; }
    __host__ __device__ const char* b_base(const Unit& u, int) const { return X + (size_t)u.g * XPLANE + (size_t)u.pn * 256 * XLD * 2; }
    __host__ __device__ long b_off(int, int c, int k) const { return (long)c * XLD * 2 + k * 2; }
    __device__ __forceinline__ void epi(Acc& acc, const Unit& u, int wr, int wc, int fr, int fq, LAS unsigned char*) const {
#pragma unroll
        for (int ai = 0; ai < 2; ++ai)
#pragma unroll
            for (int m = 0; m < 4; ++m) { const int j = ai * 128 + wr * 64 + m * 16 + fr;
                char* rowp = S + (size_t)u.g * MiB + ((size_t)j * NCOL + u.pn * 256 + wc * 32 + 8 * fq) * 2;
#pragma unroll
                for (int bj = 0; bj < 2; ++bj) { const f32x4 v0 = acc[ai][bj][m][0], v1 = acc[ai][bj][m][1];
                    u32x4 w; w.x = pk2(v0[0], v0[1]); w.y = pk2(v0[2], v0[3]); w.z = pk2(v1[0], v1[1]); w.w = pk2(v1[2], v1[3]);
                    *(u32x4*)(rowp + bj * 256) = w; } }
    }
};

struct ProbY {
    static constexpr bool PERM = true; static constexpr int NSEG = 2;
    const char* X; const char* KR; const char* M4; char* Gout; int g, b;
    __host__ __device__ int nt0() const { return TP / 64; } __host__ __device__ int nt(const Unit&) const { return XLD / 64; }
    __host__ __device__ long a_bias(int) const { return 0; } __host__ __device__ long b_bias(int seg) const { return seg ? 0 : 96; }
    __host__ __device__ bool unit(int L, Unit& u) const { constexpr int nN = TP / 256, nM = NCHB / 256; if (L >= nN * nM) return false; u.g = g; u.pm = b * nM + L / nN; u.pn = L % nN; u.ks = 0; return true; }
    __host__ __device__ const char* a_base(const Unit& u, int seg) const { return X + (size_t)u.g * XPLANE + (size_t)u.pm * 256 * XLD * 2 + (seg ? TP * 2 : 0); }
    __host__ __device__ long a_off(int, int r, int k) const { return (long)r * XLD * 2 + k * 2; }
    __host__ __device__ const char* b_base(const Unit& u, int seg) const {
        return seg ? M4 + (size_t)u.g * TP * 512 + (size_t)u.pn * 256 * 512 : KR + (size_t)u.g * KRG * 2 + (size_t)(TCH - 1 - 16 * u.pn) * 32; }
    __host__ __device__ long b_off(int seg, int c, int k) const { return seg ? (long)c * 512 + k * 2 : ((long)(c & 15) * PSTR - (long)(c >> 4) * 16 + k) * 2; }
    __device__ __forceinline__ void epi(Acc& acc, const Unit& u, int wr, int wc, int fr, int fq, LAS unsigned char*) const {
#pragma unroll
        for (int ai = 0; ai < 2; ++ai)
#pragma unroll
            for (int m = 0; m < 4; ++m) { const int col = u.pm * 256 + ai * 128 + wr * 64 + m * 16 + fr;
#pragma unroll
                for (int bj = 0; bj < 2; ++bj) { const int n0 = u.pn * 256 + bj * 128 + wc * 32 + 8 * fq;
                    const f32x4 v0 = acc[ai][bj][m][0], v1 = acc[ai][bj][m][1];
                    u32x4 w; w.x = pk2(gelu_tanh(v0[0]), gelu_tanh(v0[1])); w.y = pk2(gelu_tanh(v0[2]), gelu_tanh(v0[3]));
                    w.z = pk2(gelu_tanh(v1[0]), gelu_tanh(v1[1])); w.w = pk2(gelu_tanh(v1[2]), gelu_tanh(v1[3]));
                    *(u32x4*)(Gout + (size_t)u.g * GPLANE + ((size_t)col * TP + n0) * 2) = w; } }
    }
};

struct ProbG4 {
    static constexpr bool PERM = true; static constexpr int NSEG = 1;
    const char* Gin; const char* WG; const char* SZ; const float* bglu; char* A4;
    __host__ __device__ int nt0() const { return 32; } __host__ __device__ int nt(const Unit&) const { return 32; }
    __host__ __device__ long a_bias(int) const { return 0; } __host__ __device__ long b_bias(int) const { return 0; }
    __host__ __device__ bool unit(int L, Unit& u) const { return order_mn(L, RL / 256, 8, u); }
    __host__ __device__ const char* a_base(const Unit& u, int) const { return Gin + (size_t)u.pm * 256 * 32; }
    __host__ __device__ long a_off(int, int r, int k) const { return (long)(k >> 4) * (long)GPLANE + (long)r * 32 + (k & 15) * 2; }
    __host__ __device__ const char* b_base(const Unit& u, int) const { return WG + (size_t)u.pn * 256 * 128; }
    __host__ __device__ long b_off(int, int c, int k) const { return (long)c * 128 + (long)(k >> 6) * (2048L * 128) + (k & 63) * 2; }
    __device__ __forceinline__ void epi(Acc& acc, const Unit& u, int wr, int wc, int fr, int fq, LAS unsigned char*) const {
        f32x4 b0[2], b1[2];
#pragma unroll
        for (int bj = 0; bj < 2; ++bj) { const int n0 = u.pn * 256 + bj * 128 + wc * 32 + 8 * fq; b0[bj] = *(const f32x4*)(bglu + n0); b1[bj] = *(const f32x4*)(bglu + n0 + 4); }
#pragma unroll
        for (int ai = 0; ai < 2; ++ai) {
            u32x4 gv[4][2], sv[4][2];
#pragma unroll
            for (int m = 0; m < 4; ++m) { const int tok = u.pm * 256 + ai * 128 + wr * 64 + m * 16 + fr;
#pragma unroll
                for (int bj = 0; bj < 2; ++bj) { const int n0 = u.pn * 256 + bj * 128 + wc * 32 + 8 * fq;
                    gv[m][bj] = *(const u32x4*)(Gin + (size_t)(n0 >> 4) * GPLANE + (size_t)tok * 32 + (n0 & 15) * 2);
                    sv[m][bj] = *(const u32x4*)(SZ + ((size_t)tok * 2048 + n0) * 2); } }
#pragma unroll
            for (int m = 0; m < 4; ++m) { const int tok = u.pm * 256 + ai * 128 + wr * 64 + m * 16 + fr;
#pragma unroll
                for (int bj = 0; bj < 2; ++bj) { const int n0 = u.pn * 256 + bj * 128 + wc * 32 + 8 * fq;
                    const f32x4 v0 = acc[ai][bj][m][0] + b0[bj], v1 = acc[ai][bj][m][1] + b1[bj];
                    float o[8];
#pragma unroll
                    for (int i = 0; i < 4; ++i) { const float g0 = bf2f(gv[m][bj][i]), g1 = bf2f(gv[m][bj][i] >> 16), s0 = bf2f(sv[m][bj][i]), s1 = bf2f(sv[m][bj][i] >> 16);
                        const float a0 = (2 * i < 4) ? v0[2 * i] : v1[2 * i - 4], a1 = (2 * i + 1 < 4) ? v0[2 * i + 1] : v1[2 * i + 1 - 4];
                        o[2 * i] = g0 * sigmoidf_(a0) * s0; o[2 * i + 1] = g1 * sigmoidf_(a1) * s1; }
                    u32x4 w; w.x = pk2(o[0], o[1]); w.y = pk2(o[2], o[3]); w.z = pk2(o[4], o[5]); w.w = pk2(o[6], o[7]);
                    *(u32x4*)(A4 + (size_t)(n0 >> 6) * A4PLANE + (size_t)tok * 128 + (n0 & 63) * 2) = w; } } }
    }
};

struct ProbG5 {
    static constexpr bool PERM = true; static constexpr int NSEG = 1;
    const char* A4; const char* W5; const float* mod; char* fo;
    __host__ __device__ int nt0() const { return 32; } __host__ __device__ int nt(const Unit&) const { return 32; }
    __host__ __device__ long a_bias(int) const { return 0; } __host__ __device__ long b_bias(int) const { return 0; }
    __host__ __device__ bool unit(int L, Unit& u) const { return order_mn(L, RL / 256, 4, u); }
    __host__ __device__ const char* a_base(const Unit& u, int) const { return A4 + (size_t)u.pm * 256 * 128; }
    __host__ __device__ long a_off(int, int r, int k) const { return (long)r * 128 + (long)(k >> 6) * (long)A4PLANE + (k & 63) * 2; }
    __host__ __device__ const char* b_base(const Unit& u, int) const { return W5 + (size_t)u.pn * 256 * 128; }
    __host__ __device__ long b_off(int, int c, int k) const { return (long)c * 128 + (long)(k >> 6) * (1024L * 128) + (k & 63) * 2; }
    __device__ __forceinline__ void epi(Acc& acc, const Unit& u, int wr, int wc, int fr, int fq, LAS unsigned char*) const {
        const int rho = u.pm >> 6, col0 = u.pn * 256 + wc * 32 + 8 * fq;
        f32x4 gt[2][2];
#pragma unroll
        for (int bj = 0; bj < 2; ++bj)
#pragma unroll
            for (int n = 0; n < 2; ++n) gt[bj][n] = *(const f32x4*)(mod + (3 + rho) * 3072 + 2048 + col0 + bj * 128 + n * 4);
#pragma unroll
        for (int ai = 0; ai < 2; ++ai)
#pragma unroll
            for (int m = 0; m < 4; ++m) { char* rowp = fo + ((size_t)(u.pm * 256 + ai * 128 + wr * 64 + m * 16 + fr) * D + col0) * 2;
#pragma unroll
                for (int bj = 0; bj < 2; ++bj) { const f32x4 v0 = gt[bj][0] * acc[ai][bj][m][0], v1 = gt[bj][1] * acc[ai][bj][m][1];
                    u32x4 w; w.x = pk2(v0[0], v0[1]); w.y = pk2(v0[2], v0[3]); w.z = pk2(v1[0], v1[1]); w.w = pk2(v1[2], v1[3]);
                    *(u32x4*)(rowp + bj * 256) = w; } }
    }
};
}

struct Frame {
    LAS unsigned char* lds;
    int tid, lane, wave, G, bid;
    const float* in[23]; float* out; unsigned char* ws;
};

template <class RM>
__device__ __forceinline__ void transpose_item(const float* W, int K, int N, bf16* WT, LAS float* scr, int item, int lane, RM rowmap) {
    const int nblk = N / 64, kb = item / nblk, nb = item % nblk, k0 = 64 * kb, n0 = 64 * nb;
    f32x4 v[16];
#pragma unroll
    for (int i = 0; i < 16; ++i) v[i] = *(const f32x4*)(W + (size_t)(k0 + 4 * i + (lane >> 4)) * N + n0 + 4 * (lane & 15));
#pragma unroll
    for (int i = 0; i < 16; ++i) { LAS float* d = scr + (4 * i + (lane >> 4)) * 65 + 4 * (lane & 15); d[0] = v[i][0]; d[1] = v[i][1]; d[2] = v[i][2]; d[3] = v[i][3]; }
    LDS_WAIT(); asm volatile("" ::: "memory");
    const int c = lane & 7;
#pragma unroll
    for (int j = 0; j < 8; ++j) { const int n = (lane >> 3) + 8 * j; const LAS float* sp = scr + (8 * c) * 65 + n;
        u32x4 o; o.x = pk2(sp[0 * 65], sp[1 * 65]); o.y = pk2(sp[2 * 65], sp[3 * 65]); o.z = pk2(sp[4 * 65], sp[5 * 65]); o.w = pk2(sp[6 * 65], sp[7 * 65]);
        *(u32x4*)(WT + (size_t)kb * N * 64 + (size_t)rowmap(n0 + n) * 64 + 8 * c) = o; }
    LDS_WAIT(); asm volatile("" ::: "memory");
}
struct RowId { __device__ int operator()(int n) const { return n; } };
struct RowW1 { __device__ int operator()(int n) const { const int p = n >> 11, chg = n & 2047, nt = chg >> 6, ch = chg & 63; return nt * 256 + 128 * (p >> 1) + 16 * (p & 1) + 32 * (ch >> 4) + (ch & 15); } };

__device__ __forceinline__ void prep_ssm(Frame& F) {
    LAS float* fl = (LAS float*)F.lds;
    const int tid = F.tid;
    for (int prep_ = 0; prep_ < (PROBE_PREP_PART == 0 ? 2 : 1); ++prep_)
    for (int item = F.bid; item < 2 * NG; item += F.G) {
        const int g = item >> 1, r = item & 1;
        LAS float* Av = fl; LAS float* Fv = fl + 256; LAS float* BBs = fl + 512; LAS float* Cs = fl + 4608; LAS float* PW = fl + 8768;
        __syncthreads();
        float pbre[4], pbim[4], pcre[4], pcim[4];
#pragma unroll
        for (int it = 0; it < 4; ++it) { const int e = tid + 512 * it, rr = e >> 10, n = (e >> 4) & 63, q = e & 15, p = (e >> 6) & 15, nn = e & 63;
            pbre[it] = F.in[I_BRE][((size_t)(rr * NG + g) * 64 + n) * 16 + q]; pbim[it] = F.in[I_BIM][((size_t)(rr * NG + g) * 64 + n) * 16 + q];
            pcre[it] = F.in[I_CRE][((size_t)(rr * NG + g) * 16 + p) * 64 + nn]; pcim[it] = F.in[I_CIM][((size_t)(rr * NG + g) * 16 + p) * 64 + nn]; }
        if (tid < 128) { const int rr = tid >> 6, n = tid & 63;
            const float dt = expf(F.in[I_LSTEP][rr * NG + g]);
            const float lre = F.in[I_LRE][(rr * NG + g) * 64 + n], lim = F.in[I_LIM][(rr * NG + g) * 64 + n];
            const float mag = expf(lre * dt); float sn, cs; sincosf(lim * dt, &sn, &cs);
            const float ar = mag * cs, ai = mag * sn, qr = ar - 1.0f, qi = ai, den = lre * lre + lim * lim;
            Av[(rr * 64 + n) * 2] = ar; Av[(rr * 64 + n) * 2 + 1] = ai;
            Fv[(rr * 64 + n) * 2] = (qr * lre + qi * lim) / den; Fv[(rr * 64 + n) * 2 + 1] = (qi * lre - qr * lim) / den;
        }
        __syncthreads();
#pragma unroll
        for (int it = 0; it < 4; ++it) { const int e = tid + 512 * it, rr = e >> 10, n = (e >> 4) & 63, q = e & 15;
            const float bre = pbre[it], bim = pbim[it];
            const float fr_ = Fv[(rr * 64 + n) * 2], fi_ = Fv[(rr * 64 + n) * 2 + 1];
            const float bbr = fr_ * bre - fi_ * bim, bbi = fr_ * bim + fi_ * bre;
            BBs[e * 2] = bbr; BBs[e * 2 + 1] = bbi;
            if (rr == r) { float* bg = (float*)(F.ws + WS_BBG) + (((size_t)(r * NG + g) * 64 + n) * 16 + q) * 2; bg[0] = bbr; bg[1] = bbi; }
            const int p = (e >> 6) & 15, nn = e & 63;
            Cs[((rr * 16 + p) * 65 + nn) * 2] = pcre[it];
            Cs[((rr * 16 + p) * 65 + nn) * 2 + 1] = pcim[it]; }
        __syncthreads();
        if (tid < 64) { const int n = tid; const float ar = Av[(r * 64 + n) * 2], ai = Av[(r * 64 + n) * 2 + 1]; float pr = 1.f, pi = 0.f;
            for (int e = 0; e <= TCH; ++e) { PW[(n * 65 + e) * 2] = pr; PW[(n * 65 + e) * 2 + 1] = pi; const float nr = pr * ar - pi * ai, ni = pr * ai + pi * ar; pr = nr; pi = ni; }
            float* za = (float*)(F.ws + WS_ZA) + ((size_t)(r * NG + g) * 64 + n) * 4; za[0] = ar; za[1] = ai; za[2] = PW[(n * 65 + TCH) * 2]; za[3] = PW[(n * 65 + TCH) * 2 + 1]; }
        __syncthreads();
        { bf16* M2g = (bf16*)(F.ws + WS_M2 + (size_t)g * MiB);
          constexpr int TPR = TP / 8;
          const int k8 = (tid % TPR) * 8, s_ = k8 >> 4, q0 = k8 & 15, e = r ? s_ : (TCH - 1 - s_);
          for (int j = tid / TPR; j < 128; j += 512 / TPR) { const int cc = j >> 6, n = j & 63;
            const float pr = PW[(n * 65 + e) * 2], pi = PW[(n * 65 + e) * 2 + 1];
            float v[8];
#pragma unroll
            for (int i = 0; i < 8; ++i) { const float br_ = BBs[((r * 64 + n) * 16 + q0 + i) * 2], bi_ = BBs[((r * 64 + n) * 16 + q0 + i) * 2 + 1]; v[i] = cc ? (pr * bi_ + pi * br_) : (pr * br_ - pi * bi_); }
            u32x4 w; w.x = pk2(v[0], v[1]); w.y = pk2(v[2], v[3]); w.z = pk2(v[4], v[5]); w.w = pk2(v[6], v[7]);
            *(u32x4*)(M2g + (size_t)(r * 128 + j) * TP + k8) = w; } }
        { bf16* M4g = (bf16*)(F.ws + WS_M4) + (size_t)g * TP * 256;
          const int jj0 = (tid & 15) * 8, cc = jj0 >> 6, n0 = jj0 & 63;
          for (int row = tid >> 4; row < TP; row += 32) { const int t = row >> 4, p = row & 15, e = r ? (TCH - t) : (t + 1);
            float v[8];
#pragma unroll
            for (int i = 0; i < 8; ++i) { const float cr = Cs[((r * 16 + p) * 65 + n0 + i) * 2], ci = Cs[((r * 16 + p) * 65 + n0 + i) * 2 + 1], pr = PW[((n0 + i) * 65 + e) * 2], pi = PW[((n0 + i) * 65 + e) * 2 + 1];
                v[i] = cc ? -(cr * pi + ci * pr) : (cr * pr - ci * pi); }
            u32x4 w; w.x = pk2(v[0], v[1]); w.y = pk2(v[2], v[3]); w.z = pk2(v[4], v[5]); w.w = pk2(v[6], v[7]);
            *(u32x4*)(M4g + (size_t)row * 256 + r * 128 + jj0) = w; } }
        { bf16* KRg = (bf16*)(F.ws + WS_KR) + (size_t)g * KRG;
          const int p = tid & 15, es = tid >> 4;
          for (int jx = es; jx < TCH; jx += 32) {
            int j, e; if (r == 0) { j = jx; e = TCH - 1 - jx; } else { if (jx == 0) continue; j = TCH - 1 + jx; e = jx; }
            float a16[16];
#pragma unroll
            for (int q = 0; q < 16; ++q) a16[q] = 0.f;
#pragma unroll 2
            for (int n = 0; n < 64; ++n) { const float cr = Cs[((r * 16 + p) * 65 + n) * 2], ci = Cs[((r * 16 + p) * 65 + n) * 2 + 1], pr = PW[(n * 65 + e) * 2], pi = PW[(n * 65 + e) * 2 + 1];
                const float wr_ = cr * pr - ci * pi, wi_ = cr * pi + ci * pr;
                const LAS f32x4* bq = (const LAS f32x4*)(BBs + ((r * 64 + n) * 16) * 2);
#pragma unroll
                for (int q2 = 0; q2 < 8; ++q2) { const f32x4 bv = bq[q2]; a16[2 * q2] += wr_ * bv[0] - wi_ * bv[1]; a16[2 * q2 + 1] += wr_ * bv[2] - wi_ * bv[3]; } }
            if (r == 0 && e == 0) {
                for (int n = 0; n < 64; ++n) { const float cr = Cs[((16 + p) * 65 + n) * 2], ci = Cs[((16 + p) * 65 + n) * 2 + 1];
                    const LAS f32x4* bq = (const LAS f32x4*)(BBs + ((64 + n) * 16) * 2);
#pragma unroll
                    for (int q2 = 0; q2 < 8; ++q2) { const f32x4 bv = bq[q2]; a16[2 * q2] += cr * bv[0] - ci * bv[1]; a16[2 * q2 + 1] += cr * bv[2] - ci * bv[3]; } }
                const float dv = F.in[I_SD][g * 16 + p];
#pragma unroll
                for (int q = 0; q < 16; ++q) if (q == p) a16[q] += dv; }
            u32x4 w0, w1; w0.x = pk2(a16[0], a16[1]); w0.y = pk2(a16[2], a16[3]); w0.z = pk2(a16[4], a16[5]); w0.w = pk2(a16[6], a16[7]);
            w1.x = pk2(a16[8], a16[9]); w1.y = pk2(a16[10], a16[11]); w1.z = pk2(a16[12], a16[13]); w1.w = pk2(a16[14], a16[15]);
            *(u32x4*)(KRg + (size_t)p * PSTR + j * 16) = w0; *(u32x4*)(KRg + (size_t)p * PSTR + j * 16 + 8) = w1; } }
    }
    __syncthreads();
}
__device__ __forceinline__ void prep_mod(Frame& F) {
    LAS float* fl = (LAS float*)F.lds;
    const int tid = F.tid;
    for (int prep_ = 0; prep_ < (PROBE_PREP_PART == 1 ? 2 : 1); ++prep_)
    {   LAS float* sc = fl;
        for (int e = tid; e < 3 * D; e += 512) { const int rho = e >> 10, k = e & 1023; const float v = rho < 2 ? F.in[I_C][rho * D + k] : F.in[I_CCTX][k]; sc[e] = siluf_(v); }
        __syncthreads();
        LAS float* red = fl + 3 * D;
        for (int item = F.bid; item < 2 * 96; item += F.G) {
            const int layer = item / 96, n0 = (item % 96) * 32, kk = tid >> 5, nn = tid & 31;
            const float* w = F.in[I_ADAW] + (size_t)layer * D * 3072 + n0 + nn;
            float s0 = 0.f, s1 = 0.f, s2 = 0.f;
            for (int k = kk; k < D; k += 256) { float wv[16];
#pragma unroll
                for (int i = 0; i < 16; ++i) wv[i] = w[(size_t)(k + 16 * i) * 3072];
#pragma unroll
                for (int i = 0; i < 16; ++i) { s0 += sc[k + 16 * i] * wv[i]; s1 += sc[D + k + 16 * i] * wv[i]; s2 += sc[2 * D + k + 16 * i] * wv[i]; } }
            red[(kk * 32 + nn) * 3] = s0; red[(kk * 32 + nn) * 3 + 1] = s1; red[(kk * 32 + nn) * 3 + 2] = s2;
            __syncthreads();
            if (tid < 96) { const int rho = tid >> 5, n = tid & 31; float s = 0.f;
                for (int k2 = 0; k2 < 16; ++k2) s += red[(k2 * 32 + n) * 3 + rho];
                ((float*)(F.ws + WS_MOD))[(layer * 3 + rho) * 3072 + n0 + n] = s + F.in[I_ADAB][layer * 3072 + n0 + n]; }
            __syncthreads();
        }
    }
    __syncthreads();
}
__device__ __forceinline__ void prep_tr(Frame& F) {
    {   LAS float* scr = (LAS float*)(F.lds + F.wave * 16640);
        const int gw = F.bid * 8 + F.wave, NGW = F.G * 8;
        constexpr int I1 = (1024 / 64) * (8192 / 64), I2 = (2048 / 64) * (1024 / 64);
        for (int it = gw; it < I1 + I2; it += NGW) {
            int rI = it;
            if (rI < I1) { transpose_item(F.in[I_CWIN], 1024, 8192, (bf16*)(F.ws + WS_W1), scr, rI, F.lane, RowW1()); continue; } rI -= I1;
            transpose_item(F.in[I_CWOUT], 2048, 1024, (bf16*)(F.ws + WS_W2), scr, rI, F.lane, RowId());
        }
    }
}
__device__ __forceinline__ void prep_tr_late(Frame& F, int first_bid, int nblocks) {
    LAS float* scr = (LAS float*)(F.lds + F.wave * 16640);
    const int gw = (F.bid - first_bid) * 8 + F.wave, NGW = nblocks * 8;
    constexpr int I3 = (1024 / 64) * (4096 / 64), I4 = (2048 / 64) * (2048 / 64), I5 = (2048 / 64) * (1024 / 64);
    for (int it = gw; it < I3 + I4 + I5; it += NGW) {
        int rI = it;
        if (rI < I3) { transpose_item(F.in[I_SWIN], 1024, 4096, (bf16*)(F.ws + WS_W3), scr, rI, F.lane, RowId()); continue; } rI -= I3;
        if (rI < I4) { transpose_item(F.in[I_WGLU], 2048, 2048, (bf16*)(F.ws + WS_WG), scr, rI, F.lane, RowId()); continue; } rI -= I4;
        transpose_item(F.in[I_SWOUT], 2048, 1024, (bf16*)(F.ws + WS_W5), scr, rI, F.lane, RowId());
    }
}
__device__ __forceinline__ void phase_prep(Frame& F) {
    prep_mod(F);
    { VM_WAIT(); __syncthreads();
      if (F.tid == 0) { int mine = 0; for (int item = F.bid; item < 2 * 96; item += F.G) ++mine;
          if (mine) { __builtin_amdgcn_fence(__ATOMIC_RELEASE, "agent"); asm volatile("s_waitcnt vmcnt(0)" ::: "memory"); (void)xb_add((unsigned*)(F.ws + WS_CTL) + CW_MOD, (unsigned)mine); } } }
    if (F.bid & 1) { prep_tr(F); __syncthreads(); prep_ssm(F); } else { prep_ssm(F); prep_tr(F); }
}
__device__ __forceinline__ void store_row_blk64(char* base, size_t row, int lane, const f32x4 (&v)[4]) {
#pragma unroll
    for (int j = 0; j < 4; ++j) { const int kb = 4 * j + (lane >> 4), col = 4 * (lane & 15);
        u32x2 w; w.x = pk2(v[j][0], v[j][1]); w.y = pk2(v[j][2], v[j][3]);
        *(u32x2*)(base + (size_t)kb * HXPLANE + row * 128 + col * 2) = w; }
}
__device__ __forceinline__ void phase_mod0(Frame& F) {
    { if (F.tid == 0) { unsigned* cnt = (unsigned*)(F.ws + WS_CTL) + CW_MOD; unsigned sp = 0; while (xb_ld(cnt) < 2u * 96u && ++sp < (1u << 22)) __builtin_amdgcn_s_sleep(2);
          __builtin_amdgcn_fence(__ATOMIC_ACQUIRE, "agent"); asm volatile("s_waitcnt vmcnt(0)" ::: "memory"); }
      __syncthreads(); }
    const int gw = F.bid * 8 + F.wave, NGW = F.G * 8; const float* mod = (const float*)(F.ws + WS_MOD);
    for (int row = gw; row < RT; row += NGW) {
        const bool isctx = row >= RL; const int rho = isctx ? 2 : row / SEQ;
        const float* src = isctx ? F.in[I_CTX] + (size_t)(row - RL) * D : F.in[I_X] + (size_t)row * D;
        f32x4 v[4];
#pragma unroll
        for (int j = 0; j < 4; ++j) { const int idx = 256 * j + 4 * F.lane; const f32x4 xv = *(const f32x4*)(src + idx);
            const f32x4 sh = *(const f32x4*)(mod + rho * 3072 + idx), sc = *(const f32x4*)(mod + rho * 3072 + 1024 + idx);
            v[j] = xv * (1.0f + sc) + sh; }
        store_row_blk64((char*)F.ws + WS_HX, (size_t)row, F.lane, v);
        if (!isctx) { const int b = row / SEQ, t = row % SEQ; store_row_blk64((char*)F.out, (size_t)b * SEQ + (size_t)(t % GRIDW) * 256 + t / GRIDW, F.lane, v); }
    }
}
__device__ __forceinline__ void ln_row(f32x4 (&v)[4], const float* g, const float* b, int lane) {
    float s = 0.f;
#pragma unroll
    for (int j = 0; j < 4; ++j) s += (v[j][0] + v[j][1]) + (v[j][2] + v[j][3]);
    const float mean = wave_sum(s) * (1.f / D); float s2 = 0.f;
#pragma unroll
    for (int j = 0; j < 4; ++j) { v[j] = v[j] - mean; s2 += (v[j][0] * v[j][0] + v[j][1] * v[j][1]) + (v[j][2] * v[j][2] + v[j][3] * v[j][3]); }
    const float rstd = 1.0f / sqrtf(wave_sum(s2) * (1.f / D) + LN_EPS);
#pragma unroll
    for (int j = 0; j < 4; ++j) { const int idx = 256 * j + 4 * lane; v[j] = v[j] * rstd * *(const f32x4*)(g + idx) + *(const f32x4*)(b + idx); }
}
__device__ __forceinline__ void phase_ln_mod1(Frame& F) {
    const int gw = F.bid * 8 + F.wave, NGW = F.G * 8; const float* mod = (const float*)(F.ws + WS_MOD) + 3 * 3072;
    for (int row = gw; row < RT; row += NGW) {
        const bool isctx = row >= RL; const int rho = isctx ? 2 : row / SEQ;
        float* src = F.out + (size_t)row * D;
        f32x4 v[4];
        if (isctx) { const float* mod0 = (const float*)(F.ws + WS_MOD);
#pragma unroll
            for (int j = 0; j < 4; ++j) { const int idx = 256 * j + 4 * F.lane; f32x4 a = {0.f, 0.f, 0.f, 0.f};
#pragma unroll
                for (int ks = 0; ks < 8; ++ks) a += *(const f32x4*)((const float*)(F.ws + WS_Y1S) + ((size_t)ks * RC + (row - RL)) * D + idx);
                v[j] = DN_ALPHA * *(const f32x4*)(F.in[I_CTX] + (size_t)(row - RL) * D + idx) + *(const f32x4*)(mod0 + 2 * 3072 + 2048 + idx) * a; } }
        else {
#pragma unroll
            for (int j = 0; j < 4; ++j) { const int idx = 256 * j + 4 * F.lane; const u32x2 f = *(const u32x2*)((const char*)src + 2048 + idx * 2);
                const f32x4 fv = {bf2f(f.x), bf2f(f.x >> 16), bf2f(f.y), bf2f(f.y >> 16)};
                v[j] = DN_ALPHA * *(const f32x4*)(F.in[I_X] + (size_t)row * D + idx) + fv; } }
        ln_row(v, F.in[I_LNG], F.in[I_LNB], F.lane);
        if (!isctx) {
#pragma unroll
            for (int j = 0; j < 4; ++j) { u32x2 w; w.x = pk2(v[j][0], v[j][1]); w.y = pk2(v[j][2], v[j][3]); *(u32x2*)((char*)src + 2048 + (256 * j + 4 * F.lane) * 2) = w; } }
#pragma unroll
        for (int j = 0; j < 4; ++j) { const int idx = 256 * j + 4 * F.lane;
            const f32x4 sh = *(const f32x4*)(mod + rho * 3072 + idx), sc = *(const f32x4*)(mod + rho * 3072 + 1024 + idx);
            v[j] = v[j] * (1.0f + sc) + sh; }
        store_row_blk64((char*)F.ws + WS_HX, (size_t)row, F.lane, v);
    }
}
__device__ __forceinline__ void phase_ln_out(Frame& F) {
    const int gw = F.bid * 8 + F.wave, NGW = F.G * 8;
    for (int row = gw; row < RL; row += NGW) {
        float* src = F.out + (size_t)row * D;
        f32x4 v[4];
#pragma unroll
        for (int j = 0; j < 4; ++j) { const int idx = 256 * j + 4 * F.lane; const u32x2 f = *(const u32x2*)((const char*)F.ws + WS_FO + ((size_t)row * D + idx) * 2);
            const f32x4 fv = {bf2f(f.x), bf2f(f.x >> 16), bf2f(f.y), bf2f(f.y >> 16)};
            const u32x2 xb = *(const u32x2*)((const char*)src + 2048 + idx * 2);
            const f32x4 xv = {bf2f(xb.x), bf2f(xb.x >> 16), bf2f(xb.y), bf2f(xb.y >> 16)};
            v[j] = DN_ALPHA * xv + fv; }
        ln_row(v, F.in[I_LNG] + D, F.in[I_LNB] + D, F.lane);
#pragma unroll
        for (int j = 0; j < 4; ++j) *(f32x4*)(src + 256 * j + 4 * F.lane) = v[j];
    }
}
__device__ __forceinline__ void cmul_acc(float& hr, float& hi, float ar, float ai, float sr, float si) { const float nr = ar * hr - ai * hi + sr, ni = ar * hi + ai * hr + si; hr = nr; hi = ni; }
__device__ __forceinline__ void scan_pair(Frame& F, const int g, const int b) {
    int n = F.lane; asm volatile("" : "+v"(n));
    const int wq = F.wave & 3, r = F.wave >> 2;
    LAS float* ex = (LAS float*)F.lds;
    const f32x4 za = *(const f32x4*)((const float*)(F.ws + WS_ZA) + ((size_t)(r * NG + g) * 64 + n) * 4);
    const float ar = za[0], ai = za[1], aTr = za[2], aTi = za[3];
    float hr = 0.f, hi = 0.f;
    {   f32x4 bb[8];
        const f32x4* bp = (const f32x4*)((const float*)(F.ws + WS_BBG) + ((size_t)(r * NG + g) * 64 + n) * 32);
#pragma unroll
        for (int i = 0; i < 8; ++i) bb[i] = bp[i];
        const int s_own = 64 * wq + n, t_own = r ? (CTXL - 1 - s_own) : s_own;
        float us[16];
#pragma unroll
        for (int j = 0; j < 16; ++j) us[j] = 0.f;
#pragma unroll
        for (int ks = 0; ks < 4; ++ks) { const f32x4* rp = (const f32x4*)((const float*)(F.ws + WS_UCS) + ((size_t)ks * RC + b * CTXL + t_own) * 2048 + g * 16);
#pragma unroll
            for (int i = 0; i < 4; ++i) { const f32x4 v = rp[i]; us[4 * i] += v[0]; us[4 * i + 1] += v[1]; us[4 * i + 2] += v[2]; us[4 * i + 3] += v[3]; } }
        for (int i = 0; i < 64; ++i) { float sr = 0.f, si = 0.f;
#pragma unroll
            for (int q = 0; q < 8; ++q) { const float ua = __builtin_bit_cast(float, __builtin_amdgcn_readlane(__builtin_bit_cast(int, us[2 * q]), i));
                const float ub = __builtin_bit_cast(float, __builtin_amdgcn_readlane(__builtin_bit_cast(int, us[2 * q + 1]), i));
                sr += bb[q][0] * ua + bb[q][2] * ub; si += bb[q][1] * ua + bb[q][3] * ub; }
            cmul_acc(hr, hi, ar, ai, sr, si); }
    }
    for (int k = wq; k < 3; ++k)
#pragma unroll
        for (int z = 0; z < 64 / TCH; ++z) cmul_acc(hr, hi, aTr, aTi, 0.f, 0.f);
    __syncthreads();
    ex[((r * 4 + wq) * 64 + n) * 2] = hr; ex[((r * 4 + wq) * 64 + n) * 2 + 1] = hi;
    __syncthreads();
    float h0r = 0.f, h0i = 0.f;
#pragma unroll
    for (int k = 0; k < 4; ++k) { h0r += ex[((r * 4 + k) * 64 + n) * 2]; h0i += ex[((r * 4 + k) * 64 + n) * 2 + 1]; }
    constexpr int CPW = NCHB / 4; static_assert(CPW == 128, "scan register blocking");
    const int cb = b * NCHB + (r ? NCHB - CPW * (wq + 1) : CPW * wq);
    const bf16* re_row = (const bf16*)(F.ws + WS_S + (size_t)g * MiB) + (size_t)(r * 128 + n) * NCOL + cb;
    const bf16* im_row = re_row + (size_t)64 * NCOL;
    bf16* Xg = (bf16*)(F.ws + WS_X + (size_t)g * XPLANE) + TP + r * 128 + n;
#define SCAN_LOAD(HALF) do { _Pragma("unroll") for (int k = 0; k < 8; ++k) { const int kk = r ? (15 - 8 * (HALF) - k) : (8 * (HALF) + k); pre[k] = *(const u32x4*)(re_row + 8 * kk); pim[k] = *(const u32x4*)(im_row + 8 * kk); } } while (0)
#define SCAN_RE(i) bf2f(pre[(i) >> 3][((r ? 7 - ((i) & 7) : ((i) & 7)) >> 1)] >> (16 * ((r ? 7 - ((i) & 7) : ((i) & 7)) & 1)))
#define SCAN_IM(i) bf2f(pim[(i) >> 3][((r ? 7 - ((i) & 7) : ((i) & 7)) >> 1)] >> (16 * ((r ? 7 - ((i) & 7) : ((i) & 7)) & 1)))
    u32x4 pre[8], pim[8];
    float er = 0.f, ei = 0.f;
#pragma unroll
    for (int half = 0; half < 2; ++half) { SCAN_LOAD(half);
        if (r == 0) {
#pragma unroll
            for (int i = 0; i < 64; ++i) cmul_acc(er, ei, aTr, aTi, bf2f(pre[i >> 3][(i & 7) >> 1] >> (16 * (i & 1))), bf2f(pim[i >> 3][(i & 7) >> 1] >> (16 * (i & 1))));
        } else {
#pragma unroll
            for (int i = 0; i < 64; ++i) { const int e = 7 - (i & 7); cmul_acc(er, ei, aTr, aTi, bf2f(pre[i >> 3][e >> 1] >> (16 * (e & 1))), bf2f(pim[i >> 3][e >> 1] >> (16 * (e & 1)))); }
        }
        asm volatile("" ::: "memory"); }
    float qr = aTr, qi = aTi;
    for (int k = 1; k < CPW; k <<= 1) { const float nr = qr * qr - qi * qi, ni = 2.f * qr * qi; qr = nr; qi = ni; }
    __syncthreads();
    ex[((r * 4 + wq) * 64 + n) * 2] = er; ex[((r * 4 + wq) * 64 + n) * 2 + 1] = ei;
    __syncthreads();
    hr = h0r; hi = h0i;
    for (int k = 0; k < wq; ++k) cmul_acc(hr, hi, qr, qi, ex[((r * 4 + k) * 64 + n) * 2], ex[((r * 4 + k) * 64 + n) * 2 + 1]);
    LAS bf16* tile = (LAS bf16*)(F.lds + 8192 + F.wave * 1024);
    GAS char* hp = (GAS char*)(F.ws + WS_X + (size_t)g * XPLANE) + ((size_t)(cb + (r ? CPW - 1 - (n >> 4) : (n >> 4))) * XLD + TP + r * 128) * 2 + (n & 15) * 16;
    const long hstep4 = (r ? -4L : 4L) * XLD * 2;
#pragma unroll
    for (int half = 0; half < 2; ++half) { SCAN_LOAD(half);
        if (r == 0) {
#pragma unroll
            for (int i = 0; i < 64; ++i) {
                tile[(i & 3) * 128 + n] = (bf16)f2bf(hr); tile[(i & 3) * 128 + 64 + n] = (bf16)f2bf(hi);
                if ((i & 3) == 3) { const u32x4 w = *(const LAS u32x4*)((const LAS char*)tile + n * 16); *(GAS u32x4*)hp = w; hp += hstep4; asm volatile("" : "+v"(hp)); }
                cmul_acc(hr, hi, aTr, aTi, bf2f(pre[i >> 3][(i & 7) >> 1] >> (16 * (i & 1))), bf2f(pim[i >> 3][(i & 7) >> 1] >> (16 * (i & 1)))); }
        } else {
#pragma unroll
            for (int i = 0; i < 64; ++i) { const int e = 7 - (i & 7);
                tile[(i & 3) * 128 + n] = (bf16)f2bf(hr); tile[(i & 3) * 128 + 64 + n] = (bf16)f2bf(hi);
                if ((i & 3) == 3) { const u32x4 w = *(const LAS u32x4*)((const LAS char*)tile + n * 16); *(GAS u32x4*)hp = w; hp += hstep4; asm volatile("" : "+v"(hp)); }
                cmul_acc(hr, hi, aTr, aTi, bf2f(pre[i >> 3][e >> 1] >> (16 * (e & 1))), bf2f(pim[i >> 3][e >> 1] >> (16 * (e & 1)))); }
        }
        asm volatile("" ::: "memory"); }
#undef SCAN_LOAD
#undef SCAN_RE
#undef SCAN_IM
}

constexpr int N_PHASES = 11;
template <class P> __device__ __forceinline__ void run_gemm(Frame& F, const P& p, int bit) {
    if ((NAIVE_MASK >> bit) & 1) g8::gemm_phase_naive<P>(F.lds, p, F.G, F.bid); else g8::gemm_phase<P>(F.lds, p, F.G, F.bid);
}
__global__ void __launch_bounds__(512, 2) mk_fwd(Args args) {
    extern __shared__ __attribute__((aligned(16))) unsigned char lds_raw[];
    Frame F;
    F.lds = (LAS unsigned char*)lds_raw;
    F.tid = threadIdx.x; F.lane = F.tid & 63; F.wave = __builtin_amdgcn_readfirstlane(F.tid >> 6); F.G = gridDim.x; F.bid = blockIdx.x;
#pragma unroll
    for (int i = 0; i < 23; ++i) F.in[i] = args.in[i];
    F.out = args.out; F.ws = args.ws;
    volatile LAS unsigned* MISC = (volatile LAS unsigned*)(F.lds + MISC_OFF);
    if (F.tid < 32) MISC[F.tid] = 0u;
    __syncthreads();
    XcdBarrier bar; bar.bar = (unsigned*)(F.ws + WS_CTL) + CW_BAR; bar.x = 0; bar.st = nullptr;
    if (MK_N_LAUNCHES == 1) bar = xcd_barrier_post((unsigned*)(F.ws + WS_CTL) + CW_BAR, MISC + 8);
    const int lo = args.ph_lo, hi = args.ph_hi;
#define IN(k) (lo <= (k) && (k) < hi)
#define REP(k) for (int rep_ = 0; rep_ < 1 + ((k) == PROBE_REP_PHASE ? PROBE_REP_N : 0); ++rep_)
#define SEAM(k) do { if (IN(k) && IN((k) + 1)) xcd_barrier(bar); if ((k) + 1 == PROBE_T_LO) pt0 = __builtin_amdgcn_s_memrealtime(); if ((k) == PROBE_T_HI) pt1 = __builtin_amdgcn_s_memrealtime(); } while (0)
    unsigned long long pt0 = (PROBE_T_LO == 0) ? __builtin_amdgcn_s_memrealtime() : 0ull, pt1 = 0ull;
    unsigned char* ws = F.ws; const float* mod = (const float*)(ws + WS_MOD);
    if (IN(0)) REP(0) { phase_prep(F); }
    if (IN(1)) REP(1) { phase_mod0(F); } SEAM(1);
    if (IN(2)) REP(2) { { LAS float* cwl = (LAS float*)(F.lds + CWL_OFF); for (int e = F.tid; e < 3 * 2048; e += 512) cwl[e] = F.in[I_CW][e]; __syncthreads(); } g8::ProbG1 p{(const char*)ws + WS_HX, (const char*)F.out, (const char*)ws + WS_W1, F.in[I_CW], (char*)ws + WS_A2}; run_gemm(F, p, 0);
        { const int nun = (RT / 256) * 32, full = nun / F.G, rem = nun - full * F.G;
          __syncthreads();
          if (rem > 0 && rem < F.G) { if (F.bid >= rem) prep_tr_late(F, rem, F.G - rem); } else prep_tr_late(F, 0, F.G); } } SEAM(2);
    if (IN(3)) REP(3) { g8::ProbG2 p{(const char*)ws + WS_A2, (const char*)ws + WS_W2, mod, (char*)F.out, (float*)(ws + WS_Y1S)}; run_gemm(F, p, 1); } SEAM(3);
    if (IN(4)) REP(4) { phase_ln_mod1(F); } SEAM(4);
    if (IN(5)) REP(5) { g8::ProbG3 p{(const char*)ws + WS_HX, (const char*)ws + WS_W3, (char*)ws + WS_X, (float*)(ws + WS_UCS), (char*)ws + WS_SZ, 0}; run_gemm(F, p, 2); } SEAM(5);
    if (IN(6)) REP(6) {
        for (int pl = F.bid; pl < NG * NBATCH; pl += F.G) { const int wg = g8::xcd_remap(pl, NG * NBATCH), g = wg >> 1, b = wg & 1;
            if (PROBE_SSM_PART == 0) pt0 = __builtin_amdgcn_s_memrealtime();
            { g8::ProbS p{(const char*)ws + WS_X, (const char*)ws + WS_M2, (char*)ws + WS_S, g, b}; if ((NAIVE_MASK >> 3) & 1) g8::gemm_phase_naive(F.lds, p, 1, 0); else g8::gemm_phase(F.lds, p, 1, 0); }
            VM_WAIT(); __syncthreads();
            if (PROBE_SSM_PART == 0) pt1 = __builtin_amdgcn_s_memrealtime(); if (PROBE_SSM_PART == 1) pt0 = __builtin_amdgcn_s_memrealtime();
            scan_pair(F, g, b);
            VM_WAIT(); __syncthreads();
            if (PROBE_SSM_PART == 1) pt1 = __builtin_amdgcn_s_memrealtime(); if (PROBE_SSM_PART == 2) pt0 = __builtin_amdgcn_s_memrealtime();
            if (F.tid == 0) { unsigned* cnt = (unsigned*)(ws + WS_CTL) + CW_PAIR + g; (void)xb_add(cnt, 1u);
                unsigned sp = 0; while (xb_ld(cnt) < 2u && ++sp < (1u << 22)) __builtin_amdgcn_s_sleep(2); }
            __syncthreads();
            { g8::ProbY p{(const char*)ws + WS_X, (const char*)ws + WS_KR, (const char*)ws + WS_M4, (char*)ws + WS_G, g, b}; if ((NAIVE_MASK >> 4) & 1) g8::gemm_phase_naive(F.lds, p, 1, 0); else g8::gemm_phase(F.lds, p, 1, 0); }
            VM_WAIT(); __syncthreads(); if (PROBE_SSM_PART == 2) pt1 = __builtin_amdgcn_s_memrealtime(); } } SEAM(6);
    if (IN(7)) REP(7) { g8::ProbG3 p{(const char*)ws + WS_HX, (const char*)ws + WS_W3, (char*)ws + WS_X, (float*)(ws + WS_UCS), (char*)ws + WS_SZ, 1}; run_gemm(F, p, 5); VM_WAIT(); __syncthreads(); }
    if (IN(8)) REP(8) { g8::ProbG4 p{(const char*)ws + WS_G, (const char*)ws + WS_WG, (const char*)ws + WS_SZ, F.in[I_BGLU], (char*)ws + WS_A4}; run_gemm(F, p, 6); } SEAM(8);
    if (IN(9)) REP(9) { g8::ProbG5 p{(const char*)ws + WS_A4, (const char*)ws + WS_W5, mod, (char*)ws + WS_FO}; run_gemm(F, p, 7); } SEAM(9);
    if (IN(10)) REP(10) { phase_ln_out(F); }
    if (PROBE_T_LO >= 0 || PROBE_SSM_PART >= 0) { if (PROBE_T_HI == 10) { VM_WAIT(); pt1 = __builtin_amdgcn_s_memrealtime(); }
        if (F.bid == 0 && F.tid == 0) { const unsigned long long tgt = __builtin_amdgcn_s_memrealtime() + (unsigned long long)PROBE_T_MULT * (pt1 - pt0);
            while (__builtin_amdgcn_s_memrealtime() < tgt) __builtin_amdgcn_s_sleep(8); } }
#undef IN
#undef SEAM
}

extern "C" void kernel_launch(void* const* d_in, const int* in_sizes, int n_in, void* d_out, int out_size, void* d_ws, size_t ws_size, hipStream_t stream) {
    static int grid = 0;
    if (grid == 0) {
        if (n_in != 23 || in_sizes[0] != RL * D || out_size != RL * D || ws_size < WS_END) { fprintf(stderr, "kernel_launch: unexpected shapes (n_in %d, in0 %d, out %d, ws %zu); nothing launched\n", n_in, n_in > 0 ? in_sizes[0] : -1, out_size, ws_size); grid = -1; return; }
        int dev = 0, cus = 0, per_cu = 0;
        if (hipGetDevice(&dev) != hipSuccess || hipDeviceGetAttribute(&cus, hipDeviceAttributeMultiprocessorCount, dev) != hipSuccess) { grid = -1; return; }
        if (hipFuncSetAttribute((const void*)mk_fwd, hipFuncAttributeMaxDynamicSharedMemorySize, LDS_BYTES) != hipSuccess) { fprintf(stderr, "kernel_launch: hipFuncSetAttribute failed\n"); grid = -1; return; }
        if (hipOccupancyMaxActiveBlocksPerMultiprocessor(&per_cu, (const void*)mk_fwd, 512, LDS_BYTES) != hipSuccess || per_cu < 1) { fprintf(stderr, "kernel_launch: occupancy query says %d\n", per_cu); per_cu = 1; }
        (void)hipGetLastError();
        grid = cus * 1;
        if (per_cu < 1) grid = -1;
    }
    if (grid < 0) return;
    (void)hipMemsetAsync((char*)d_ws + WS_CTL, 0, CTL_ZERO_BYTES, stream);
    Args a{};
    for (int i = 0; i < 23; ++i) a.in[i] = (const float*)d_in[i];
    a.out = (float*)d_out; a.ws = (unsigned char*)d_ws;
    if (MK_N_LAUNCHES == 1) {
        a.ph_lo = 0; a.ph_hi = N_PHASES;
        void* kargs[] = {&a};
        hipError_t e = hipLaunchCooperativeKernel((const void*)mk_fwd, dim3(grid), dim3(512), kargs, LDS_BYTES, stream);
        if (e != hipSuccess) fprintf(stderr, "kernel_launch: cooperative launch failed: %s (grid %d)\n", hipGetErrorString(e), grid);
    } else {
        for (int ph = 0; ph < N_PHASES; ++ph) { a.ph_lo = ph; a.ph_hi = ph + 1; hipLaunchKernelGGL(mk_fwd, dim3(grid), dim3(512), LDS_BYTES, stream, a); }
    }
}
```

```cpp
#include <hip/hip_runtime.h>
#include <cstdio>
#include <cstdint>

#ifndef MK_N_LAUNCHES
#define MK_N_LAUNCHES 1
#endif
#ifndef NAIVE_MASK
#define NAIVE_MASK 0
#endif

#ifndef PROBE_REP_PHASE
#define PROBE_REP_PHASE -1
#define PROBE_REP_N 0
#endif
#ifndef PROBE_PREP_PART
#define PROBE_PREP_PART -1
#endif
#ifndef PROBE_SSM_PART
#define PROBE_SSM_PART -1
#endif
#ifndef PROBE_T_LO
#define PROBE_T_LO -1
#define PROBE_T_HI -1
#define PROBE_T_MULT 4
#endif
#define GAS __attribute__((address_space(1)))
#define LAS __attribute__((address_space(3)))
typedef unsigned short bf16;
typedef short bf16x8 __attribute__((ext_vector_type(8)));
typedef float f32x4 __attribute__((ext_vector_type(4)));
typedef float f32x2 __attribute__((ext_vector_type(2)));
typedef unsigned u32x4 __attribute__((ext_vector_type(4)));
typedef unsigned u32x2 __attribute__((ext_vector_type(2)));

constexpr int D = 1024, NBATCH = 2, SEQ = 16384, CTXL = 256, GRIDW = 64, EW = 2048, NG = 128, NST = 64, PG = 16;
constexpr int RL = NBATCH * SEQ;
constexpr int RC = NBATCH * CTXL;
constexpr int RT = RL + RC;
constexpr int TCH = 32;
constexpr int TP = TCH * PG;
constexpr int XLD = TP + 4 * NST;
constexpr int NCHB = SEQ / TCH;
constexpr int NCOL = NBATCH * NCHB;
constexpr int PSTR = 2 * TCH * PG;
constexpr int KRG = PG * PSTR;
constexpr float LN_EPS = 1e-5f;
constexpr float DN_ALPHA = 1.41421356237f;

constexpr size_t MiB = 1u << 20;
constexpr size_t WS_CTL = 0, CTL_ZERO_BYTES = 128 * 1024;
constexpr size_t WS_MOD = 1 * MiB;
constexpr size_t WS_ZA = 1 * MiB + 256 * 1024;
constexpr size_t WS_BBG = 2 * MiB;
constexpr size_t WS_WG = 6 * MiB, WS_W5 = 14 * MiB, WS_W3 = 18 * MiB;
constexpr size_t WS_KR = 26 * MiB;
constexpr size_t WS_M4 = 34 * MiB;
constexpr size_t WS_HX = 98 * MiB;
constexpr size_t WS_X = 163 * MiB;
constexpr size_t WS_A2 = 163 * MiB;
constexpr size_t WS_SZ = 195 * MiB;
constexpr size_t WS_M2 = 355 * MiB;
constexpr size_t WS_G = 355 * MiB;
constexpr size_t WS_S = 355 * MiB + 256 * 1024;
constexpr size_t WS_UCTX = 483 * MiB;
constexpr size_t WS_W1 = 484 * MiB, WS_W2 = 500 * MiB;
constexpr size_t WS_Y1S = 294 * MiB;
constexpr size_t WS_UCS = 484 * MiB;
constexpr size_t WS_FO = 163 * MiB;
constexpr size_t WS_A4 = 34 * MiB;
constexpr size_t WS_END = 504 * MiB;
constexpr size_t HXPLANE = (size_t)RT * 128;
constexpr size_t A4PLANE = (size_t)RL * 128;
constexpr size_t GPLANE = (size_t)RL * 32;
constexpr size_t XPLANE = (size_t)NCOL * XLD * 2;
static_assert(WS_X + (size_t)NG * XPLANE <= WS_M2 && WS_A2 + 32 * HXPLANE <= WS_M2 && WS_Y1S + 8 * (size_t)RC * D * 4 <= WS_M2, "map");
static_assert(WS_HX + 16 * HXPLANE <= WS_X && 16 * HXPLANE <= (size_t)RL * D * 4, "map");
static_assert(WS_G + (size_t)NG * GPLANE <= WS_UCTX && WS_SZ + (size_t)RL * 2048 * 2 <= WS_X + (size_t)NG * XPLANE && WS_A4 + 32 * A4PLANE <= WS_X, "map");
static_assert(WS_M4 + (size_t)NG * TP * 256 * 2 <= WS_HX && WS_KR + (size_t)NG * KRG * 2 <= WS_M4 && (size_t)256 * TP * 2 == 256 * 1024 && (size_t)NCOL * 256 * 2 == 512 * 1024 && GPLANE == MiB && WS_W2 + 4 * MiB <= WS_END, "map");
constexpr int CW_BAR = 4096, CW_MOD = 8000, CW_PAIR = 8192;

constexpr int RING_BYTES = 131072;
constexpr int XL_OFF = RING_BYTES;
constexpr int XL_BYTES = 2048;
constexpr int CWL_OFF = XL_OFF + XL_BYTES;
constexpr int MISC_OFF = CWL_OFF + 3 * 2048 * 4;
constexpr int LDS_BYTES = MISC_OFF + 128;

#define RLX_AGENT __ATOMIC_RELAXED, __HIP_MEMORY_SCOPE_AGENT
#define LDS_WAIT() asm volatile("s_waitcnt lgkmcnt(0)" ::: "memory")
#define VM_WAIT() asm volatile("s_waitcnt vmcnt(0)" ::: "memory")
__host__ __device__ __forceinline__ unsigned f2bf(float f) { unsigned u = __builtin_bit_cast(unsigned, f); return (u + 0x7fffu + ((u >> 16) & 1u)) >> 16; }
typedef __bf16 bf16x2_t __attribute__((ext_vector_type(2)));
__host__ __device__ __forceinline__ unsigned pk2(float lo, float hi) {
#if defined(__HIP_DEVICE_COMPILE__)
    const f32x2 v = {lo, hi}; return __builtin_bit_cast(unsigned, __builtin_convertvector(v, bf16x2_t));
#else
    return f2bf(lo) | (f2bf(hi) << 16);
#endif
}
__host__ __device__ __forceinline__ float bf2f(unsigned b) { return __builtin_bit_cast(float, (b & 0xffffu) << 16); }
__device__ __forceinline__ float sigmoidf_(float x) { return __builtin_amdgcn_rcpf(1.0f + __expf(-x)); }
__device__ __forceinline__ float siluf_(float x) { return x * sigmoidf_(x); }
__device__ __forceinline__ float gelu_tanh(float x) { return x * sigmoidf_(1.5957691216f * (x + 0.044715f * x * x * x)); }
__device__ __forceinline__ float wave_sum(float v) {
#pragma unroll
    for (int o = 1; o < 64; o <<= 1) v += __shfl_xor(v, o);
    return v;
}

__device__ __forceinline__ float dpp_from_prev(float carry, float v) { return __builtin_bit_cast(float, __builtin_amdgcn_update_dpp(__builtin_bit_cast(int, carry), __builtin_bit_cast(int, v), 0x111, 0xf, 0xf, false)); }
__device__ __forceinline__ float dpp_from_next(float carry, float v) { return __builtin_bit_cast(float, __builtin_amdgcn_update_dpp(__builtin_bit_cast(int, carry), __builtin_bit_cast(int, v), 0x101, 0xf, 0xf, false)); }
__device__ __forceinline__ float dpp_ror1(float v) { return __builtin_bit_cast(float, __builtin_amdgcn_update_dpp(0, __builtin_bit_cast(int, v), 0x121, 0xf, 0xf, false)); }
__device__ __forceinline__ float dpp_ror15(float v) { return __builtin_bit_cast(float, __builtin_amdgcn_update_dpp(0, __builtin_bit_cast(int, v), 0x12F, 0xf, 0xf, false)); }
#define XB_TMO      128
#define XB_XCNT(j)  (256  + 64 * (j))
#define XB_XSUB(j)  (1280 + 64 * (j))
#define XB_XGEN(j)  (2304 + 64 * (j))
#define XB_TOP      3328
#define XB_TOPGEN   3392
#define XCD_BAR_WORDS 3456
#define XB_SPIN_CAP (1u << 20)
__device__ __forceinline__ unsigned xb_ld(unsigned* p)              { return __hip_atomic_load(p, __ATOMIC_RELAXED, __HIP_MEMORY_SCOPE_AGENT); }
__device__ __forceinline__ unsigned xb_add(unsigned* p, unsigned v) { return __hip_atomic_fetch_add(p, v, __ATOMIC_RELAXED, __HIP_MEMORY_SCOPE_AGENT); }
__device__ __forceinline__ unsigned xb_xcc_id() { return (unsigned)__builtin_amdgcn_s_getreg((3 << 11) | 20) & 0xFu; }
#define XB_SPIN(cond, bar) do { unsigned _sp = 0; while (cond) { __builtin_amdgcn_s_sleep(1); \
    if ((++_sp & 255u) == 0u) { if (xb_ld(&(bar)[XB_TMO])) break; if (_sp > XB_SPIN_CAP) { atomicAdd(&(bar)[XB_TMO], 1u); break; } } } } while (0)
struct XcdBarrier { unsigned* bar; unsigned x; volatile LAS unsigned* st; };
__device__ __forceinline__ XcdBarrier xcd_barrier_post(unsigned* bar, volatile LAS unsigned* st) {
    XcdBarrier b; b.bar = bar; b.x = xb_xcc_id(); b.st = st;
    if (threadIdx.x == 0) (void)xb_add(&bar[XB_XCNT(b.x)], 1u);
    return b;
}
__device__ __forceinline__ void xcd_barrier_complete(unsigned* bar, unsigned x, unsigned& nloc, unsigned& nx) {
    const unsigned G = gridDim.x * gridDim.y * gridDim.z;
    unsigned sum, cnt, mine, sp = 0u;
    for (;;) {
        sum = 0u; cnt = 0u; mine = 0u;
#pragma unroll
        for (unsigned j = 0; j < 16; ++j) { const unsigned c = xb_ld(&bar[XB_XCNT(j)]); sum += c; cnt += (c > 0u) ? 1u : 0u; mine = (j == x) ? c : mine; }
        if (sum == G) break;
        __builtin_amdgcn_s_sleep(1);
        if ((++sp & 255u) == 0u) { if (xb_ld(&bar[XB_TMO])) break; if (sp > XB_SPIN_CAP) { atomicAdd(&bar[XB_TMO], 1u); break; } }
    }
    nloc = mine > 0u ? mine : 1u; nx = cnt > 0u ? cnt : 1u;
}
__device__ __forceinline__ void xcd_barrier(const XcdBarrier& b) {
    asm volatile("s_waitcnt vmcnt(0)" ::: "memory");
    __syncthreads();
    if (threadIdx.x == 0) {
        unsigned* bar = b.bar;
        __builtin_amdgcn_s_waitcnt(0);
        unsigned nloc = b.st[0], nx = b.st[1];
        if (nloc == 0u) { xcd_barrier_complete(bar, b.x, nloc, nx); b.st[0] = nloc; b.st[1] = nx; }
        const unsigned old = xb_add(&bar[XB_XSUB(b.x)], 1u);
        const unsigned gen = old / nloc;
        if (old + 1u == (gen + 1u) * nloc) {
            __builtin_amdgcn_fence(__ATOMIC_RELEASE, "agent");
            asm volatile("s_waitcnt vmcnt(0)" ::: "memory");
            const unsigned og = xb_add(&bar[XB_TOP], 1u);
            const unsigned tg = og / nx;
            if (og + 1u == (tg + 1u) * nx) xb_add(&bar[XB_TOPGEN], 1u);
            else XB_SPIN(xb_ld(&bar[XB_TOPGEN]) == tg, bar);
            __builtin_amdgcn_fence(__ATOMIC_ACQUIRE, "agent");
            xb_add(&bar[XB_XGEN(b.x)], 1u);
            asm volatile("s_waitcnt vmcnt(0)" ::: "memory");
        } else {
            XB_SPIN(xb_ld(&bar[XB_XGEN(b.x)]) == gen, bar);
            __builtin_amdgcn_fence(__ATOMIC_ACQUIRE, "agent");
            asm volatile("s_waitcnt vmcnt(0)" ::: "memory");
        }
    }
    __syncthreads();
}

struct Args {
    const float* in[23];
    float* out; unsigned char* ws;
    int ph_lo, ph_hi;
};
enum { I_X = 0, I_C, I_CTX, I_CCTX, I_ADAW, I_ADAB, I_LNG, I_LNB, I_CWIN, I_CW, I_CWOUT, I_SWIN, I_LRE, I_LIM, I_LSTEP, I_BRE, I_BIM, I_CRE, I_CIM, I_SD, I_WGLU, I_BGLU, I_SWOUT };

namespace g8 {
constexpr int BM = 256, BK = 64, HALF = 128, HTB = HALF * BK * 2, NXCD = 8, WGM = 8;
__host__ __device__ __forceinline__ int lds_byte(int r, int c) { const int st = (r >> 4) * 2 + (c >> 5), rr = r & 15, cc = c & 31, ob = rr * 64 + cc * 2; return st * 1024 + (ob ^ (((ob >> 9) & 1) << 5)); }
__host__ __device__ __forceinline__ void stage_rc(int b, int& R, int& C) { const int st = b / 1024, sb = b % 1024, swz = sb ^ (((sb >> 9) & 1) << 5); R = (st >> 1) * 16 + swz / 64; C = (st & 1) * 32 + (swz % 64) / 2; }
__host__ __device__ __forceinline__ int perm32(int rho) { const int n = rho >> 4, i = rho & 15; return 8 * (i >> 2) + 4 * n + (i & 3); }

struct Unit { int pm, pn, g, ks; };
__host__ __device__ __forceinline__ int xcd_remap(int L, int nwg) { const int q = nwg / NXCD, r = nwg % NXCD, xcd = L % NXCD, off = L / NXCD; return (xcd < r ? xcd * (q + 1) : r * (q + 1) + (xcd - r) * q) + off; }
__host__ __device__ __forceinline__ bool order_mn(int L, int nM, int nN, Unit& u) {
    const int nwg = nM * nN; if (L >= nwg) return false;
    const int wgid = xcd_remap(L, nwg);
    const int nig = WGM * nN, gid = wgid / nig, fm = gid * WGM, gsz = (nM - fm) < WGM ? (nM - fm) : WGM;
    u.pm = fm + ((wgid % nig) % gsz); u.pn = (wgid % nig) / gsz; u.g = 0; u.ks = 0; return true;
}
__host__ __device__ __forceinline__ bool order_g(int L, int ng, int nM, int nN, Unit& u) {
    const int per = nM * nN, nwg = ng * per; if (L >= nwg) return false;
    const int wgid = xcd_remap(L, nwg);
    u.g = wgid / per; const int rem = wgid % per; u.pm = rem / nN; u.pn = rem % nN; u.ks = 0; return true;
}

__device__ __forceinline__ unsigned cvt_pk_bf16(float lo, float hi) { unsigned r; asm volatile("v_cvt_pk_bf16_f32 %0, %1, %2" : "=v"(r) : "v"(lo), "v"(hi)); return r; }

typedef f32x4 Acc[2][2][4][2];

template <class P>
__device__ __forceinline__ void gemm_phase(LAS unsigned char* lds, const P& p, const int G, const int c) {
    int tid = threadIdx.x; asm volatile("" : "+v"(tid));
    const int wid = __builtin_amdgcn_readfirstlane(tid >> 6), lane = tid & 63, wr = wid >> 2, wc = wid & 3, fr = lane & 15, fq = lane >> 4;
    constexpr int NS = P::NSEG; constexpr int S1 = NS - 1;
    const int nt0 = p.nt0();
    unsigned voffA0, voffA1, voffB0, voffB1;
    { int R, C; stage_rc(tid * 16, R, C); const int Rb = P::PERM ? ((R & ~31) + perm32(R & 31)) : R;
      voffA0 = (unsigned)(p.a_off(0, R, C) - p.a_off(0, 0, 0) + p.a_bias(0)); voffB0 = (unsigned)(p.b_off(0, Rb, C) - p.b_off(0, 0, 0) + p.b_bias(0));
      voffA1 = (unsigned)(p.a_off(S1, R, C) - p.a_off(S1, 0, 0) + p.a_bias(S1)); voffB1 = (unsigned)(p.b_off(S1, Rb, C) - p.b_off(S1, 0, 0) + p.b_bias(S1)); }
    const long r64A0 = p.a_off(0, 64, 0) - p.a_off(0, 0, 0), r64A1 = p.a_off(S1, 64, 0) - p.a_off(S1, 0, 0), r64B0 = p.b_off(0, 64, 0) - p.b_off(0, 0, 0), r64B1 = p.b_off(S1, 64, 0) - p.b_off(S1, 0, 0);
    const long hA0 = p.a_off(0, 128, 0) - p.a_off(0, 0, 0), hA1 = p.a_off(S1, 128, 0) - p.a_off(S1, 0, 0), hB0 = p.b_off(0, 128, 0) - p.b_off(0, 0, 0), hB1 = p.b_off(S1, 128, 0) - p.b_off(S1, 0, 0);
    const long ksA0 = p.a_off(0, 0, 64) - p.a_off(0, 0, 0), ksA1 = p.a_off(S1, 0, 64) - p.a_off(S1, 0, 0), ksB0 = p.b_off(0, 0, 64) - p.b_off(0, 0, 0), ksB1 = p.b_off(S1, 0, 64) - p.b_off(S1, 0, 0);
    const unsigned ldsw = (unsigned)wid * 1024u;
    const int aoff = lds_byte(wr * 64 + fr, fq * 8), boff = lds_byte(wc * 32 + fr, fq * 8);
#define G8_SA(b, h) (((b) * 2 + (h)) * HTB)
#define G8_SB(b, h) ((4 + (b) * 2 + (h)) * HTB)
#define G8_STAGE1(bufoff, gptr, voff, r64) do { \
        __builtin_amdgcn_global_load_lds((const unsigned*)((gptr) + (voff)), (LAS unsigned*)(lds + (bufoff) + ldsw), 16, 0, 0); \
        __builtin_amdgcn_global_load_lds((const unsigned*)((gptr) + (r64) + (voff)), (LAS unsigned*)(lds + (bufoff) + ldsw + 8192), 16, 0, 0); } while (0)
#define G8_STA(bufoff, ptr, sg, h) G8_STAGE1(bufoff, (ptr) + (h) * ((sg) ? hA1 : hA0), ((sg) ? voffA1 : voffA0), ((sg) ? r64A1 : r64A0))
#define G8_STB(bufoff, ptr, sg, h) G8_STAGE1(bufoff, (ptr) + (h) * ((sg) ? hB1 : hB0), ((sg) ? voffB1 : voffB0), ((sg) ? r64B1 : r64B0))
#define G8_LDA(dst, b, h) do { _Pragma("unroll") for (int m = 0; m < 4; ++m) _Pragma("unroll") for (int k = 0; k < 2; ++k) dst[m][k] = *(const LAS bf16x8*)(lds + G8_SA(b, h) + aoff + m * 2048 + k * 1024); } while (0)
#define G8_LDB(dst, b, h) do { _Pragma("unroll") for (int n = 0; n < 2; ++n) _Pragma("unroll") for (int k = 0; k < 2; ++k) dst[n][k] = *(const LAS bf16x8*)(lds + G8_SB(b, h) + boff + n * 2048 + k * 1024); } while (0)
#define G8_MMA(ai, bj, At, Bt) do { __builtin_amdgcn_s_setprio(1); _Pragma("unroll") for (int m = 0; m < 4; ++m) _Pragma("unroll") for (int n = 0; n < 2; ++n) _Pragma("unroll") for (int k = 0; k < 2; ++k) \
        acc[ai][bj][m][n] = __builtin_amdgcn_mfma_f32_16x16x32_bf16(Bt[n][k], At[m][k], acc[ai][bj][m][n], 0, 0, 0); __builtin_amdgcn_s_setprio(0); } while (0)
#define G8_WAIT_V(n) asm volatile("s_waitcnt vmcnt(" #n ")" ::: "memory")
#define G8_WAIT_L(n) asm volatile("s_waitcnt lgkmcnt(" #n ")" ::: "memory")
#define G8_BAR __builtin_amdgcn_s_barrier()
#define G8_SCHED __builtin_amdgcn_sched_barrier(0)
    Unit cur, nxt; int ui = 0;
    if (!p.unit(c, cur)) return;
    Acc acc;
#pragma unroll
    for (int a = 0; a < 2; ++a)
#pragma unroll
        for (int b = 0; b < 2; ++b)
#pragma unroll
            for (int m = 0; m < 4; ++m)
#pragma unroll
                for (int n = 0; n < 2; ++n) acc[a][b][m][n] = (f32x4){0.f, 0.f, 0.f, 0.f};
    bf16x8 At[4][2], B0[2][2], B1[2][2];
    const char* cA0 = p.a_base(cur, 0) - p.a_bias(0); const char* cA1 = p.a_base(cur, S1) - p.a_bias(S1);
    const char* cB0 = p.b_base(cur, 0) - p.b_bias(0); const char* cB1 = p.b_base(cur, S1) - p.b_bias(S1);
    G8_STB(G8_SB(0, 0), cB0, false, 0); G8_STB(G8_SB(0, 1), cB0, false, 1); G8_STA(G8_SA(0, 0), cA0, false, 0); G8_STA(G8_SA(0, 1), cA0, false, 1);
    if (wr == 1) G8_BAR;
    G8_WAIT_V(2); G8_BAR;
    G8_STB(G8_SB(1, 0), cB0 + ksB0, false, 0); G8_STA(G8_SA(1, 0), cA0 + ksA0, false, 0); G8_STB(G8_SB(1, 1), cB0 + ksB0, false, 1);
    G8_WAIT_V(6); G8_BAR;
    for (;;) {
        const bool has_next = p.unit((ui + 1) * G + c, nxt);
        const int nt = p.nt(cur);
        const char* nA0 = has_next ? p.a_base(nxt, 0) - p.a_bias(0) : cA0; const char* nA1 = has_next ? p.a_base(nxt, S1) - p.a_bias(S1) : cA1;
        const char* nB0 = has_next ? p.b_base(nxt, 0) - p.b_bias(0) : cB0; const char* nB1 = has_next ? p.b_base(nxt, S1) - p.b_bias(S1) : cB1;
        for (int t = 0; t < nt; t += 2) {
            const bool last = (t == nt - 2);
            const bool sg1 = (NS > 1) && (t + 1 >= nt0);
            const bool sg2 = (NS > 1) && !last && (t + 2 >= nt0);
            const char* a1 = sg1 ? cA1 + (long)(t + 1 - nt0) * ksA1 : cA0 + (long)(t + 1) * ksA0;
            const char* a2 = last ? nA0 : (sg2 ? cA1 + (long)(t + 2 - nt0) * ksA1 : cA0 + (long)(t + 2) * ksA0);
            const char* b2 = last ? nB0 : (sg2 ? cB1 + (long)(t + 2 - nt0) * ksB1 : cB0 + (long)(t + 2) * ksB0);
            const char* a3 = a2 + (sg2 ? ksA1 : ksA0); const char* b3 = b2 + (sg2 ? ksB1 : ksB0);
            G8_LDB(B0, 0, 0); G8_LDB(B1, 0, 1); G8_SCHED; G8_LDA(At, 0, 0); G8_STA(G8_SA(1, 1), a1, sg1, 1);
            G8_WAIT_V(8); G8_WAIT_L(0); G8_BAR; G8_MMA(0, 0, At, B0); G8_MMA(0, 1, At, B1); G8_BAR; G8_SCHED;
            G8_LDA(At, 0, 1); G8_STB(G8_SB(0, 0), b2, sg2, 0); G8_STB(G8_SB(0, 1), b2, sg2, 1); G8_STA(G8_SA(0, 0), a2, sg2, 0);
            G8_WAIT_V(8); G8_WAIT_L(0); G8_BAR; G8_MMA(1, 0, At, B0); G8_MMA(1, 1, At, B1); G8_BAR; G8_SCHED;
            G8_LDB(B0, 1, 0); G8_LDB(B1, 1, 1); G8_SCHED; G8_LDA(At, 1, 0); G8_STA(G8_SA(0, 1), a2, sg2, 1);
            G8_WAIT_V(8); G8_WAIT_L(0); G8_BAR; G8_MMA(0, 0, At, B0); G8_MMA(0, 1, At, B1); G8_BAR; G8_SCHED;
            G8_LDA(At, 1, 1); G8_STB(G8_SB(1, 0), b3, sg2, 0); G8_STB(G8_SB(1, 1), b3, sg2, 1); G8_STA(G8_SA(1, 0), a3, sg2, 0);
            G8_WAIT_V(8); G8_WAIT_L(0); G8_BAR; G8_MMA(1, 0, At, B0); G8_MMA(1, 1, At, B1); G8_BAR; G8_SCHED;
        }
        if (wr == 0) G8_BAR;
        p.epi(acc, cur, wr, wc, fr, fq, lds);
        if (!has_next) break;
#pragma unroll
        for (int a = 0; a < 2; ++a)
#pragma unroll
            for (int b = 0; b < 2; ++b)
#pragma unroll
                for (int m = 0; m < 4; ++m)
#pragma unroll
                    for (int n = 0; n < 2; ++n) acc[a][b][m][n] = (f32x4){0.f, 0.f, 0.f, 0.f};
        cur = nxt; ++ui; cA0 = nA0; cA1 = nA1; cB0 = nB0; cB1 = nB1;
        if (wr == 1) G8_BAR;
    }
    G8_WAIT_V(0);
    G8_BAR;
#undef G8_SA
#undef G8_SB
#undef G8_STAGE1
#undef G8_STA
#undef G8_STB
#undef G8_LDA
#undef G8_LDB
#undef G8_MMA
#undef G8_WAIT_V
#undef G8_WAIT_L
#undef G8_BAR
#undef G8_SCHED
}

template <class P>
__device__ __forceinline__ void gemm_phase_naive(LAS unsigned char* lds, const P& p, const int G, const int c) {
    const int tid = threadIdx.x, wid = tid >> 6, lane = tid & 63, wr = wid >> 2, wc = wid & 3, fr = lane & 15, fq = lane >> 4;
    LAS float* As = (LAS float*)lds;
    LAS float* Bs = As + 16 * 260;
    const int nt0 = p.nt0();
    Unit u;
    for (int ui = 0; p.unit(ui * G + c, u); ++ui) {
        const int nt = p.nt(u);
        Acc acc;
#pragma unroll
        for (int a = 0; a < 2; ++a)
#pragma unroll
            for (int b = 0; b < 2; ++b)
#pragma unroll
                for (int m = 0; m < 4; ++m)
#pragma unroll
                    for (int n = 0; n < 2; ++n) acc[a][b][m][n] = (f32x4){0.f, 0.f, 0.f, 0.f};
        for (int k0 = 0; k0 < nt * 64; k0 += 16) {
            const int seg = (P::NSEG > 1 && k0 >= nt0 * 64) ? 1 : 0, ks = k0 - (seg ? nt0 * 64 : 0);
            { const int row = tid >> 1, h8 = tid & 1;
              const u32x4 va = *(const u32x4*)(p.a_base(u, seg) + p.a_off(seg, row, ks + 8 * h8));
              const u32x4 vb = *(const u32x4*)(p.b_base(u, seg) + p.b_off(seg, row, ks + 8 * h8));
              __syncthreads();
#pragma unroll
              for (int i = 0; i < 4; ++i) { As[(8 * h8 + 2 * i) * 260 + row] = bf2f(va[i]); As[(8 * h8 + 2 * i + 1) * 260 + row] = bf2f(va[i] >> 16);
                                            Bs[(8 * h8 + 2 * i) * 260 + row] = bf2f(vb[i]); Bs[(8 * h8 + 2 * i + 1) * 260 + row] = bf2f(vb[i] >> 16); }
              __syncthreads(); }
            for (int kk = 0; kk < 16; ++kk) {
                float av[2][4], bv[2][2][4];
#pragma unroll
                for (int ai = 0; ai < 2; ++ai)
#pragma unroll
                    for (int m = 0; m < 4; ++m) av[ai][m] = As[kk * 260 + ai * 128 + wr * 64 + m * 16 + fr];
#pragma unroll
                for (int bj = 0; bj < 2; ++bj)
#pragma unroll
                    for (int n = 0; n < 2; ++n)
#pragma unroll
                        for (int j = 0; j < 4; ++j) bv[bj][n][j] = Bs[kk * 260 + bj * 128 + wc * 32 + (P::PERM ? 8 * fq + 4 * n + j : 16 * n + 4 * fq + j)];
#pragma unroll
                for (int ai = 0; ai < 2; ++ai)
#pragma unroll
                    for (int bj = 0; bj < 2; ++bj)
#pragma unroll
                        for (int m = 0; m < 4; ++m)
#pragma unroll
                            for (int n = 0; n < 2; ++n)
#pragma unroll
                                for (int j = 0; j < 4; ++j) acc[ai][bj][m][n][j] += av[ai][m] * bv[bj][n][j];
            }
        }
        __syncthreads();
        p.epi(acc, u, wr, wc, fr, fq, lds);
        __syncthreads();
    }
}


struct ProbG1 {
    static constexpr bool PERM = false; static constexpr int NSEG = 1;
    const char* HX; const char* HXV; const char* W1; const float* convw; char* A2;
    __host__ __device__ int nt0() const { return 16; } __host__ __device__ int nt(const Unit&) const { return 16; }
    __host__ __device__ long a_bias(int) const { return 0; } __host__ __device__ long b_bias(int) const { return 0; }
    __host__ __device__ bool unit(int L, Unit& u) const { return order_mn(L, RT / 256, 32, u); }
    __host__ __device__ const char* a_base(const Unit& u, int) const { return ((u.pn < 16 || u.pm >= 128) ? HX : HXV) + (size_t)u.pm * 256 * 128; }
    __host__ __device__ long a_off(int, int r, int k) const { return (long)r * 128 + (long)(k >> 6) * (long)HXPLANE + (k & 63) * 2; }
    __host__ __device__ const char* b_base(const Unit& u, int) const { return W1 + (size_t)u.pn * 256 * 128; }
    __host__ __device__ long b_off(int, int c, int k) const { return (long)c * 128 + (long)(k >> 6) * (8192L * 128) + (k & 63) * 2; }
    __device__ __forceinline__ void epi(Acc& acc, const Unit& u, int wr, int wc, int fr, int fq, LAS unsigned char* lds) const {
        LAS float* xb = (LAS float*)(lds + XL_OFF); const LAS float* cw = (const LAS float*)(lds + CWL_OFF);
        const bool chain = (u.pn >= 16) || (u.pm >= 128);
        const bool vert = (u.pn >= 16) && (u.pm < 128);
        const int ch0 = wc * 16 + fq * 4, chg = u.pn * 64 + ch0;
        const f32x4 w0 = *(const LAS f32x4*)(cw + chg), w1 = *(const LAS f32x4*)(cw + 2048 + chg), w2 = *(const LAS f32x4*)(cw + 4096 + chg);
        f32x4 uu[2][4];
#pragma unroll
        for (int ai = 0; ai < 2; ++ai)
#pragma unroll
            for (int m = 0; m < 4; ++m) uu[ai][m] = acc[ai][0][m][1] * acc[ai][1][m][0];
        f32x4 bu[2] = {{0.f, 0.f, 0.f, 0.f}, {0.f, 0.f, 0.f, 0.f}}, bd[2] = {{0.f, 0.f, 0.f, 0.f}, {0.f, 0.f, 0.f, 0.f}};
        if (chain) {
            const int sl = ch0;
#pragma unroll
            for (int ai = 0; ai < 2; ++ai) { const int bi = 2 * ai + wr;
                if (fr == 0) *(LAS f32x4*)(xb + (bi * 2 + 0) * 64 + sl) = uu[ai][0];
                if (fr == 15) *(LAS f32x4*)(xb + (bi * 2 + 1) * 64 + sl) = uu[ai][3]; }
            LDS_WAIT(); __builtin_amdgcn_s_barrier();
#pragma unroll
            for (int ai = 0; ai < 2; ++ai) { const int bi = 2 * ai + wr;
                if (bi > 0) bu[ai] = *(const LAS f32x4*)(xb + ((bi - 1) * 2 + 1) * 64 + sl);
                if (bi < 3) bd[ai] = *(const LAS f32x4*)(xb + ((bi + 1) * 2 + 0) * 64 + sl); }
        }
#pragma unroll
        for (int ai = 0; ai < 2; ++ai)
#pragma unroll
            for (int m = 0; m < 4; ++m) {
                const int rt = ai * 128 + wr * 64 + m * 16 + fr;
                f32x4 upv, dnv;
#pragma unroll
                for (int j = 0; j < 4; ++j) {
                    const float cu = (m == 0) ? bu[ai][j] : dpp_ror1(uu[ai][m > 0 ? m - 1 : 0][j]);
                    upv[j] = dpp_from_prev(cu, uu[ai][m][j]);
                    const float cd = (m == 3) ? bd[ai][j] : dpp_ror15(uu[ai][m < 3 ? m + 1 : 3][j]);
                    dnv[j] = dpp_from_next(cd, uu[ai][m][j]); }
                const f32x4 yc = w1 * uu[ai][m] + w0 * upv + w2 * dnv;
                const f32x4 bgv = acc[ai][0][m][0], zv = acc[ai][1][m][1];
                f32x4 o;
#pragma unroll
                for (int j = 0; j < 4; ++j) o[j] = bgv[j] * yc[j] * siluf_(zv[j]);
                const int tok = vert ? ((u.pm >> 6) * SEQ + rt * GRIDW + (u.pm & 63)) : (u.pm * 256 + rt);
                u32x2 w; w.x = pk2(o[0], o[1]); w.y = pk2(o[2], o[3]);
                *(u32x2*)(A2 + (size_t)u.pn * HXPLANE + (size_t)tok * 128 + ch0 * 2) = w;
            }
    }
};

struct ProbG2 {
    static constexpr bool PERM = true; static constexpr int NSEG = 1;
    const char* A2; const char* W2; const float* mod; char* f1; float* y1s;
    __host__ __device__ int nt0() const { return 32; } __host__ __device__ int nt(const Unit& u) const { return u.pm >= 128 ? 4 : 32; }
    __host__ __device__ long a_bias(int) const { return 0; } __host__ __device__ long b_bias(int) const { return 0; }
    __host__ __device__ bool unit(int L, Unit& u) const {
        if (L < 512) return order_mn(L, RL / 256, 4, u);
        const int idx = L - 512; if (idx >= 64) return false;
        u.ks = idx & 7; const int tile = idx >> 3; u.pm = 128 + (tile >> 2); u.pn = tile & 3; u.g = 0; return true; }
    __host__ __device__ const char* a_base(const Unit& u, int) const { return A2 + (size_t)u.pm * 256 * 128 + (size_t)u.ks * 4 * HXPLANE; }
    __host__ __device__ long a_off(int, int r, int k) const { return (long)r * 128 + (long)(k >> 6) * (long)HXPLANE + (k & 63) * 2; }
    __host__ __device__ const char* b_base(const Unit& u, int) const { return W2 + (size_t)u.pn * 256 * 128 + (size_t)u.ks * 4 * (1024 * 128); }
    __host__ __device__ long b_off(int, int c, int k) const { return (long)c * 128 + (long)(k >> 6) * (1024L * 128) + (k & 63) * 2; }
    __device__ __forceinline__ void epi(Acc& acc, const Unit& u, int wr, int wc, int fr, int fq, LAS unsigned char*) const {
        const int col0 = u.pn * 256 + wc * 32 + 8 * fq;
        if (u.pm >= 128) {
#pragma unroll
            for (int ai = 0; ai < 2; ++ai)
#pragma unroll
                for (int m = 0; m < 4; ++m) { float* rowp = y1s + ((size_t)u.ks * RC + (u.pm - 128) * 256 + ai * 128 + wr * 64 + m * 16 + fr) * D + col0;
#pragma unroll
                    for (int bj = 0; bj < 2; ++bj)
#pragma unroll
                        for (int n = 0; n < 2; ++n) *(f32x4*)(rowp + bj * 128 + n * 4) = acc[ai][bj][m][n]; }
            return; }
        const int rho = u.pm >> 6;
        f32x4 gt[2][2];
#pragma unroll
        for (int bj = 0; bj < 2; ++bj)
#pragma unroll
            for (int n = 0; n < 2; ++n) gt[bj][n] = *(const f32x4*)(mod + rho * 3072 + 2048 + col0 + bj * 128 + n * 4);
#pragma unroll
        for (int ai = 0; ai < 2; ++ai)
#pragma unroll
            for (int m = 0; m < 4; ++m) { char* rowp = f1 + (size_t)(u.pm * 256 + ai * 128 + wr * 64 + m * 16 + fr) * 4096 + 2048 + col0 * 2;
#pragma unroll
                for (int bj = 0; bj < 2; ++bj) { const f32x4 v0 = gt[bj][0] * acc[ai][bj][m][0], v1 = gt[bj][1] * acc[ai][bj][m][1];
                    u32x4 w; w.x = pk2(v0[0], v0[1]); w.y = pk2(v0[2], v0[3]); w.z = pk2(v1[0], v1[1]); w.w = pk2(v1[2], v1[3]);
                    *(u32x4*)(rowp + bj * 256) = w; } }
    }
};

struct ProbG3 {
    static constexpr bool PERM = true; static constexpr int NSEG = 1;
    const char* HX; const char* W3; char* X; float* ucs; char* SZ; int zhalf;
    __host__ __device__ int nt0() const { return 16; } __host__ __device__ int nt(const Unit& u) const { return u.pm >= 128 ? 4 : 16; }
    __host__ __device__ long a_bias(int) const { return 0; } __host__ __device__ long b_bias(int) const { return 0; }
    __host__ __device__ bool unit(int L, Unit& u) const {
        if (L < 1024) return order_mn(L, RL / 256, 8, u);
        const int idx = L - 1024; if (zhalf || idx >= 64) return false;
        u.ks = idx & 3; const int tile = idx >> 2; u.pm = 128 + (tile >> 3); u.pn = tile & 7; u.g = 0; return true; }
    __host__ __device__ const char* a_base(const Unit& u, int) const { return HX + (size_t)u.pm * 256 * 128 + (size_t)u.ks * 4 * HXPLANE; }
    __host__ __device__ long a_off(int, int r, int k) const { return (long)r * 128 + (long)(k >> 6) * (long)HXPLANE + (k & 63) * 2; }
    __host__ __device__ const char* b_base(const Unit& u, int) const { return W3 + (size_t)(zhalf * 2048 + u.pn * 256) * 128 + (size_t)u.ks * 4 * (4096 * 128); }
    __host__ __device__ long b_off(int, int c, int k) const { return (long)c * 128 + (long)(k >> 6) * (4096L * 128) + (k & 63) * 2; }
    __device__ __forceinline__ void epi(Acc& acc, const Unit& u, int wr, int wc, int fr, int fq, LAS unsigned char*) const {
#pragma unroll
        for (int ai = 0; ai < 2; ++ai)
#pragma unroll
            for (int m = 0; m < 4; ++m) { const int tok = u.pm * 256 + ai * 128 + wr * 64 + m * 16 + fr;
#pragma unroll
                for (int bj = 0; bj < 2; ++bj) { const int n0 = u.pn * 256 + bj * 128 + wc * 32 + 8 * fq;
                    f32x4 v0 = acc[ai][bj][m][0], v1 = acc[ai][bj][m][1];
                    if (u.pm >= 128) { float* rp = ucs + ((size_t)u.ks * RC + (tok - RL)) * 2048 + n0; *(f32x4*)rp = v0; *(f32x4*)(rp + 4) = v1; continue; }
                    if (zhalf) {
#pragma unroll
                        for (int j = 0; j < 4; ++j) { v0[j] = siluf_(v0[j]); v1[j] = siluf_(v1[j]); } }
                    u32x4 w; w.x = pk2(v0[0], v0[1]); w.y = pk2(v0[2], v0[3]); w.z = pk2(v1[0], v1[1]); w.w = pk2(v1[2], v1[3]);
                    if (zhalf) *(u32x4*)(SZ + ((size_t)tok * 2048 + n0) * 2) = w;
                    else { const int g = n0 >> 4, p0 = n0 & 15;
                        const int b = tok / SEQ, tt = tok % SEQ, col = b * NCHB + tt / TCH, t = tt % TCH;
                        *(u32x4*)(X + (size_t)g * XPLANE + ((size_t)col * XLD + t * 16 + p0) * 2) = w; } } }
    }
};
__device__ __forceinline__ void reduce_uctx(const float* ucs, char* UCTX, int gtid, int gthreads) {
    for (int idx = gtid; idx < RC * 256; idx += gthreads) { const int row = idx >> 8, n0 = (idx & 255) * 8;
        f32x4 a0 = {0.f, 0.f, 0.f, 0.f}, a1 = a0;
#pragma unroll
        for (int ks = 0; ks < 4; ++ks) { const float* rp = ucs + ((size_t)ks * RC + row) * 2048 + n0; a0 += *(const f32x4*)rp; a1 += *(const f32x4*)(rp + 4); }
        u32x4 w; w.x = pk2(a0[0], a0[1]); w.y = pk2(a0[2], a0[3]); w.z = pk2(a1[0], a1[1]); w.w = pk2(a1[2], a1[3]);
        *(u32x4*)(UCTX + (size_t)(n0 >> 4) * (RC * 32) + (size_t)row * 32 + (n0 & 15) * 2) = w; }
}

struct ProbS {
    static constexpr bool PERM = true; static constexpr int NSEG = 1;
    const char* X; const char* M2; char* S; int g, b;
    __host__ __device__ int nt0() const { return TP / 64; } __host__ __device__ int nt(const Unit&) const { return TP / 64; }
    __host__ __device__ long a_bias(int) const { return 0; } __host__ __device__ long b_bias(int) const { return 0; }
    __host__ __device__ bool unit(int L, Unit& u) const { if (L >= NCHB / 256) return false; u.g = g; u.pm = 0; u.pn = b * (NCHB / 256) + L; u.ks = 0; return true; }
    __host__ __device__ const char* a_base(const Unit& u, int) const { return M2 + (size_t)u.g * MiB; }
    __host__ __device__ long a_off(int, int r, int k) const { return (long)r * TP * 2 + k * 2; }
    __host__ __device__ const char* b_base(const Unit& u, int) const { return X + (size_t)u.g * XPLANE + (size_t)u.pn * 256 * XLD * 2; }
    __host__ __device__ long b_off(int, int c, int k) const { return (long)c * XLD * 2 + k * 2; }
    __device__ __forceinline__ void epi(Acc& acc, const Unit& u, int wr, int wc, int fr, int fq, LAS unsigned char*) const {
#pragma unroll
        for (int ai = 0; ai < 2; ++ai)
#pragma unroll
            for (int m = 0; m < 4; ++m) { const int j = ai * 128 + wr * 64 + m * 16 + fr;
                char* rowp = S + (size_t)u.g * MiB + ((size_t)j * NCOL + u.pn * 256 + wc * 32 + 8 * fq) * 2;
#pragma unroll
                for (int bj = 0; bj < 2; ++bj) { const f32x4 v0 = acc[ai][bj][m][0], v1 = acc[ai][bj][m][1];
                    u32x4 w; w.x = pk2(v0[0], v0[1]); w.y = pk2(v0[2], v0[3]); w.z = pk2(v1[0], v1[1]); w.w = pk2(v1[2], v1[3]);
                    *(u32x4*)(rowp + bj * 256) = w; } }
    }
};

struct ProbY {
    static constexpr bool PERM = true; static constexpr int NSEG = 2;
    const char* X; const char* KR; const char* M4; char* Gout; int g, b;
    __host__ __device__ int nt0() const { return TP / 64; } __host__ __device__ int nt(const Unit&) const { return XLD / 64; }
    __host__ __device__ long a_bias(int) const { return 0; } __host__ __device__ long b_bias(int seg) const { return seg ? 0 : 96; }
    __host__ __device__ bool unit(int L, Unit& u) const { constexpr int nN = TP / 256, nM = NCHB / 256; if (L >= nN * nM) return false; u.g = g; u.pm = b * nM + L / nN; u.pn = L % nN; u.ks = 0; return true; }
    __host__ __device__ const char* a_base(const Unit& u, int seg) const { return X + (size_t)u.g * XPLANE + (size_t)u.pm * 256 * XLD * 2 + (seg ? TP * 2 : 0); }
    __host__ __device__ long a_off(int, int r, int k) const { return (long)r * XLD * 2 + k * 2; }
    __host__ __device__ const char* b_base(const Unit& u, int seg) const {
        return seg ? M4 + (size_t)u.g * TP * 512 + (size_t)u.pn * 256 * 512 : KR + (size_t)u.g * KRG * 2 + (size_t)(TCH - 1 - 16 * u.pn) * 32; }
    __host__ __device__ long b_off(int seg, int c, int k) const { return seg ? (long)c * 512 + k * 2 : ((long)(c & 15) * PSTR - (long)(c >> 4) * 16 + k) * 2; }
    __device__ __forceinline__ void epi(Acc& acc, const Unit& u, int wr, int wc, int fr, int fq, LAS unsigned char*) const {
#pragma unroll
        for (int ai = 0; ai < 2; ++ai)
#pragma unroll
            for (int m = 0; m < 4; ++m) { const int col = u.pm * 256 + ai * 128 + wr * 64 + m * 16 + fr;
#pragma unroll
                for (int bj = 0; bj < 2; ++bj) { const int n0 = u.pn * 256 + bj * 128 + wc * 32 + 8 * fq;
                    const f32x4 v0 = acc[ai][bj][m][0], v1 = acc[ai][bj][m][1];
                    u32x4 w; w.x = pk2(gelu_tanh(v0[0]), gelu_tanh(v0[1])); w.y = pk2(gelu_tanh(v0[2]), gelu_tanh(v0[3]));
                    w.z = pk2(gelu_tanh(v1[0]), gelu_tanh(v1[1])); w.w = pk2(gelu_tanh(v1[2]), gelu_tanh(v1[3]));
                    *(u32x4*)(Gout + (size_t)u.g * GPLANE + ((size_t)col * TP + n0) * 2) = w; } }
    }
};

struct ProbG4 {
    static constexpr bool PERM = true; static constexpr int NSEG = 1;
    const char* Gin; const char* WG; const char* SZ; const float* bglu; char* A4;
    __host__ __device__ int nt0() const { return 32; } __host__ __device__ int nt(const Unit&) const { return 32; }
    __host__ __device__ long a_bias(int) const { return 0; } __host__ __device__ long b_bias(int) const { return 0; }
    __host__ __device__ bool unit(int L, Unit& u) const { return order_mn(L, RL / 256, 8, u); }
    __host__ __device__ const char* a_base(const Unit& u, int) const { return Gin + (size_t)u.pm * 256 * 32; }
    __host__ __device__ long a_off(int, int r, int k) const { return (long)(k >> 4) * (long)GPLANE + (long)r * 32 + (k & 15) * 2; }
    __host__ __device__ const char* b_base(const Unit& u, int) const { return WG + (size_t)u.pn * 256 * 128; }
    __host__ __device__ long b_off(int, int c, int k) const { return (long)c * 128 + (long)(k >> 6) * (2048L * 128) + (k & 63) * 2; }
    __device__ __forceinline__ void epi(Acc& acc, const Unit& u, int wr, int wc, int fr, int fq, LAS unsigned char*) const {
        f32x4 b0[2], b1[2];
#pragma unroll
        for (int bj = 0; bj < 2; ++bj) { const int n0 = u.pn * 256 + bj * 128 + wc * 32 + 8 * fq; b0[bj] = *(const f32x4*)(bglu + n0); b1[bj] = *(const f32x4*)(bglu + n0 + 4); }
#pragma unroll
        for (int ai = 0; ai < 2; ++ai) {
            u32x4 gv[4][2], sv[4][2];
#pragma unroll
            for (int m = 0; m < 4; ++m) { const int tok = u.pm * 256 + ai * 128 + wr * 64 + m * 16 + fr;
#pragma unroll
                for (int bj = 0; bj < 2; ++bj) { const int n0 = u.pn * 256 + bj * 128 + wc * 32 + 8 * fq;
                    gv[m][bj] = __builtin_nontemporal_load((const u32x4*)(Gin + (size_t)(n0 >> 4) * GPLANE + (size_t)tok * 32 + (n0 & 15) * 2));
                    sv[m][bj] = __builtin_nontemporal_load((const u32x4*)(SZ + ((size_t)tok * 2048 + n0) * 2)); } }
#pragma unroll
            for (int m = 0; m < 4; ++m) { const int tok = u.pm * 256 + ai * 128 + wr * 64 + m * 16 + fr;
#pragma unroll
                for (int bj = 0; bj < 2; ++bj) { const int n0 = u.pn * 256 + bj * 128 + wc * 32 + 8 * fq;
                    const f32x4 v0 = acc[ai][bj][m][0] + b0[bj], v1 = acc[ai][bj][m][1] + b1[bj];
                    float o[8];
#pragma unroll
                    for (int i = 0; i < 4; ++i) { const float g0 = bf2f(gv[m][bj][i]), g1 = bf2f(gv[m][bj][i] >> 16), s0 = bf2f(sv[m][bj][i]), s1 = bf2f(sv[m][bj][i] >> 16);
                        const float a0 = (2 * i < 4) ? v0[2 * i] : v1[2 * i - 4], a1 = (2 * i + 1 < 4) ? v0[2 * i + 1] : v1[2 * i + 1 - 4];
                        o[2 * i] = g0 * sigmoidf_(a0) * s0; o[2 * i + 1] = g1 * sigmoidf_(a1) * s1; }
                    u32x4 w; w.x = pk2(o[0], o[1]); w.y = pk2(o[2], o[3]); w.z = pk2(o[4], o[5]); w.w = pk2(o[6], o[7]);
                    *(u32x4*)(A4 + (size_t)(n0 >> 6) * A4PLANE + (size_t)tok * 128 + (n0 & 63) * 2) = w; } } }
    }
};

struct ProbG5 {
    static constexpr bool PERM = true; static constexpr int NSEG = 1;
    const char* A4; const char* W5; const float* mod; char* fo;
    __host__ __device__ int nt0() const { return 32; } __host__ __device__ int nt(const Unit&) const { return 32; }
    __host__ __device__ long a_bias(int) const { return 0; } __host__ __device__ long b_bias(int) const { return 0; }
    __host__ __device__ bool unit(int L, Unit& u) const { return order_mn(L, RL / 256, 4, u); }
    __host__ __device__ const char* a_base(const Unit& u, int) const { return A4 + (size_t)u.pm * 256 * 128; }
    __host__ __device__ long a_off(int, int r, int k) const { return (long)r * 128 + (long)(k >> 6) * (long)A4PLANE + (k & 63) * 2; }
    __host__ __device__ const char* b_base(const Unit& u, int) const { return W5 + (size_t)u.pn * 256 * 128; }
    __host__ __device__ long b_off(int, int c, int k) const { return (long)c * 128 + (long)(k >> 6) * (1024L * 128) + (k & 63) * 2; }
    __device__ __forceinline__ void epi(Acc& acc, const Unit& u, int wr, int wc, int fr, int fq, LAS unsigned char*) const {
        const int rho = u.pm >> 6, col0 = u.pn * 256 + wc * 32 + 8 * fq;
        f32x4 gt[2][2];
#pragma unroll
        for (int bj = 0; bj < 2; ++bj)
#pragma unroll
            for (int n = 0; n < 2; ++n) gt[bj][n] = *(const f32x4*)(mod + (3 + rho) * 3072 + 2048 + col0 + bj * 128 + n * 4);
#pragma unroll
        for (int ai = 0; ai < 2; ++ai)
#pragma unroll
            for (int m = 0; m < 4; ++m) { char* rowp = fo + ((size_t)(u.pm * 256 + ai * 128 + wr * 64 + m * 16 + fr) * D + col0) * 2;
#pragma unroll
                for (int bj = 0; bj < 2; ++bj) { const f32x4 v0 = gt[bj][0] * acc[ai][bj][m][0], v1 = gt[bj][1] * acc[ai][bj][m][1];
                    u32x4 w; w.x = pk2(v0[0], v0[1]); w.y = pk2(v0[2], v0[3]); w.z = pk2(v1[0], v1[1]); w.w = pk2(v1[2], v1[3]);
                    *(u32x4*)(rowp + bj * 256) = w; } }
    }
};
}

struct Frame {
    LAS unsigned char* lds;
    int tid, lane, wave, G, bid;
    const float* in[23]; float* out; unsigned char* ws;
};

template <class RM>
__device__ __forceinline__ void transpose_item(const float* W, int K, int N, bf16* WT, LAS float* scr, int item, int lane, RM rowmap) {
    const int nblk = N / 64, kb = item / nblk, nb = item % nblk, k0 = 64 * kb, n0 = 64 * nb;
    f32x4 v[16];
#pragma unroll
    for (int i = 0; i < 16; ++i) v[i] = __builtin_nontemporal_load((const f32x4*)(W + (size_t)(k0 + 4 * i + (lane >> 4)) * N + n0 + 4 * (lane & 15)));
#pragma unroll
    for (int i = 0; i < 16; ++i) { LAS float* d = scr + (4 * i + (lane >> 4)) * 65 + 4 * (lane & 15); d[0] = v[i][0]; d[1] = v[i][1]; d[2] = v[i][2]; d[3] = v[i][3]; }
    LDS_WAIT(); asm volatile("" ::: "memory");
    const int c = lane & 7;
#pragma unroll
    for (int j = 0; j < 8; ++j) { const int n = (lane >> 3) + 8 * j; const LAS float* sp = scr + (8 * c) * 65 + n;
        u32x4 o; o.x = pk2(sp[0 * 65], sp[1 * 65]); o.y = pk2(sp[2 * 65], sp[3 * 65]); o.z = pk2(sp[4 * 65], sp[5 * 65]); o.w = pk2(sp[6 * 65], sp[7 * 65]);
        *(u32x4*)(WT + (size_t)kb * N * 64 + (size_t)rowmap(n0 + n) * 64 + 8 * c) = o; }
    LDS_WAIT(); asm volatile("" ::: "memory");
}
struct RowId { __device__ int operator()(int n) const { return n; } };
struct RowW1 { __device__ int operator()(int n) const { const int p = n >> 11, chg = n & 2047, nt = chg >> 6, ch = chg & 63; return nt * 256 + 128 * (p >> 1) + 16 * (p & 1) + 32 * (ch >> 4) + (ch & 15); } };

__device__ __forceinline__ void prep_ssm(Frame& F) {
    LAS float* fl = (LAS float*)F.lds;
    const int tid = F.tid;
    for (int prep_ = 0; prep_ < (PROBE_PREP_PART == 0 ? 2 : 1); ++prep_)
    for (int item = F.bid; item < 2 * NG; item += F.G) {
        const int g = item >> 1, r = item & 1;
        LAS float* Av = fl; LAS float* Fv = fl + 256; LAS float* BBs = fl + 512; LAS float* Cs = fl + 4608; LAS float* PW = fl + 8768;
        __syncthreads();
        float pbre[4], pbim[4], pcre[4], pcim[4];
#pragma unroll
        for (int it = 0; it < 4; ++it) { const int e = tid + 512 * it, rr = e >> 10, n = (e >> 4) & 63, q = e & 15, p = (e >> 6) & 15, nn = e & 63;
            pbre[it] = F.in[I_BRE][((size_t)(rr * NG + g) * 64 + n) * 16 + q]; pbim[it] = F.in[I_BIM][((size_t)(rr * NG + g) * 64 + n) * 16 + q];
            pcre[it] = F.in[I_CRE][((size_t)(rr * NG + g) * 16 + p) * 64 + nn]; pcim[it] = F.in[I_CIM][((size_t)(rr * NG + g) * 16 + p) * 64 + nn]; }
        if (tid < 128) { const int rr = tid >> 6, n = tid & 63;
            const float dt = expf(F.in[I_LSTEP][rr * NG + g]);
            const float lre = F.in[I_LRE][(rr * NG + g) * 64 + n], lim = F.in[I_LIM][(rr * NG + g) * 64 + n];
            const float mag = expf(lre * dt); float sn, cs; sincosf(lim * dt, &sn, &cs);
            const float ar = mag * cs, ai = mag * sn, qr = ar - 1.0f, qi = ai, den = lre * lre + lim * lim;
            Av[(rr * 64 + n) * 2] = ar; Av[(rr * 64 + n) * 2 + 1] = ai;
            Fv[(rr * 64 + n) * 2] = (qr * lre + qi * lim) / den; Fv[(rr * 64 + n) * 2 + 1] = (qi * lre - qr * lim) / den;
        }
        __syncthreads();
#pragma unroll
        for (int it = 0; it < 4; ++it) { const int e = tid + 512 * it, rr = e >> 10, n = (e >> 4) & 63, q = e & 15;
            const float bre = pbre[it], bim = pbim[it];
            const float fr_ = Fv[(rr * 64 + n) * 2], fi_ = Fv[(rr * 64 + n) * 2 + 1];
            const float bbr = fr_ * bre - fi_ * bim, bbi = fr_ * bim + fi_ * bre;
            BBs[e * 2] = bbr; BBs[e * 2 + 1] = bbi;
            if (rr == r) { float* bg = (float*)(F.ws + WS_BBG) + (((size_t)(r * NG + g) * 64 + n) * 16 + q) * 2; bg[0] = bbr; bg[1] = bbi; }
            const int p = (e >> 6) & 15, nn = e & 63;
            Cs[((rr * 16 + p) * 65 + nn) * 2] = pcre[it];
            Cs[((rr * 16 + p) * 65 + nn) * 2 + 1] = pcim[it]; }
        __syncthreads();
        if (tid < 64) { const int n = tid; const float ar = Av[(r * 64 + n) * 2], ai = Av[(r * 64 + n) * 2 + 1]; float pr = 1.f, pi = 0.f;
            for (int e = 0; e <= TCH; ++e) { PW[(n * 65 + e) * 2] = pr; PW[(n * 65 + e) * 2 + 1] = pi; const float nr = pr * ar - pi * ai, ni = pr * ai + pi * ar; pr = nr; pi = ni; }
            float* za = (float*)(F.ws + WS_ZA) + ((size_t)(r * NG + g) * 64 + n) * 4; za[0] = ar; za[1] = ai; za[2] = PW[(n * 65 + TCH) * 2]; za[3] = PW[(n * 65 + TCH) * 2 + 1]; }
        __syncthreads();
        { bf16* M2g = (bf16*)(F.ws + WS_M2 + (size_t)g * MiB);
          constexpr int TPR = TP / 8;
          const int k8 = (tid % TPR) * 8, s_ = k8 >> 4, q0 = k8 & 15, e = r ? s_ : (TCH - 1 - s_);
          for (int j = tid / TPR; j < 128; j += 512 / TPR) { const int cc = j >> 6, n = j & 63;
            const float pr = PW[(n * 65 + e) * 2], pi = PW[(n * 65 + e) * 2 + 1];
            float v[8];
#pragma unroll
            for (int i = 0; i < 8; ++i) { const float br_ = BBs[((r * 64 + n) * 16 + q0 + i) * 2], bi_ = BBs[((r * 64 + n) * 16 + q0 + i) * 2 + 1]; v[i] = cc ? (pr * bi_ + pi * br_) : (pr * br_ - pi * bi_); }
            u32x4 w; w.x = pk2(v[0], v[1]); w.y = pk2(v[2], v[3]); w.z = pk2(v[4], v[5]); w.w = pk2(v[6], v[7]);
            *(u32x4*)(M2g + (size_t)(r * 128 + j) * TP + k8) = w; } }
        { bf16* M4g = (bf16*)(F.ws + WS_M4) + (size_t)g * TP * 256;
          const int jj0 = (tid & 15) * 8, cc = jj0 >> 6, n0 = jj0 & 63;
          for (int row = tid >> 4; row < TP; row += 32) { const int t = row >> 4, p = row & 15, e = r ? (TCH - t) : (t + 1);
            float v[8];
#pragma unroll
            for (int i = 0; i < 8; ++i) { const float cr = Cs[((r * 16 + p) * 65 + n0 + i) * 2], ci = Cs[((r * 16 + p) * 65 + n0 + i) * 2 + 1], pr = PW[((n0 + i) * 65 + e) * 2], pi = PW[((n0 + i) * 65 + e) * 2 + 1];
                v[i] = cc ? -(cr * pi + ci * pr) : (cr * pr - ci * pi); }
            u32x4 w; w.x = pk2(v[0], v[1]); w.y = pk2(v[2], v[3]); w.z = pk2(v[4], v[5]); w.w = pk2(v[6], v[7]);
            *(u32x4*)(M4g + (size_t)row * 256 + r * 128 + jj0) = w; } }
        { bf16* KRg = (bf16*)(F.ws + WS_KR) + (size_t)g * KRG;
          const int p = tid & 15, es = tid >> 4;
          for (int jx = es; jx < TCH; jx += 32) {
            int j, e; if (r == 0) { j = jx; e = TCH - 1 - jx; } else { if (jx == 0) continue; j = TCH - 1 + jx; e = jx; }
            float a16[16];
#pragma unroll
            for (int q = 0; q < 16; ++q) a16[q] = 0.f;
#pragma unroll 2
            for (int n = 0; n < 64; ++n) { const float cr = Cs[((r * 16 + p) * 65 + n) * 2], ci = Cs[((r * 16 + p) * 65 + n) * 2 + 1], pr = PW[(n * 65 + e) * 2], pi = PW[(n * 65 + e) * 2 + 1];
                const float wr_ = cr * pr - ci * pi, wi_ = cr * pi + ci * pr;
                const LAS f32x4* bq = (const LAS f32x4*)(BBs + ((r * 64 + n) * 16) * 2);
#pragma unroll
                for (int q2 = 0; q2 < 8; ++q2) { const f32x4 bv = bq[q2]; a16[2 * q2] += wr_ * bv[0] - wi_ * bv[1]; a16[2 * q2 + 1] += wr_ * bv[2] - wi_ * bv[3]; } }
            if (r == 0 && e == 0) {
                for (int n = 0; n < 64; ++n) { const float cr = Cs[((16 + p) * 65 + n) * 2], ci = Cs[((16 + p) * 65 + n) * 2 + 1];
                    const LAS f32x4* bq = (const LAS f32x4*)(BBs + ((64 + n) * 16) * 2);
#pragma unroll
                    for (int q2 = 0; q2 < 8; ++q2) { const f32x4 bv = bq[q2]; a16[2 * q2] += cr * bv[0] - ci * bv[1]; a16[2 * q2 + 1] += cr * bv[2] - ci * bv[3]; } }
                const float dv = F.in[I_SD][g * 16 + p];
#pragma unroll
                for (int q = 0; q < 16; ++q) if (q == p) a16[q] += dv; }
            u32x4 w0, w1; w0.x = pk2(a16[0], a16[1]); w0.y = pk2(a16[2], a16[3]); w0.z = pk2(a16[4], a16[5]); w0.w = pk2(a16[6], a16[7]);
            w1.x = pk2(a16[8], a16[9]); w1.y = pk2(a16[10], a16[11]); w1.z = pk2(a16[12], a16[13]); w1.w = pk2(a16[14], a16[15]);
            *(u32x4*)(KRg + (size_t)p * PSTR + j * 16) = w0; *(u32x4*)(KRg + (size_t)p * PSTR + j * 16 + 8) = w1; } }
    }
    __syncthreads();
}
__device__ __forceinline__ void prep_mod(Frame& F) {
    LAS float* fl = (LAS float*)F.lds;
    const int tid = F.tid;
    for (int prep_ = 0; prep_ < (PROBE_PREP_PART == 1 ? 2 : 1); ++prep_)
    {   LAS float* sc = fl;
        for (int e = tid; e < 3 * D; e += 512) { const int rho = e >> 10, k = e & 1023; const float v = rho < 2 ? F.in[I_C][rho * D + k] : F.in[I_CCTX][k]; sc[e] = siluf_(v); }
        __syncthreads();
        LAS float* red = fl + 3 * D;
        for (int item = F.bid; item < 2 * 96; item += F.G) {
            const int layer = item / 96, n0 = (item % 96) * 32, kk = tid >> 5, nn = tid & 31;
            const float* w = F.in[I_ADAW] + (size_t)layer * D * 3072 + n0 + nn;
            float s0 = 0.f, s1 = 0.f, s2 = 0.f;
            for (int k = kk; k < D; k += 256) { float wv[16];
#pragma unroll
                for (int i = 0; i < 16; ++i) wv[i] = w[(size_t)(k + 16 * i) * 3072];
#pragma unroll
                for (int i = 0; i < 16; ++i) { s0 += sc[k + 16 * i] * wv[i]; s1 += sc[D + k + 16 * i] * wv[i]; s2 += sc[2 * D + k + 16 * i] * wv[i]; } }
            red[(kk * 32 + nn) * 3] = s0; red[(kk * 32 + nn) * 3 + 1] = s1; red[(kk * 32 + nn) * 3 + 2] = s2;
            __syncthreads();
            if (tid < 96) { const int rho = tid >> 5, n = tid & 31; float s = 0.f;
                for (int k2 = 0; k2 < 16; ++k2) s += red[(k2 * 32 + n) * 3 + rho];
                ((float*)(F.ws + WS_MOD))[(layer * 3 + rho) * 3072 + n0 + n] = s + F.in[I_ADAB][layer * 3072 + n0 + n]; }
            __syncthreads();
        }
    }
    __syncthreads();
}
__device__ __forceinline__ void prep_tr(Frame& F) {
    {   LAS float* scr = (LAS float*)(F.lds + F.wave * 16640);
        const int gw = F.bid * 8 + F.wave, NGW = F.G * 8;
        constexpr int I1 = (1024 / 64) * (8192 / 64), I2 = (2048 / 64) * (1024 / 64);
        for (int it = gw; it < I1 + I2; it += NGW) {
            int rI = it;
            if (rI < I1) { transpose_item(F.in[I_CWIN], 1024, 8192, (bf16*)(F.ws + WS_W1), scr, rI, F.lane, RowW1()); continue; } rI -= I1;
            transpose_item(F.in[I_CWOUT], 2048, 1024, (bf16*)(F.ws + WS_W2), scr, rI, F.lane, RowId());
        }
    }
}
__device__ __forceinline__ void prep_tr_late(Frame& F, int first_bid, int nblocks) {
    LAS float* scr = (LAS float*)(F.lds + F.wave * 16640);
    const int gw = (F.bid - first_bid) * 8 + F.wave, NGW = nblocks * 8;
    constexpr int I3 = (1024 / 64) * (4096 / 64), I4 = (2048 / 64) * (2048 / 64), I5 = (2048 / 64) * (1024 / 64);
    for (int it = gw; it < I3 + I4 + I5; it += NGW) {
        int rI = it;
        if (rI < I3) { transpose_item(F.in[I_SWIN], 1024, 4096, (bf16*)(F.ws + WS_W3), scr, rI, F.lane, RowId()); continue; } rI -= I3;
        if (rI < I4) { transpose_item(F.in[I_WGLU], 2048, 2048, (bf16*)(F.ws + WS_WG), scr, rI, F.lane, RowId()); continue; } rI -= I4;
        transpose_item(F.in[I_SWOUT], 2048, 1024, (bf16*)(F.ws + WS_W5), scr, rI, F.lane, RowId());
    }
}
__device__ __forceinline__ void phase_prep(Frame& F) {
    prep_mod(F);
    { VM_WAIT(); __syncthreads();
      if (F.tid == 0) { int mine = 0; for (int item = F.bid; item < 2 * 96; item += F.G) ++mine;
          if (mine) { __builtin_amdgcn_fence(__ATOMIC_RELEASE, "agent"); asm volatile("s_waitcnt vmcnt(0)" ::: "memory"); (void)xb_add((unsigned*)(F.ws + WS_CTL) + CW_MOD, (unsigned)mine); } } }
    if (F.bid & 1) { prep_tr(F); __syncthreads(); prep_ssm(F); } else { prep_ssm(F); prep_tr(F); }
}
__device__ __forceinline__ void store_row_blk64(char* base, size_t row, int lane, const f32x4 (&v)[4]) {
#pragma unroll
    for (int j = 0; j < 4; ++j) { const int kb = 4 * j + (lane >> 4), col = 4 * (lane & 15);
        u32x2 w; w.x = pk2(v[j][0], v[j][1]); w.y = pk2(v[j][2], v[j][3]);
        *(u32x2*)(base + (size_t)kb * HXPLANE + row * 128 + col * 2) = w; }
}
__device__ __forceinline__ void phase_mod0(Frame& F) {
    { if (F.tid == 0) { unsigned* cnt = (unsigned*)(F.ws + WS_CTL) + CW_MOD; unsigned sp = 0; while (xb_ld(cnt) < 2u * 96u && ++sp < (1u << 22)) __builtin_amdgcn_s_sleep(2);
          __builtin_amdgcn_fence(__ATOMIC_ACQUIRE, "agent"); asm volatile("s_waitcnt vmcnt(0)" ::: "memory"); }
      __syncthreads(); }
    const int gw = F.bid * 8 + F.wave, NGW = F.G * 8; const float* mod = (const float*)(F.ws + WS_MOD);
    for (int row = gw; row < RT; row += NGW) {
        const bool isctx = row >= RL; const int rho = isctx ? 2 : row / SEQ;
        const float* src = isctx ? F.in[I_CTX] + (size_t)(row - RL) * D : F.in[I_X] + (size_t)row * D;
        f32x4 v[4];
#pragma unroll
        for (int j = 0; j < 4; ++j) { const int idx = 256 * j + 4 * F.lane; const f32x4 xv = __builtin_nontemporal_load((const f32x4*)(src + idx));
            const f32x4 sh = *(const f32x4*)(mod + rho * 3072 + idx), sc = *(const f32x4*)(mod + rho * 3072 + 1024 + idx);
            v[j] = xv * (1.0f + sc) + sh; }
        store_row_blk64((char*)F.ws + WS_HX, (size_t)row, F.lane, v);
        if (!isctx) { const int b = row / SEQ, t = row % SEQ; store_row_blk64((char*)F.out, (size_t)b * SEQ + (size_t)(t % GRIDW) * 256 + t / GRIDW, F.lane, v); }
    }
}
__device__ __forceinline__ void ln_row(f32x4 (&v)[4], const float* g, const float* b, int lane) {
    float s = 0.f;
#pragma unroll
    for (int j = 0; j < 4; ++j) s += (v[j][0] + v[j][1]) + (v[j][2] + v[j][3]);
    const float mean = wave_sum(s) * (1.f / D); float s2 = 0.f;
#pragma unroll
    for (int j = 0; j < 4; ++j) { v[j] = v[j] - mean; s2 += (v[j][0] * v[j][0] + v[j][1] * v[j][1]) + (v[j][2] * v[j][2] + v[j][3] * v[j][3]); }
    const float rstd = 1.0f / sqrtf(wave_sum(s2) * (1.f / D) + LN_EPS);
#pragma unroll
    for (int j = 0; j < 4; ++j) { const int idx = 256 * j + 4 * lane; v[j] = v[j] * rstd * *(const f32x4*)(g + idx) + *(const f32x4*)(b + idx); }
}
__device__ __forceinline__ void phase_ln_mod1(Frame& F) {
    const int gw = F.bid * 8 + F.wave, NGW = F.G * 8; const float* mod = (const float*)(F.ws + WS_MOD) + 3 * 3072;
    for (int row = gw; row < RT; row += NGW) {
        const bool isctx = row >= RL; const int rho = isctx ? 2 : row / SEQ;
        float* src = F.out + (size_t)row * D;
        f32x4 v[4];
        if (isctx) { const float* mod0 = (const float*)(F.ws + WS_MOD);
#pragma unroll
            for (int j = 0; j < 4; ++j) { const int idx = 256 * j + 4 * F.lane; f32x4 a = {0.f, 0.f, 0.f, 0.f};
#pragma unroll
                for (int ks = 0; ks < 8; ++ks) a += *(const f32x4*)((const float*)(F.ws + WS_Y1S) + ((size_t)ks * RC + (row - RL)) * D + idx);
                v[j] = DN_ALPHA * *(const f32x4*)(F.in[I_CTX] + (size_t)(row - RL) * D + idx) + *(const f32x4*)(mod0 + 2 * 3072 + 2048 + idx) * a; } }
        else {
#pragma unroll
            for (int j = 0; j < 4; ++j) { const int idx = 256 * j + 4 * F.lane; const u32x2 f = __builtin_nontemporal_load((const u32x2*)((const char*)src + 2048 + idx * 2));
                const f32x4 fv = {bf2f(f.x), bf2f(f.x >> 16), bf2f(f.y), bf2f(f.y >> 16)};
                v[j] = DN_ALPHA * __builtin_nontemporal_load((const f32x4*)(F.in[I_X] + (size_t)row * D + idx)) + fv; } }
        ln_row(v, F.in[I_LNG], F.in[I_LNB], F.lane);
        if (!isctx) {
#pragma unroll
            for (int j = 0; j < 4; ++j) { u32x2 w; w.x = pk2(v[j][0], v[j][1]); w.y = pk2(v[j][2], v[j][3]); __builtin_nontemporal_store(w, (u32x2*)((char*)src + 2048 + (256 * j + 4 * F.lane) * 2)); } }
#pragma unroll
        for (int j = 0; j < 4; ++j) { const int idx = 256 * j + 4 * F.lane;
            const f32x4 sh = *(const f32x4*)(mod + rho * 3072 + idx), sc = *(const f32x4*)(mod + rho * 3072 + 1024 + idx);
            v[j] = v[j] * (1.0f + sc) + sh; }
        store_row_blk64((char*)F.ws + WS_HX, (size_t)row, F.lane, v);
    }
}
__device__ __forceinline__ void phase_ln_out(Frame& F) {
    const int gw = F.bid * 8 + F.wave, NGW = F.G * 8;
    for (int row = gw; row < RL; row += NGW) {
        float* src = F.out + (size_t)row * D;
        f32x4 v[4];
#pragma unroll
        for (int j = 0; j < 4; ++j) { const int idx = 256 * j + 4 * F.lane; const u32x2 f = __builtin_nontemporal_load((const u32x2*)((const char*)F.ws + WS_FO + ((size_t)row * D + idx) * 2));
            const f32x4 fv = {bf2f(f.x), bf2f(f.x >> 16), bf2f(f.y), bf2f(f.y >> 16)};
            const u32x2 xb = __builtin_nontemporal_load((const u32x2*)((const char*)src + 2048 + idx * 2));
            const f32x4 xv = {bf2f(xb.x), bf2f(xb.x >> 16), bf2f(xb.y), bf2f(xb.y >> 16)};
            v[j] = DN_ALPHA * xv + fv; }
        ln_row(v, F.in[I_LNG] + D, F.in[I_LNB] + D, F.lane);
#pragma unroll
        for (int j = 0; j < 4; ++j) __builtin_nontemporal_store(v[j], (f32x4*)(src + 256 * j + 4 * F.lane));
    }
}
__device__ __forceinline__ void cmul_acc(float& hr, float& hi, float ar, float ai, float sr, float si) { const float nr = ar * hr - ai * hi + sr, ni = ar * hi + ai * hr + si; hr = nr; hi = ni; }
__device__ __forceinline__ void scan_pair(Frame& F, const int g, const int b) {
    int n = F.lane; asm volatile("" : "+v"(n));
    const int wq = F.wave & 3, r = F.wave >> 2;
    LAS float* ex = (LAS float*)F.lds;
    const f32x4 za = *(const f32x4*)((const float*)(F.ws + WS_ZA) + ((size_t)(r * NG + g) * 64 + n) * 4);
    const float ar = za[0], ai = za[1], aTr = za[2], aTi = za[3];
    float hr = 0.f, hi = 0.f;
    {   f32x4 bb[8];
        const f32x4* bp = (const f32x4*)((const float*)(F.ws + WS_BBG) + ((size_t)(r * NG + g) * 64 + n) * 32);
#pragma unroll
        for (int i = 0; i < 8; ++i) bb[i] = bp[i];
        const int s_own = 64 * wq + n, t_own = r ? (CTXL - 1 - s_own) : s_own;
        float us[16];
#pragma unroll
        for (int j = 0; j < 16; ++j) us[j] = 0.f;
#pragma unroll
        for (int ks = 0; ks < 4; ++ks) { const f32x4* rp = (const f32x4*)((const float*)(F.ws + WS_UCS) + ((size_t)ks * RC + b * CTXL + t_own) * 2048 + g * 16);
#pragma unroll
            for (int i = 0; i < 4; ++i) { const f32x4 v = rp[i]; us[4 * i] += v[0]; us[4 * i + 1] += v[1]; us[4 * i + 2] += v[2]; us[4 * i + 3] += v[3]; } }
        for (int i = 0; i < 64; ++i) { float sr = 0.f, si = 0.f;
#pragma unroll
            for (int q = 0; q < 8; ++q) { const float ua = __builtin_bit_cast(float, __builtin_amdgcn_readlane(__builtin_bit_cast(int, us[2 * q]), i));
                const float ub = __builtin_bit_cast(float, __builtin_amdgcn_readlane(__builtin_bit_cast(int, us[2 * q + 1]), i));
                sr += bb[q][0] * ua + bb[q][2] * ub; si += bb[q][1] * ua + bb[q][3] * ub; }
            cmul_acc(hr, hi, ar, ai, sr, si); }
    }
    for (int k = wq; k < 3; ++k)
#pragma unroll
        for (int z = 0; z < 64 / TCH; ++z) cmul_acc(hr, hi, aTr, aTi, 0.f, 0.f);
    __syncthreads();
    ex[((r * 4 + wq) * 64 + n) * 2] = hr; ex[((r * 4 + wq) * 64 + n) * 2 + 1] = hi;
    __syncthreads();
    float h0r = 0.f, h0i = 0.f;
#pragma unroll
    for (int k = 0; k < 4; ++k) { h0r += ex[((r * 4 + k) * 64 + n) * 2]; h0i += ex[((r * 4 + k) * 64 + n) * 2 + 1]; }
    constexpr int CPW = NCHB / 4; static_assert(CPW == 128, "scan register blocking");
    const int cb = b * NCHB + (r ? NCHB - CPW * (wq + 1) : CPW * wq);
    const bf16* re_row = (const bf16*)(F.ws + WS_S + (size_t)g * MiB) + (size_t)(r * 128 + n) * NCOL + cb;
    const bf16* im_row = re_row + (size_t)64 * NCOL;
    bf16* Xg = (bf16*)(F.ws + WS_X + (size_t)g * XPLANE) + TP + r * 128 + n;
#define SCAN_LOAD(HALF) do { _Pragma("unroll") for (int k = 0; k < 8; ++k) { const int kk = r ? (15 - 8 * (HALF) - k) : (8 * (HALF) + k); pre[k] = *(const u32x4*)(re_row + 8 * kk); pim[k] = *(const u32x4*)(im_row + 8 * kk); } } while (0)
#define SCAN_RE(i) bf2f(pre[(i) >> 3][((r ? 7 - ((i) & 7) : ((i) & 7)) >> 1)] >> (16 * ((r ? 7 - ((i) & 7) : ((i) & 7)) & 1)))
#define SCAN_IM(i) bf2f(pim[(i) >> 3][((r ? 7 - ((i) & 7) : ((i) & 7)) >> 1)] >> (16 * ((r ? 7 - ((i) & 7) : ((i) & 7)) & 1)))
    u32x4 pre[8], pim[8];
    float er = 0.f, ei = 0.f;
#pragma unroll
    for (int half = 0; half < 2; ++half) { SCAN_LOAD(half);
        if (r == 0) {
#pragma unroll
            for (int i = 0; i < 64; ++i) cmul_acc(er, ei, aTr, aTi, bf2f(pre[i >> 3][(i & 7) >> 1] >> (16 * (i & 1))), bf2f(pim[i >> 3][(i & 7) >> 1] >> (16 * (i & 1))));
        } else {
#pragma unroll
            for (int i = 0; i < 64; ++i) { const int e = 7 - (i & 7); cmul_acc(er, ei, aTr, aTi, bf2f(pre[i >> 3][e >> 1] >> (16 * (e & 1))), bf2f(pim[i >> 3][e >> 1] >> (16 * (e & 1)))); }
        }
        asm volatile("" ::: "memory"); }
    float qr = aTr, qi = aTi;
    for (int k = 1; k < CPW; k <<= 1) { const float nr = qr * qr - qi * qi, ni = 2.f * qr * qi; qr = nr; qi = ni; }
    __syncthreads();
    ex[((r * 4 + wq) * 64 + n) * 2] = er; ex[((r * 4 + wq) * 64 + n) * 2 + 1] = ei;
    __syncthreads();
    hr = h0r; hi = h0i;
    for (int k = 0; k < wq; ++k) cmul_acc(hr, hi, qr, qi, ex[((r * 4 + k) * 64 + n) * 2], ex[((r * 4 + k) * 64 + n) * 2 + 1]);
    LAS bf16* tile = (LAS bf16*)(F.lds + 8192 + F.wave * 1024);
    GAS char* hp = (GAS char*)(F.ws + WS_X + (size_t)g * XPLANE) + ((size_t)(cb + (r ? CPW - 1 - (n >> 4) : (n >> 4))) * XLD + TP + r * 128) * 2 + (n & 15) * 16;
    const long hstep4 = (r ? -4L : 4L) * XLD * 2;
#pragma unroll
    for (int half = 0; half < 2; ++half) { SCAN_LOAD(half);
        if (r == 0) {
#pragma unroll
            for (int i = 0; i < 64; ++i) {
                tile[(i & 3) * 128 + n] = (bf16)f2bf(hr); tile[(i & 3) * 128 + 64 + n] = (bf16)f2bf(hi);
                if ((i & 3) == 3) { const u32x4 w = *(const LAS u32x4*)((const LAS char*)tile + n * 16); *(GAS u32x4*)hp = w; hp += hstep4; asm volatile("" : "+v"(hp)); }
                cmul_acc(hr, hi, aTr, aTi, bf2f(pre[i >> 3][(i & 7) >> 1] >> (16 * (i & 1))), bf2f(pim[i >> 3][(i & 7) >> 1] >> (16 * (i & 1)))); }
        } else {
#pragma unroll
            for (int i = 0; i < 64; ++i) { const int e = 7 - (i & 7);
                tile[(i & 3) * 128 + n] = (bf16)f2bf(hr); tile[(i & 3) * 128 + 64 + n] = (bf16)f2bf(hi);
                if ((i & 3) == 3) { const u32x4 w = *(const LAS u32x4*)((const LAS char*)tile + n * 16); *(GAS u32x4*)hp = w; hp += hstep4; asm volatile("" : "+v"(hp)); }
                cmul_acc(hr, hi, aTr, aTi, bf2f(pre[i >> 3][e >> 1] >> (16 * (e & 1))), bf2f(pim[i >> 3][e >> 1] >> (16 * (e & 1)))); }
        }
        asm volatile("" ::: "memory"); }
#undef SCAN_LOAD
#undef SCAN_RE
#undef SCAN_IM
}

constexpr int N_PHASES = 11;
template <class P> __device__ __forceinline__ void run_gemm(Frame& F, const P& p, int bit) {
    if ((NAIVE_MASK >> bit) & 1) g8::gemm_phase_naive<P>(F.lds, p, F.G, F.bid); else g8::gemm_phase<P>(F.lds, p, F.G, F.bid);
}
__global__ void __launch_bounds__(512, 2) mk_fwd(Args args) {
    extern __shared__ __attribute__((aligned(16))) unsigned char lds_raw[];
    Frame F;
    F.lds = (LAS unsigned char*)lds_raw;
    F.tid = threadIdx.x; F.lane = F.tid & 63; F.wave = __builtin_amdgcn_readfirstlane(F.tid >> 6); F.G = gridDim.x; F.bid = blockIdx.x;
#pragma unroll
    for (int i = 0; i < 23; ++i) F.in[i] = args.in[i];
    F.out = args.out; F.ws = args.ws;
    volatile LAS unsigned* MISC = (volatile LAS unsigned*)(F.lds + MISC_OFF);
    if (F.tid < 32) MISC[F.tid] = 0u;
    __syncthreads();
    XcdBarrier bar; bar.bar = (unsigned*)(F.ws + WS_CTL) + CW_BAR; bar.x = 0; bar.st = nullptr;
    if (MK_N_LAUNCHES == 1) bar = xcd_barrier_post((unsigned*)(F.ws + WS_CTL) + CW_BAR, MISC + 8);
    const int lo = args.ph_lo, hi = args.ph_hi;
#define IN(k) (lo <= (k) && (k) < hi)
#define REP(k) for (int rep_ = 0; rep_ < 1 + ((k) == PROBE_REP_PHASE ? PROBE_REP_N : 0); ++rep_)
#define SEAM(k) do { if (IN(k) && IN((k) + 1)) xcd_barrier(bar); if ((k) + 1 == PROBE_T_LO) pt0 = __builtin_amdgcn_s_memrealtime(); if ((k) == PROBE_T_HI) pt1 = __builtin_amdgcn_s_memrealtime(); } while (0)
    unsigned long long pt0 = (PROBE_T_LO == 0) ? __builtin_amdgcn_s_memrealtime() : 0ull, pt1 = 0ull;
    unsigned char* ws = F.ws; const float* mod = (const float*)(ws + WS_MOD);
    if (IN(0)) REP(0) { phase_prep(F); }
    if (IN(1)) REP(1) { phase_mod0(F); } SEAM(1);
    if (IN(2)) REP(2) { { LAS float* cwl = (LAS float*)(F.lds + CWL_OFF); for (int e = F.tid; e < 3 * 2048; e += 512) cwl[e] = F.in[I_CW][e]; __syncthreads(); } g8::ProbG1 p{(const char*)ws + WS_HX, (const char*)F.out, (const char*)ws + WS_W1, F.in[I_CW], (char*)ws + WS_A2}; run_gemm(F, p, 0);
        { const int nun = (RT / 256) * 32, full = nun / F.G, rem = nun - full * F.G;
          __syncthreads();
          if (rem > 0 && rem < F.G) { if (F.bid >= rem) prep_tr_late(F, rem, F.G - rem); } else prep_tr_late(F, 0, F.G); } } SEAM(2);
    if (IN(3)) REP(3) { g8::ProbG2 p{(const char*)ws + WS_A2, (const char*)ws + WS_W2, mod, (char*)F.out, (float*)(ws + WS_Y1S)}; run_gemm(F, p, 1); } SEAM(3);
    if (IN(4)) REP(4) { phase_ln_mod1(F); } SEAM(4);
    if (IN(5)) REP(5) { g8::ProbG3 p{(const char*)ws + WS_HX, (const char*)ws + WS_W3, (char*)ws + WS_X, (float*)(ws + WS_UCS), (char*)ws + WS_SZ, 0}; run_gemm(F, p, 2); } SEAM(5);
    if (IN(6)) REP(6) {
        for (int pl = F.bid; pl < NG * NBATCH; pl += F.G) { const int wg = g8::xcd_remap(pl, NG * NBATCH), g = wg >> 1, b = wg & 1;
            if (PROBE_SSM_PART == 0) pt0 = __builtin_amdgcn_s_memrealtime();
            { g8::ProbS p{(const char*)ws + WS_X, (const char*)ws + WS_M2, (char*)ws + WS_S, g, b}; if ((NAIVE_MASK >> 3) & 1) g8::gemm_phase_naive(F.lds, p, 1, 0); else g8::gemm_phase(F.lds, p, 1, 0); }
            VM_WAIT(); __syncthreads();
            if (PROBE_SSM_PART == 0) pt1 = __builtin_amdgcn_s_memrealtime(); if (PROBE_SSM_PART == 1) pt0 = __builtin_amdgcn_s_memrealtime();
            scan_pair(F, g, b);
            VM_WAIT(); __syncthreads();
            if (PROBE_SSM_PART == 1) pt1 = __builtin_amdgcn_s_memrealtime(); if (PROBE_SSM_PART == 2) pt0 = __builtin_amdgcn_s_memrealtime();
            if (F.tid == 0) { unsigned* cnt = (unsigned*)(ws + WS_CTL) + CW_PAIR + g; (void)xb_add(cnt, 1u);
                unsigned sp = 0; while (xb_ld(cnt) < 2u && ++sp < (1u << 22)) __builtin_amdgcn_s_sleep(2); }
            __syncthreads();
            { g8::ProbY p{(const char*)ws + WS_X, (const char*)ws + WS_KR, (const char*)ws + WS_M4, (char*)ws + WS_G, g, b}; if ((NAIVE_MASK >> 4) & 1) g8::gemm_phase_naive(F.lds, p, 1, 0); else g8::gemm_phase(F.lds, p, 1, 0); }
            VM_WAIT(); __syncthreads(); if (PROBE_SSM_PART == 2) pt1 = __builtin_amdgcn_s_memrealtime(); } } SEAM(6);
    if (IN(7)) REP(7) { g8::ProbG3 p{(const char*)ws + WS_HX, (const char*)ws + WS_W3, (char*)ws + WS_X, (float*)(ws + WS_UCS), (char*)ws + WS_SZ, 1}; run_gemm(F, p, 5); VM_WAIT(); __syncthreads(); }
    if (IN(8)) REP(8) { g8::ProbG4 p{(const char*)ws + WS_G, (const char*)ws + WS_WG, (const char*)ws + WS_SZ, F.in[I_BGLU], (char*)ws + WS_A4}; run_gemm(F, p, 6); } SEAM(8);
    if (IN(9)) REP(9) { g8::ProbG5 p{(const char*)ws + WS_A4, (const char*)ws + WS_W5, mod, (char*)ws + WS_FO}; run_gemm(F, p, 7); } SEAM(9);
    if (IN(10)) REP(10) { phase_ln_out(F); }
    if (PROBE_T_LO >= 0 || PROBE_SSM_PART >= 0) { if (PROBE_T_HI == 10) { VM_WAIT(); pt1 = __builtin_amdgcn_s_memrealtime(); }
        if (F.bid == 0 && F.tid == 0) { const unsigned long long tgt = __builtin_amdgcn_s_memrealtime() + (unsigned long long)PROBE_T_MULT * (pt1 - pt0);
            while (__builtin_amdgcn_s_memrealtime() < tgt) __builtin_amdgcn_s_sleep(8); } }
#undef IN
#undef SEAM
}

extern "C" void kernel_launch(void* const* d_in, const int* in_sizes, int n_in, void* d_out, int out_size, void* d_ws, size_t ws_size, hipStream_t stream) {
    static int grid = 0;
    if (grid == 0) {
        if (n_in != 23 || in_sizes[0] != RL * D || out_size != RL * D || ws_size < WS_END) { fprintf(stderr, "kernel_launch: unexpected shapes (n_in %d, in0 %d, out %d, ws %zu); nothing launched\n", n_in, n_in > 0 ? in_sizes[0] : -1, out_size, ws_size); grid = -1; return; }
        int dev = 0, cus = 0, per_cu = 0;
        if (hipGetDevice(&dev) != hipSuccess || hipDeviceGetAttribute(&cus, hipDeviceAttributeMultiprocessorCount, dev) != hipSuccess) { grid = -1; return; }
        if (hipFuncSetAttribute((const void*)mk_fwd, hipFuncAttributeMaxDynamicSharedMemorySize, LDS_BYTES) != hipSuccess) { fprintf(stderr, "kernel_launch: hipFuncSetAttribute failed\n"); grid = -1; return; }
        if (hipOccupancyMaxActiveBlocksPerMultiprocessor(&per_cu, (const void*)mk_fwd, 512, LDS_BYTES) != hipSuccess || per_cu < 1) { fprintf(stderr, "kernel_launch: occupancy query says %d\n", per_cu); per_cu = 1; }
        (void)hipGetLastError();
        grid = cus * 1;
        if (per_cu < 1) grid = -1;
    }
    if (grid < 0) return;
    (void)hipMemsetAsync((char*)d_ws + WS_CTL, 0, CTL_ZERO_BYTES, stream);
    Args a{};
    for (int i = 0; i < 23; ++i) a.in[i] = (const float*)d_in[i];
    a.out = (float*)d_out; a.ws = (unsigned char*)d_ws;
    if (MK_N_LAUNCHES == 1) {
        a.ph_lo = 0; a.ph_hi = N_PHASES;
        void* kargs[] = {&a};
        hipError_t e = hipLaunchCooperativeKernel((const void*)mk_fwd, dim3(grid), dim3(512), kargs, LDS_BYTES, stream);
        if (e != hipSuccess) fprintf(stderr, "kernel_launch: cooperative launch failed: %s (grid %d)\n", hipGetErrorString(e), grid);
    } else {
        for (int ph = 0; ph < N_PHASES; ++ph) { a.ph_lo = ph; a.ph_hi = ph + 1; hipLaunchKernelGGL(mk_fwd, dim3(grid), dim3(512), LDS_BYTES, stream, a); }
    }
}
```

```cpp
#include <hip/hip_runtime.h>
#include <cstdio>
#include <cstdint>

#ifndef MK_N_LAUNCHES
#define MK_N_LAUNCHES 1
#endif
#ifndef NAIVE_MASK
#define NAIVE_MASK 0
#endif

#ifndef PROBE_REP_PHASE
#define PROBE_REP_PHASE -1
#define PROBE_REP_N 0
#endif
#ifndef PROBE_PREP_PART
#define PROBE_PREP_PART -1
#endif
#ifndef PROBE_SSM_PART
#define PROBE_SSM_PART -1
#endif
#ifndef PROBE_T_LO
#define PROBE_T_LO -1
#define PROBE_T_HI -1
#define PROBE_T_MULT 4
#endif
#define GAS __attribute__((address_space(1)))
#define LAS __attribute__((address_space(3)))
typedef unsigned short bf16;
typedef short bf16x8 __attribute__((ext_vector_type(8)));
typedef float f32x4 __attribute__((ext_vector_type(4)));
typedef float f32x2 __attribute__((ext_vector_type(2)));
typedef unsigned u32x4 __attribute__((ext_vector_type(4)));
typedef unsigned u32x2 __attribute__((ext_vector_type(2)));

constexpr int D = 1024, NBATCH = 2, SEQ = 16384, CTXL = 256, GRIDW = 64, EW = 2048, NG = 128, NST = 64, PG = 16;
constexpr int RL = NBATCH * SEQ;
constexpr int RC = NBATCH * CTXL;
constexpr int RT = RL + RC;
constexpr int TCH = 32;
constexpr int TP = TCH * PG;
constexpr int XLD = TP + 4 * NST;
constexpr int NCHB = SEQ / TCH;
constexpr int NCOL = NBATCH * NCHB;
constexpr int PSTR = 2 * TCH * PG;
constexpr int KRG = PG * PSTR;
constexpr float LN_EPS = 1e-5f;
constexpr float DN_ALPHA = 1.41421356237f;

constexpr size_t MiB = 1u << 20;
constexpr size_t WS_CTL = 0, CTL_ZERO_BYTES = 128 * 1024;
constexpr size_t WS_MOD = 1 * MiB;
constexpr size_t WS_ZA = 1 * MiB + 256 * 1024;
constexpr size_t WS_BBG = 2 * MiB;
constexpr size_t WS_WG = 6 * MiB, WS_W5 = 14 * MiB, WS_W3 = 18 * MiB;
constexpr size_t WS_KR = 26 * MiB;
constexpr size_t WS_M4 = 34 * MiB;
constexpr size_t WS_HX = 98 * MiB;
constexpr size_t WS_X = 163 * MiB;
constexpr size_t WS_A2 = 163 * MiB;
constexpr size_t WS_SZ = 195 * MiB;
constexpr size_t WS_M2 = 355 * MiB;
constexpr size_t WS_G = 355 * MiB;
constexpr size_t WS_S = 355 * MiB + 256 * 1024;
constexpr size_t WS_UCTX = 483 * MiB;
constexpr size_t WS_W1 = 484 * MiB, WS_W2 = 500 * MiB;
constexpr size_t WS_Y1S = 294 * MiB;
constexpr size_t WS_UCS = 484 * MiB;
constexpr size_t WS_FO = 163 * MiB;
constexpr size_t WS_A4 = 34 * MiB;
constexpr size_t WS_END = 504 * MiB;
constexpr size_t HXPLANE = (size_t)RT * 128;
constexpr size_t A4PLANE = (size_t)RL * 128;
constexpr size_t GPLANE = (size_t)RL * 32;
constexpr size_t XPLANE = (size_t)NCOL * XLD * 2;
static_assert(WS_X + (size_t)NG * XPLANE <= WS_M2 && WS_A2 + 32 * HXPLANE <= WS_M2 && WS_Y1S + 8 * (size_t)RC * D * 4 <= WS_M2, "map");
static_assert(WS_HX + 16 * HXPLANE <= WS_X && 16 * HXPLANE <= (size_t)RL * D * 4, "map");
static_assert(WS_G + (size_t)NG * GPLANE <= WS_UCTX && WS_SZ + (size_t)RL * 2048 * 2 <= WS_X + (size_t)NG * XPLANE && WS_A4 + 32 * A4PLANE <= WS_X, "map");
static_assert(WS_M4 + (size_t)NG * TP * 256 * 2 <= WS_HX && WS_KR + (size_t)NG * KRG * 2 <= WS_M4 && (size_t)256 * TP * 2 == 256 * 1024 && (size_t)NCOL * 256 * 2 == 512 * 1024 && GPLANE == MiB && WS_W2 + 4 * MiB <= WS_END, "map");
constexpr int CW_BAR = 4096, CW_MOD = 8000, CW_PAIR = 8192;

constexpr int RING_BYTES = 131072;
constexpr int XL_OFF = RING_BYTES;
constexpr int XL_BYTES = 2048;
constexpr int CWL_OFF = XL_OFF + XL_BYTES;
constexpr int MISC_OFF = CWL_OFF + 3 * 2048 * 4;
constexpr int LDS_BYTES = MISC_OFF + 128;

#define RLX_AGENT __ATOMIC_RELAXED, __HIP_MEMORY_SCOPE_AGENT
#define LDS_WAIT() asm volatile("s_waitcnt lgkmcnt(0)" ::: "memory")
#define VM_WAIT() asm volatile("s_waitcnt vmcnt(0)" ::: "memory")
__host__ __device__ __forceinline__ unsigned f2bf(float f) { unsigned u = __builtin_bit_cast(unsigned, f); return (u + 0x7fffu + ((u >> 16) & 1u)) >> 16; }
typedef __bf16 bf16x2_t __attribute__((ext_vector_type(2)));
__host__ __device__ __forceinline__ unsigned pk2(float lo, float hi) {
#if defined(__HIP_DEVICE_COMPILE__)
    const f32x2 v = {lo, hi}; return __builtin_bit_cast(unsigned, __builtin_convertvector(v, bf16x2_t));
#else
    return f2bf(lo) | (f2bf(hi) << 16);
#endif
}
__host__ __device__ __forceinline__ float bf2f(unsigned b) { return __builtin_bit_cast(float, (b & 0xffffu) << 16); }
__device__ __forceinline__ float sigmoidf_(float x) { return __builtin_amdgcn_rcpf(1.0f + __expf(-x)); }
__device__ __forceinline__ float siluf_(float x) { return x * sigmoidf_(x); }
__device__ __forceinline__ float gelu_tanh(float x) { return x * sigmoidf_(1.5957691216f * (x + 0.044715f * x * x * x)); }
__device__ __forceinline__ f32x4 rcp_1p_exp2(f32x4 u) { f32x4 e;
#pragma unroll
    for (int i = 0; i < 4; ++i) e[i] = __builtin_amdgcn_exp2f(u[i]);
    e = e + 1.0f;
#pragma unroll
    for (int i = 0; i < 4; ++i) e[i] = __builtin_amdgcn_rcpf(e[i]);
    return e; }
__device__ __forceinline__ f32x4 sigmoid4(f32x4 x) { return rcp_1p_exp2(x * -1.4426950409f); }
__device__ __forceinline__ f32x4 silu4(f32x4 x) { return x * sigmoid4(x); }
__device__ __forceinline__ f32x4 gelu_tanh4(f32x4 x) { return x * rcp_1p_exp2(x * (x * x * (-1.4426950409f * 1.5957691216f * 0.044715f) + (-1.4426950409f * 1.5957691216f))); }
__device__ __forceinline__ f32x4 bf4_lo(u32x2 p) { f32x4 r; r[0] = __builtin_bit_cast(float, p.x << 16); r[1] = __builtin_bit_cast(float, p.x & 0xffff0000u); r[2] = __builtin_bit_cast(float, p.y << 16); r[3] = __builtin_bit_cast(float, p.y & 0xffff0000u); return r; }
__device__ __forceinline__ float wave_sum(float v) {
#pragma unroll
    for (int o = 1; o < 64; o <<= 1) v += __shfl_xor(v, o);
    return v;
}

__device__ __forceinline__ float dpp_from_prev(float carry, float v) { return __builtin_bit_cast(float, __builtin_amdgcn_update_dpp(__builtin_bit_cast(int, carry), __builtin_bit_cast(int, v), 0x111, 0xf, 0xf, false)); }
__device__ __forceinline__ float dpp_from_next(float carry, float v) { return __builtin_bit_cast(float, __builtin_amdgcn_update_dpp(__builtin_bit_cast(int, carry), __builtin_bit_cast(int, v), 0x101, 0xf, 0xf, false)); }
__device__ __forceinline__ float dpp_ror1(float v) { return __builtin_bit_cast(float, __builtin_amdgcn_update_dpp(0, __builtin_bit_cast(int, v), 0x121, 0xf, 0xf, false)); }
__device__ __forceinline__ float dpp_ror15(float v) { return __builtin_bit_cast(float, __builtin_amdgcn_update_dpp(0, __builtin_bit_cast(int, v), 0x12F, 0xf, 0xf, false)); }
#define XB_TMO      128
#define XB_XCNT(j)  (256  + 64 * (j))
#define XB_XSUB(j)  (1280 + 64 * (j))
#define XB_XGEN(j)  (2304 + 64 * (j))
#define XB_TOP      3328
#define XB_TOPGEN   3392
#define XCD_BAR_WORDS 3456
#define XB_SPIN_CAP (1u << 20)
__device__ __forceinline__ unsigned xb_ld(unsigned* p)              { return __hip_atomic_load(p, __ATOMIC_RELAXED, __HIP_MEMORY_SCOPE_AGENT); }
__device__ __forceinline__ unsigned xb_add(unsigned* p, unsigned v) { return __hip_atomic_fetch_add(p, v, __ATOMIC_RELAXED, __HIP_MEMORY_SCOPE_AGENT); }
__device__ __forceinline__ unsigned xb_xcc_id() { return (unsigned)__builtin_amdgcn_s_getreg((3 << 11) | 20) & 0xFu; }
#define XB_SPIN(cond, bar) do { unsigned _sp = 0; while (cond) { __builtin_amdgcn_s_sleep(1); \
    if ((++_sp & 255u) == 0u) { if (xb_ld(&(bar)[XB_TMO])) break; if (_sp > XB_SPIN_CAP) { atomicAdd(&(bar)[XB_TMO], 1u); break; } } } } while (0)
struct XcdBarrier { unsigned* bar; unsigned x; volatile LAS unsigned* st; };
__device__ __forceinline__ XcdBarrier xcd_barrier_post(unsigned* bar, volatile LAS unsigned* st) {
    XcdBarrier b; b.bar = bar; b.x = xb_xcc_id(); b.st = st;
    if (threadIdx.x == 0) (void)xb_add(&bar[XB_XCNT(b.x)], 1u);
    return b;
}
__device__ __forceinline__ void xcd_barrier_complete(unsigned* bar, unsigned x, unsigned& nloc, unsigned& nx) {
    const unsigned G = gridDim.x * gridDim.y * gridDim.z;
    unsigned sum, cnt, mine, sp = 0u;
    for (;;) {
        sum = 0u; cnt = 0u; mine = 0u;
#pragma unroll
        for (unsigned j = 0; j < 16; ++j) { const unsigned c = xb_ld(&bar[XB_XCNT(j)]); sum += c; cnt += (c > 0u) ? 1u : 0u; mine = (j == x) ? c : mine; }
        if (sum == G) break;
        __builtin_amdgcn_s_sleep(1);
        if ((++sp & 255u) == 0u) { if (xb_ld(&bar[XB_TMO])) break; if (sp > XB_SPIN_CAP) { atomicAdd(&bar[XB_TMO], 1u); break; } }
    }
    nloc = mine > 0u ? mine : 1u; nx = cnt > 0u ? cnt : 1u;
}
__device__ __forceinline__ void xcd_barrier(const XcdBarrier& b) {
    asm volatile("s_waitcnt vmcnt(0)" ::: "memory");
    __syncthreads();
    if (threadIdx.x == 0) {
        unsigned* bar = b.bar;
        __builtin_amdgcn_s_waitcnt(0);
        unsigned nloc = b.st[0], nx = b.st[1];
        if (nloc == 0u) { xcd_barrier_complete(bar, b.x, nloc, nx); b.st[0] = nloc; b.st[1] = nx; }
        const unsigned old = xb_add(&bar[XB_XSUB(b.x)], 1u);
        const unsigned gen = old / nloc;
        if (old + 1u == (gen + 1u) * nloc) {
            __builtin_amdgcn_fence(__ATOMIC_RELEASE, "agent");
            asm volatile("s_waitcnt vmcnt(0)" ::: "memory");
            const unsigned og = xb_add(&bar[XB_TOP], 1u);
            const unsigned tg = og / nx;
            if (og + 1u == (tg + 1u) * nx) xb_add(&bar[XB_TOPGEN], 1u);
            else XB_SPIN(xb_ld(&bar[XB_TOPGEN]) == tg, bar);
            __builtin_amdgcn_fence(__ATOMIC_ACQUIRE, "agent");
            xb_add(&bar[XB_XGEN(b.x)], 1u);
            asm volatile("s_waitcnt vmcnt(0)" ::: "memory");
        } else {
            XB_SPIN(xb_ld(&bar[XB_XGEN(b.x)]) == gen, bar);
            __builtin_amdgcn_fence(__ATOMIC_ACQUIRE, "agent");
            asm volatile("s_waitcnt vmcnt(0)" ::: "memory");
        }
    }
    __syncthreads();
}

struct Args {
    const float* in[23];
    float* out; unsigned char* ws;
    int ph_lo, ph_hi;
};
enum { I_X = 0, I_C, I_CTX, I_CCTX, I_ADAW, I_ADAB, I_LNG, I_LNB, I_CWIN, I_CW, I_CWOUT, I_SWIN, I_LRE, I_LIM, I_LSTEP, I_BRE, I_BIM, I_CRE, I_CIM, I_SD, I_WGLU, I_BGLU, I_SWOUT };

namespace g8 {
constexpr int BM = 256, BK = 64, HALF = 128, HTB = HALF * BK * 2, NXCD = 8, WGM = 8;
__host__ __device__ __forceinline__ int lds_byte(int r, int c) { const int st = (r >> 4) * 2 + (c >> 5), rr = r & 15, cc = c & 31, ob = rr * 64 + cc * 2; return st * 1024 + (ob ^ (((ob >> 9) & 1) << 5)); }
__host__ __device__ __forceinline__ void stage_rc(int b, int& R, int& C) { const int st = b / 1024, sb = b % 1024, swz = sb ^ (((sb >> 9) & 1) << 5); R = (st >> 1) * 16 + swz / 64; C = (st & 1) * 32 + (swz % 64) / 2; }
__host__ __device__ __forceinline__ int perm32(int rho) { const int n = rho >> 4, i = rho & 15; return 8 * (i >> 2) + 4 * n + (i & 3); }

struct Unit { int pm, pn, g, ks; };
__host__ __device__ __forceinline__ int xcd_remap(int L, int nwg) { const int q = nwg / NXCD, r = nwg % NXCD, xcd = L % NXCD, off = L / NXCD; return (xcd < r ? xcd * (q + 1) : r * (q + 1) + (xcd - r) * q) + off; }
__host__ __device__ __forceinline__ bool order_mn(int L, int nM, int nN, Unit& u) {
    const int nwg = nM * nN; if (L >= nwg) return false;
    const int wgid = xcd_remap(L, nwg);
    const int nig = WGM * nN, gid = wgid / nig, fm = gid * WGM, gsz = (nM - fm) < WGM ? (nM - fm) : WGM;
    u.pm = fm + ((wgid % nig) % gsz); u.pn = (wgid % nig) / gsz; u.g = 0; u.ks = 0; return true;
}
__host__ __device__ __forceinline__ bool order_g(int L, int ng, int nM, int nN, Unit& u) {
    const int per = nM * nN, nwg = ng * per; if (L >= nwg) return false;
    const int wgid = xcd_remap(L, nwg);
    u.g = wgid / per; const int rem = wgid % per; u.pm = rem / nN; u.pn = rem % nN; u.ks = 0; return true;
}

__device__ __forceinline__ unsigned cvt_pk_bf16(float lo, float hi) { unsigned r; asm volatile("v_cvt_pk_bf16_f32 %0, %1, %2" : "=v"(r) : "v"(lo), "v"(hi)); return r; }

typedef f32x4 Acc[2][2][4][2];

template <class P>
__device__ __forceinline__ void gemm_phase(LAS unsigned char* lds, const P& p, const int G, const int c) {
    int tid = threadIdx.x; asm volatile("" : "+v"(tid));
    const int wid = __builtin_amdgcn_readfirstlane(tid >> 6), lane = tid & 63, wr = wid >> 2, wc = wid & 3, fr = lane & 15, fq = lane >> 4;
    constexpr int NS = P::NSEG; constexpr int S1 = NS - 1;
    const int nt0 = p.nt0();
    unsigned voffA0, voffA1, voffB0, voffB1;
    { int R, C; stage_rc(tid * 16, R, C); const int Rb = P::PERM ? ((R & ~31) + perm32(R & 31)) : R;
      voffA0 = (unsigned)(p.a_off(0, R, C) - p.a_off(0, 0, 0) + p.a_bias(0)); voffB0 = (unsigned)(p.b_off(0, Rb, C) - p.b_off(0, 0, 0) + p.b_bias(0));
      voffA1 = (unsigned)(p.a_off(S1, R, C) - p.a_off(S1, 0, 0) + p.a_bias(S1)); voffB1 = (unsigned)(p.b_off(S1, Rb, C) - p.b_off(S1, 0, 0) + p.b_bias(S1)); }
    const long r64A0 = p.a_off(0, 64, 0) - p.a_off(0, 0, 0), r64A1 = p.a_off(S1, 64, 0) - p.a_off(S1, 0, 0), r64B0 = p.b_off(0, 64, 0) - p.b_off(0, 0, 0), r64B1 = p.b_off(S1, 64, 0) - p.b_off(S1, 0, 0);
    const long hA0 = p.a_off(0, 128, 0) - p.a_off(0, 0, 0), hA1 = p.a_off(S1, 128, 0) - p.a_off(S1, 0, 0), hB0 = p.b_off(0, 128, 0) - p.b_off(0, 0, 0), hB1 = p.b_off(S1, 128, 0) - p.b_off(S1, 0, 0);
    const long ksA0 = p.a_off(0, 0, 64) - p.a_off(0, 0, 0), ksA1 = p.a_off(S1, 0, 64) - p.a_off(S1, 0, 0), ksB0 = p.b_off(0, 0, 64) - p.b_off(0, 0, 0), ksB1 = p.b_off(S1, 0, 64) - p.b_off(S1, 0, 0);
    const unsigned ldsw = (unsigned)wid * 1024u;
    const int aoff = lds_byte(wr * 64 + fr, fq * 8), boff = lds_byte(wc * 32 + fr, fq * 8);
#define G8_SA(b, h) (((b) * 2 + (h)) * HTB)
#define G8_SB(b, h) ((4 + (b) * 2 + (h)) * HTB)
#define G8_STAGE1(bufoff, gptr, voff, r64) do { \
        __builtin_amdgcn_global_load_lds((const unsigned*)((gptr) + (voff)), (LAS unsigned*)(lds + (bufoff) + ldsw), 16, 0, 0); \
        __builtin_amdgcn_global_load_lds((const unsigned*)((gptr) + (r64) + (voff)), (LAS unsigned*)(lds + (bufoff) + ldsw + 8192), 16, 0, 0); } while (0)
#define G8_STA(bufoff, ptr, sg, h) G8_STAGE1(bufoff, (ptr) + (h) * ((sg) ? hA1 : hA0), ((sg) ? voffA1 : voffA0), ((sg) ? r64A1 : r64A0))
#define G8_STB(bufoff, ptr, sg, h) G8_STAGE1(bufoff, (ptr) + (h) * ((sg) ? hB1 : hB0), ((sg) ? voffB1 : voffB0), ((sg) ? r64B1 : r64B0))
#define G8_LDA(dst, b, h) do { _Pragma("unroll") for (int m = 0; m < 4; ++m) _Pragma("unroll") for (int k = 0; k < 2; ++k) dst[m][k] = *(const LAS bf16x8*)(lds + G8_SA(b, h) + aoff + m * 2048 + k * 1024); } while (0)
#define G8_LDB(dst, b, h) do { _Pragma("unroll") for (int n = 0; n < 2; ++n) _Pragma("unroll") for (int k = 0; k < 2; ++k) dst[n][k] = *(const LAS bf16x8*)(lds + G8_SB(b, h) + boff + n * 2048 + k * 1024); } while (0)
#define G8_MMA(ai, bj, At, Bt) do { __builtin_amdgcn_s_setprio(1); _Pragma("unroll") for (int m = 0; m < 4; ++m) _Pragma("unroll") for (int n = 0; n < 2; ++n) _Pragma("unroll") for (int k = 0; k < 2; ++k) \
        acc[ai][bj][m][n] = __builtin_amdgcn_mfma_f32_16x16x32_bf16(Bt[n][k], At[m][k], acc[ai][bj][m][n], 0, 0, 0); __builtin_amdgcn_s_setprio(0); } while (0)
#define G8_WAIT_V(n) asm volatile("s_waitcnt vmcnt(" #n ")" ::: "memory")
#define G8_WAIT_L(n) asm volatile("s_waitcnt lgkmcnt(" #n ")" ::: "memory")
#define G8_BAR __builtin_amdgcn_s_barrier()
#define G8_SCHED __builtin_amdgcn_sched_barrier(0)
    Unit cur, nxt; int ui = 0;
    if (!p.unit(c, cur)) return;
    Acc acc;
#pragma unroll
    for (int a = 0; a < 2; ++a)
#pragma unroll
        for (int b = 0; b < 2; ++b)
#pragma unroll
            for (int m = 0; m < 4; ++m)
#pragma unroll
                for (int n = 0; n < 2; ++n) acc[a][b][m][n] = (f32x4){0.f, 0.f, 0.f, 0.f};
    bf16x8 At[4][2], B0[2][2], B1[2][2];
    const char* cA0 = p.a_base(cur, 0) - p.a_bias(0); const char* cA1 = p.a_base(cur, S1) - p.a_bias(S1);
    const char* cB0 = p.b_base(cur, 0) - p.b_bias(0); const char* cB1 = p.b_base(cur, S1) - p.b_bias(S1);
    G8_STB(G8_SB(0, 0), cB0, false, 0); G8_STB(G8_SB(0, 1), cB0, false, 1); G8_STA(G8_SA(0, 0), cA0, false, 0); G8_STA(G8_SA(0, 1), cA0, false, 1);
    if (wr == 1) G8_BAR;
    G8_WAIT_V(2); G8_BAR;
    G8_STB(G8_SB(1, 0), cB0 + ksB0, false, 0); G8_STA(G8_SA(1, 0), cA0 + ksA0, false, 0); G8_STB(G8_SB(1, 1), cB0 + ksB0, false, 1);
    G8_WAIT_V(6); G8_BAR;
    for (;;) {
        const bool has_next = p.unit((ui + 1) * G + c, nxt);
        const int nt = p.nt(cur);
        const char* nA0 = has_next ? p.a_base(nxt, 0) - p.a_bias(0) : cA0; const char* nA1 = has_next ? p.a_base(nxt, S1) - p.a_bias(S1) : cA1;
        const char* nB0 = has_next ? p.b_base(nxt, 0) - p.b_bias(0) : cB0; const char* nB1 = has_next ? p.b_base(nxt, S1) - p.b_bias(S1) : cB1;
        for (int t = 0; t < nt; t += 2) {
            const bool last = (t == nt - 2);
            const bool sg1 = (NS > 1) && (t + 1 >= nt0);
            const bool sg2 = (NS > 1) && !last && (t + 2 >= nt0);
            const char* a1 = sg1 ? cA1 + (long)(t + 1 - nt0) * ksA1 : cA0 + (long)(t + 1) * ksA0;
            const char* a2 = last ? nA0 : (sg2 ? cA1 + (long)(t + 2 - nt0) * ksA1 : cA0 + (long)(t + 2) * ksA0);
            const char* b2 = last ? nB0 : (sg2 ? cB1 + (long)(t + 2 - nt0) * ksB1 : cB0 + (long)(t + 2) * ksB0);
            const char* a3 = a2 + (sg2 ? ksA1 : ksA0); const char* b3 = b2 + (sg2 ? ksB1 : ksB0);
            G8_LDB(B0, 0, 0); G8_LDB(B1, 0, 1); G8_SCHED; G8_LDA(At, 0, 0); G8_STA(G8_SA(1, 1), a1, sg1, 1);
            G8_WAIT_V(8); G8_WAIT_L(0); G8_BAR; G8_MMA(0, 0, At, B0); G8_MMA(0, 1, At, B1); G8_BAR; G8_SCHED;
            G8_LDA(At, 0, 1); G8_STB(G8_SB(0, 0), b2, sg2, 0); G8_STB(G8_SB(0, 1), b2, sg2, 1); G8_STA(G8_SA(0, 0), a2, sg2, 0);
            G8_WAIT_V(8); G8_WAIT_L(0); G8_BAR; G8_MMA(1, 0, At, B0); G8_MMA(1, 1, At, B1); G8_BAR; G8_SCHED;
            G8_LDB(B0, 1, 0); G8_LDB(B1, 1, 1); G8_SCHED; G8_LDA(At, 1, 0); G8_STA(G8_SA(0, 1), a2, sg2, 1);
            G8_WAIT_V(8); G8_WAIT_L(0); G8_BAR; G8_MMA(0, 0, At, B0); G8_MMA(0, 1, At, B1); G8_BAR; G8_SCHED;
            G8_LDA(At, 1, 1); G8_STB(G8_SB(1, 0), b3, sg2, 0); G8_STB(G8_SB(1, 1), b3, sg2, 1); G8_STA(G8_SA(1, 0), a3, sg2, 0);
            G8_WAIT_V(8); G8_WAIT_L(0); G8_BAR; G8_MMA(1, 0, At, B0); G8_MMA(1, 1, At, B1); G8_BAR; G8_SCHED;
        }
        if (wr == 0) G8_BAR;
        p.epi(acc, cur, wr, wc, fr, fq, lds);
        if (!has_next) break;
#pragma unroll
        for (int a = 0; a < 2; ++a)
#pragma unroll
            for (int b = 0; b < 2; ++b)
#pragma unroll
                for (int m = 0; m < 4; ++m)
#pragma unroll
                    for (int n = 0; n < 2; ++n) acc[a][b][m][n] = (f32x4){0.f, 0.f, 0.f, 0.f};
        cur = nxt; ++ui; cA0 = nA0; cA1 = nA1; cB0 = nB0; cB1 = nB1;
        if (wr == 1) G8_BAR;
    }
    G8_WAIT_V(0);
    G8_BAR;
#undef G8_SA
#undef G8_SB
#undef G8_STAGE1
#undef G8_STA
#undef G8_STB
#undef G8_LDA
#undef G8_LDB
#undef G8_MMA
#undef G8_WAIT_V
#undef G8_WAIT_L
#undef G8_BAR
#undef G8_SCHED
}

template <class P>
__device__ __forceinline__ void gemm_phase_naive(LAS unsigned char* lds, const P& p, const int G, const int c) {
    const int tid = threadIdx.x, wid = tid >> 6, lane = tid & 63, wr = wid >> 2, wc = wid & 3, fr = lane & 15, fq = lane >> 4;
    LAS float* As = (LAS float*)lds;
    LAS float* Bs = As + 16 * 260;
    const int nt0 = p.nt0();
    Unit u;
    for (int ui = 0; p.unit(ui * G + c, u); ++ui) {
        const int nt = p.nt(u);
        Acc acc;
#pragma unroll
        for (int a = 0; a < 2; ++a)
#pragma unroll
            for (int b = 0; b < 2; ++b)
#pragma unroll
                for (int m = 0; m < 4; ++m)
#pragma unroll
                    for (int n = 0; n < 2; ++n) acc[a][b][m][n] = (f32x4){0.f, 0.f, 0.f, 0.f};
        for (int k0 = 0; k0 < nt * 64; k0 += 16) {
            const int seg = (P::NSEG > 1 && k0 >= nt0 * 64) ? 1 : 0, ks = k0 - (seg ? nt0 * 64 : 0);
            { const int row = tid >> 1, h8 = tid & 1;
              const u32x4 va = *(const u32x4*)(p.a_base(u, seg) + p.a_off(seg, row, ks + 8 * h8));
              const u32x4 vb = *(const u32x4*)(p.b_base(u, seg) + p.b_off(seg, row, ks + 8 * h8));
              __syncthreads();
#pragma unroll
              for (int i = 0; i < 4; ++i) { As[(8 * h8 + 2 * i) * 260 + row] = bf2f(va[i]); As[(8 * h8 + 2 * i + 1) * 260 + row] = bf2f(va[i] >> 16);
                                            Bs[(8 * h8 + 2 * i) * 260 + row] = bf2f(vb[i]); Bs[(8 * h8 + 2 * i + 1) * 260 + row] = bf2f(vb[i] >> 16); }
              __syncthreads(); }
            for (int kk = 0; kk < 16; ++kk) {
                float av[2][4], bv[2][2][4];
#pragma unroll
                for (int ai = 0; ai < 2; ++ai)
#pragma unroll
                    for (int m = 0; m < 4; ++m) av[ai][m] = As[kk * 260 + ai * 128 + wr * 64 + m * 16 + fr];
#pragma unroll
                for (int bj = 0; bj < 2; ++bj)
#pragma unroll
                    for (int n = 0; n < 2; ++n)
#pragma unroll
                        for (int j = 0; j < 4; ++j) bv[bj][n][j] = Bs[kk * 260 + bj * 128 + wc * 32 + (P::PERM ? 8 * fq + 4 * n + j : 16 * n + 4 * fq + j)];
#pragma unroll
                for (int ai = 0; ai < 2; ++ai)
#pragma unroll
                    for (int bj = 0; bj < 2; ++bj)
#pragma unroll
                        for (int m = 0; m < 4; ++m)
#pragma unroll
                            for (int n = 0; n < 2; ++n)
#pragma unroll
                                for (int j = 0; j < 4; ++j) acc[ai][bj][m][n][j] += av[ai][m] * bv[bj][n][j];
            }
        }
        __syncthreads();
        p.epi(acc, u, wr, wc, fr, fq, lds);
        __syncthreads();
    }
}


struct ProbG1 {
    static constexpr bool PERM = false; static constexpr int NSEG = 1;
    const char* HX; const char* HXV; const char* W1; const float* convw; char* A2;
    __host__ __device__ int nt0() const { return 16; } __host__ __device__ int nt(const Unit&) const { return 16; }
    __host__ __device__ long a_bias(int) const { return 0; } __host__ __device__ long b_bias(int) const { return 0; }
    __host__ __device__ bool unit(int L, Unit& u) const { return order_mn(L, RT / 256, 32, u); }
    __host__ __device__ const char* a_base(const Unit& u, int) const { return ((u.pn < 16 || u.pm >= 128) ? HX : HXV) + (size_t)u.pm * 256 * 128; }
    __host__ __device__ long a_off(int, int r, int k) const { return (long)r * 128 + (long)(k >> 6) * (long)HXPLANE + (k & 63) * 2; }
    __host__ __device__ const char* b_base(const Unit& u, int) const { return W1 + (size_t)u.pn * 256 * 128; }
    __host__ __device__ long b_off(int, int c, int k) const { return (long)c * 128 + (long)(k >> 6) * (8192L * 128) + (k & 63) * 2; }
    __device__ __forceinline__ void epi(Acc& acc, const Unit& u, int wr, int wc, int fr, int fq, LAS unsigned char* lds) const {
        LAS float* xb = (LAS float*)(lds + XL_OFF); const LAS float* cw = (const LAS float*)(lds + CWL_OFF);
        const bool chain = (u.pn >= 16) || (u.pm >= 128);
        const bool vert = (u.pn >= 16) && (u.pm < 128);
        const int ch0 = wc * 16 + fq * 4, chg = u.pn * 64 + ch0;
        const f32x4 w0 = *(const LAS f32x4*)(cw + chg), w1 = *(const LAS f32x4*)(cw + 2048 + chg), w2 = *(const LAS f32x4*)(cw + 4096 + chg);
        f32x4 uu[2][4];
#pragma unroll
        for (int ai = 0; ai < 2; ++ai)
#pragma unroll
            for (int m = 0; m < 4; ++m) uu[ai][m] = acc[ai][0][m][1] * acc[ai][1][m][0];
        f32x4 bu[2] = {{0.f, 0.f, 0.f, 0.f}, {0.f, 0.f, 0.f, 0.f}}, bd[2] = {{0.f, 0.f, 0.f, 0.f}, {0.f, 0.f, 0.f, 0.f}};
        if (chain) {
            const int sl = ch0;
#pragma unroll
            for (int ai = 0; ai < 2; ++ai) { const int bi = 2 * ai + wr;
                if (fr == 0) *(LAS f32x4*)(xb + (bi * 2 + 0) * 64 + sl) = uu[ai][0];
                if (fr == 15) *(LAS f32x4*)(xb + (bi * 2 + 1) * 64 + sl) = uu[ai][3]; }
            LDS_WAIT(); __builtin_amdgcn_s_barrier();
#pragma unroll
            for (int ai = 0; ai < 2; ++ai) { const int bi = 2 * ai + wr;
                if (bi > 0) bu[ai] = *(const LAS f32x4*)(xb + ((bi - 1) * 2 + 1) * 64 + sl);
                if (bi < 3) bd[ai] = *(const LAS f32x4*)(xb + ((bi + 1) * 2 + 0) * 64 + sl); }
        }
#pragma unroll
        for (int ai = 0; ai < 2; ++ai)
#pragma unroll
            for (int m = 0; m < 4; ++m) {
                const int rt = ai * 128 + wr * 64 + m * 16 + fr;
                f32x4 upv, dnv;
#pragma unroll
                for (int j = 0; j < 4; ++j) {
                    const float cu = (m == 0) ? bu[ai][j] : dpp_ror1(uu[ai][m > 0 ? m - 1 : 0][j]);
                    upv[j] = dpp_from_prev(cu, uu[ai][m][j]);
                    const float cd = (m == 3) ? bd[ai][j] : dpp_ror15(uu[ai][m < 3 ? m + 1 : 3][j]);
                    dnv[j] = dpp_from_next(cd, uu[ai][m][j]); }
                const f32x4 yc = w1 * uu[ai][m] + w0 * upv + w2 * dnv;
                const f32x4 bgv = acc[ai][0][m][0], zv = acc[ai][1][m][1];
                const f32x4 o = bgv * yc * silu4(zv);
                const int tok = vert ? ((u.pm >> 6) * SEQ + rt * GRIDW + (u.pm & 63)) : (u.pm * 256 + rt);
                u32x2 w; w.x = pk2(o[0], o[1]); w.y = pk2(o[2], o[3]);
                *(u32x2*)(A2 + (size_t)u.pn * HXPLANE + (size_t)tok * 128 + ch0 * 2) = w;
            }
    }
};

struct ProbG2 {
    static constexpr bool PERM = true; static constexpr int NSEG = 1;
    const char* A2; const char* W2; const float* mod; char* f1; float* y1s;
    __host__ __device__ int nt0() const { return 32; } __host__ __device__ int nt(const Unit& u) const { return u.pm >= 128 ? 4 : 32; }
    __host__ __device__ long a_bias(int) const { return 0; } __host__ __device__ long b_bias(int) const { return 0; }
    __host__ __device__ bool unit(int L, Unit& u) const {
        if (L < 512) return order_mn(L, RL / 256, 4, u);
        const int idx = L - 512; if (idx >= 64) return false;
        u.ks = idx & 7; const int tile = idx >> 3; u.pm = 128 + (tile >> 2); u.pn = tile & 3; u.g = 0; return true; }
    __host__ __device__ const char* a_base(const Unit& u, int) const { return A2 + (size_t)u.pm * 256 * 128 + (size_t)u.ks * 4 * HXPLANE; }
    __host__ __device__ long a_off(int, int r, int k) const { return (long)r * 128 + (long)(k >> 6) * (long)HXPLANE + (k & 63) * 2; }
    __host__ __device__ const char* b_base(const Unit& u, int) const { return W2 + (size_t)u.pn * 256 * 128 + (size_t)u.ks * 4 * (1024 * 128); }
    __host__ __device__ long b_off(int, int c, int k) const { return (long)c * 128 + (long)(k >> 6) * (1024L * 128) + (k & 63) * 2; }
    __device__ __forceinline__ void epi(Acc& acc, const Unit& u, int wr, int wc, int fr, int fq, LAS unsigned char*) const {
        const int col0 = u.pn * 256 + wc * 32 + 8 * fq;
        if (u.pm >= 128) {
#pragma unroll
            for (int ai = 0; ai < 2; ++ai)
#pragma unroll
                for (int m = 0; m < 4; ++m) { float* rowp = y1s + ((size_t)u.ks * RC + (u.pm - 128) * 256 + ai * 128 + wr * 64 + m * 16 + fr) * D + col0;
#pragma unroll
                    for (int bj = 0; bj < 2; ++bj)
#pragma unroll
                        for (int n = 0; n < 2; ++n) *(f32x4*)(rowp + bj * 128 + n * 4) = acc[ai][bj][m][n]; }
            return; }
        const int rho = u.pm >> 6;
        f32x4 gt[2][2];
#pragma unroll
        for (int bj = 0; bj < 2; ++bj)
#pragma unroll
            for (int n = 0; n < 2; ++n) gt[bj][n] = *(const f32x4*)(mod + rho * 3072 + 2048 + col0 + bj * 128 + n * 4);
#pragma unroll
        for (int ai = 0; ai < 2; ++ai)
#pragma unroll
            for (int m = 0; m < 4; ++m) { char* rowp = f1 + (size_t)(u.pm * 256 + ai * 128 + wr * 64 + m * 16 + fr) * 4096 + 2048 + col0 * 2;
#pragma unroll
                for (int bj = 0; bj < 2; ++bj) { const f32x4 v0 = gt[bj][0] * acc[ai][bj][m][0], v1 = gt[bj][1] * acc[ai][bj][m][1];
                    u32x4 w; w.x = pk2(v0[0], v0[1]); w.y = pk2(v0[2], v0[3]); w.z = pk2(v1[0], v1[1]); w.w = pk2(v1[2], v1[3]);
                    *(u32x4*)(rowp + bj * 256) = w; } }
    }
};

struct ProbG3 {
    static constexpr bool PERM = true; static constexpr int NSEG = 1;
    const char* HX; const char* W3; char* X; float* ucs; char* SZ; int zhalf;
    __host__ __device__ int nt0() const { return 16; } __host__ __device__ int nt(const Unit& u) const { return u.pm >= 128 ? 4 : 16; }
    __host__ __device__ long a_bias(int) const { return 0; } __host__ __device__ long b_bias(int) const { return 0; }
    __host__ __device__ bool unit(int L, Unit& u) const {
        if (L < 1024) return order_mn(L, RL / 256, 8, u);
        const int idx = L - 1024; if (zhalf || idx >= 64) return false;
        u.ks = idx & 3; const int tile = idx >> 2; u.pm = 128 + (tile >> 3); u.pn = tile & 7; u.g = 0; return true; }
    __host__ __device__ const char* a_base(const Unit& u, int) const { return HX + (size_t)u.pm * 256 * 128 + (size_t)u.ks * 4 * HXPLANE; }
    __host__ __device__ long a_off(int, int r, int k) const { return (long)r * 128 + (long)(k >> 6) * (long)HXPLANE + (k & 63) * 2; }
    __host__ __device__ const char* b_base(const Unit& u, int) const { return W3 + (size_t)(zhalf * 2048 + u.pn * 256) * 128 + (size_t)u.ks * 4 * (4096 * 128); }
    __host__ __device__ long b_off(int, int c, int k) const { return (long)c * 128 + (long)(k >> 6) * (4096L * 128) + (k & 63) * 2; }
    __device__ __forceinline__ void epi(Acc& acc, const Unit& u, int wr, int wc, int fr, int fq, LAS unsigned char*) const {
#pragma unroll
        for (int ai = 0; ai < 2; ++ai)
#pragma unroll
            for (int m = 0; m < 4; ++m) { const int tok = u.pm * 256 + ai * 128 + wr * 64 + m * 16 + fr;
#pragma unroll
                for (int bj = 0; bj < 2; ++bj) { const int n0 = u.pn * 256 + bj * 128 + wc * 32 + 8 * fq;
                    f32x4 v0 = acc[ai][bj][m][0], v1 = acc[ai][bj][m][1];
                    if (u.pm >= 128) { float* rp = ucs + ((size_t)u.ks * RC + (tok - RL)) * 2048 + n0; *(f32x4*)rp = v0; *(f32x4*)(rp + 4) = v1; continue; }
                    if (zhalf) { v0 = silu4(v0); v1 = silu4(v1); }
                    u32x4 w; w.x = pk2(v0[0], v0[1]); w.y = pk2(v0[2], v0[3]); w.z = pk2(v1[0], v1[1]); w.w = pk2(v1[2], v1[3]);
                    if (zhalf) *(u32x4*)(SZ + ((size_t)tok * 2048 + n0) * 2) = w;
                    else { const int g = n0 >> 4, p0 = n0 & 15;
                        const int b = tok / SEQ, tt = tok % SEQ, col = b * NCHB + tt / TCH, t = tt % TCH;
                        *(u32x4*)(X + (size_t)g * XPLANE + ((size_t)col * XLD + t * 16 + p0) * 2) = w; } } }
    }
};
__device__ __forceinline__ void reduce_uctx(const float* ucs, char* UCTX, int gtid, int gthreads) {
    for (int idx = gtid; idx < RC * 256; idx += gthreads) { const int row = idx >> 8, n0 = (idx & 255) * 8;
        f32x4 a0 = {0.f, 0.f, 0.f, 0.f}, a1 = a0;
#pragma unroll
        for (int ks = 0; ks < 4; ++ks) { const float* rp = ucs + ((size_t)ks * RC + row) * 2048 + n0; a0 += *(const f32x4*)rp; a1 += *(const f32x4*)(rp + 4); }
        u32x4 w; w.x = pk2(a0[0], a0[1]); w.y = pk2(a0[2], a0[3]); w.z = pk2(a1[0], a1[1]); w.w = pk2(a1[2], a1[3]);
        *(u32x4*)(UCTX + (size_t)(n0 >> 4) * (RC * 32) + (size_t)row * 32 + (n0 & 15) * 2) = w; }
}

struct ProbS {
    static constexpr bool PERM = true; static constexpr int NSEG = 1;
    const char* X; const char* M2; char* S; int g, b;
    __host__ __device__ int nt0() const { return TP / 64; } __host__ __device__ int nt(const Unit&) const { return TP / 64; }
    __host__ __device__ long a_bias(int) const { return 0; } __host__ __device__ long b_bias(int) const { return 0; }
    __host__ __device__ bool unit(int L, Unit& u) const { if (L >= NCHB / 256) return false; u.g = g; u.pm = 0; u.pn = b * (NCHB / 256) + L; u.ks = 0; return true; }
    __host__ __device__ const char* a_base(const Unit& u, int) const { return M2 + (size_t)u.g * MiB; }
    __host__ __device__ long a_off(int, int r, int k) const { return (long)r * TP * 2 + k * 2; }
    __host__ __device__ const char* b_base(const Unit& u, int) const { return X + (size_t)u.g * XPLANE + (size_t)u.pn * 256 * XLD * 2; }
    __host__ __device__ long b_off(int, int c, int k) const { return (long)c * XLD * 2 + k * 2; }
    __device__ __forceinline__ void epi(Acc& acc, const Unit& u, int wr, int wc, int fr, int fq, LAS unsigned char*) const {
#pragma unroll
        for (int ai = 0; ai < 2; ++ai)
#pragma unroll
            for (int m = 0; m < 4; ++m) { const int j = ai * 128 + wr * 64 + m * 16 + fr;
                char* rowp = S + (size_t)u.g * MiB + ((size_t)((u.pn * 256 + wc * 32 + 8 * fq) >> 3) * 256 + j) * 16;
#pragma unroll
                for (int bj = 0; bj < 2; ++bj) { const f32x4 v0 = acc[ai][bj][m][0], v1 = acc[ai][bj][m][1];
                    u32x4 w; w.x = pk2(v0[0], v0[1]); w.y = pk2(v0[2], v0[3]); w.z = pk2(v1[0], v1[1]); w.w = pk2(v1[2], v1[3]);
                    *(u32x4*)(rowp + bj * (16 * 256 * 16)) = w; } }
    }
};

struct ProbY {
    static constexpr bool PERM = true; static constexpr int NSEG = 2;
    const char* X; const char* KR; const char* M4; char* Gout; int g, b;
    __host__ __device__ int nt0() const { return TP / 64; } __host__ __device__ int nt(const Unit&) const { return XLD / 64; }
    __host__ __device__ long a_bias(int) const { return 0; } __host__ __device__ long b_bias(int seg) const { return seg ? 0 : 96; }
    __host__ __device__ bool unit(int L, Unit& u) const { constexpr int nN = TP / 256, nM = NCHB / 256; if (L >= nN * nM) return false; u.g = g; u.pm = b * nM + L / nN; u.pn = L % nN; u.ks = 0; return true; }
    __host__ __device__ const char* a_base(const Unit& u, int seg) const { return X + (size_t)u.g * XPLANE + (size_t)u.pm * 256 * XLD * 2 + (seg ? TP * 2 : 0); }
    __host__ __device__ long a_off(int, int r, int k) const { return (long)r * XLD * 2 + k * 2; }
    __host__ __device__ const char* b_base(const Unit& u, int seg) const {
        return seg ? M4 + (size_t)u.g * TP * 512 + (size_t)u.pn * 256 * 512 : KR + (size_t)u.g * KRG * 2 + (size_t)(TCH - 1 - 16 * u.pn) * 32; }
    __host__ __device__ long b_off(int seg, int c, int k) const { return seg ? (long)c * 512 + k * 2 : ((long)(c & 15) * PSTR - (long)(c >> 4) * 16 + k) * 2; }
    __device__ __forceinline__ void epi(Acc& acc, const Unit& u, int wr, int wc, int fr, int fq, LAS unsigned char*) const {
#pragma unroll
        for (int ai = 0; ai < 2; ++ai)
#pragma unroll
            for (int m = 0; m < 4; ++m) { const int col = u.pm * 256 + ai * 128 + wr * 64 + m * 16 + fr;
#pragma unroll
                for (int bj = 0; bj < 2; ++bj) { const int n0 = u.pn * 256 + bj * 128 + wc * 32 + 8 * fq;
                    const f32x4 v0 = gelu_tanh4(acc[ai][bj][m][0]), v1 = gelu_tanh4(acc[ai][bj][m][1]);
                    u32x4 w; w.x = pk2(v0[0], v0[1]); w.y = pk2(v0[2], v0[3]); w.z = pk2(v1[0], v1[1]); w.w = pk2(v1[2], v1[3]);
                    *(u32x4*)(Gout + (size_t)u.g * GPLANE + ((size_t)col * TP + n0) * 2) = w; } }
    }
};

struct ProbG4 {
    static constexpr bool PERM = true; static constexpr int NSEG = 1;
    const char* Gin; const char* WG; const char* SZ; const float* bglu; char* A4;
    __host__ __device__ int nt0() const { return 32; } __host__ __device__ int nt(const Unit&) const { return 32; }
    __host__ __device__ long a_bias(int) const { return 0; } __host__ __device__ long b_bias(int) const { return 0; }
    __host__ __device__ bool unit(int L, Unit& u) const { return order_mn(L, RL / 256, 8, u); }
    __host__ __device__ const char* a_base(const Unit& u, int) const { return Gin + (size_t)u.pm * 256 * 32; }
    __host__ __device__ long a_off(int, int r, int k) const { return (long)(k >> 4) * (long)GPLANE + (long)r * 32 + (k & 15) * 2; }
    __host__ __device__ const char* b_base(const Unit& u, int) const { return WG + (size_t)u.pn * 256 * 128; }
    __host__ __device__ long b_off(int, int c, int k) const { return (long)c * 128 + (long)(k >> 6) * (2048L * 128) + (k & 63) * 2; }
    __device__ __forceinline__ void epi(Acc& acc, const Unit& u, int wr, int wc, int fr, int fq, LAS unsigned char*) const {
        f32x4 b0[2], b1[2];
#pragma unroll
        for (int bj = 0; bj < 2; ++bj) { const int n0 = u.pn * 256 + bj * 128 + wc * 32 + 8 * fq; b0[bj] = *(const f32x4*)(bglu + n0); b1[bj] = *(const f32x4*)(bglu + n0 + 4); }
#pragma unroll
        for (int ai = 0; ai < 2; ++ai) {
            u32x4 gv[4][2], sv[4][2];
#pragma unroll
            for (int m = 0; m < 4; ++m) { const int tok = u.pm * 256 + ai * 128 + wr * 64 + m * 16 + fr;
#pragma unroll
                for (int bj = 0; bj < 2; ++bj) { const int n0 = u.pn * 256 + bj * 128 + wc * 32 + 8 * fq;
                    gv[m][bj] = __builtin_nontemporal_load((const u32x4*)(Gin + (size_t)(n0 >> 4) * GPLANE + (size_t)tok * 32 + (n0 & 15) * 2));
                    sv[m][bj] = __builtin_nontemporal_load((const u32x4*)(SZ + ((size_t)tok * 2048 + n0) * 2)); } }
#pragma unroll
            for (int m = 0; m < 4; ++m) { const int tok = u.pm * 256 + ai * 128 + wr * 64 + m * 16 + fr;
#pragma unroll
                for (int bj = 0; bj < 2; ++bj) { const int n0 = u.pn * 256 + bj * 128 + wc * 32 + 8 * fq;
                    const f32x4 v0 = acc[ai][bj][m][0] + b0[bj], v1 = acc[ai][bj][m][1] + b1[bj];
                    const u32x4 gq = gv[m][bj], sq = sv[m][bj];
                    const f32x4 o0 = bf4_lo(u32x2{gq.x, gq.y}) * bf4_lo(u32x2{sq.x, sq.y}) * sigmoid4(v0), o1 = bf4_lo(u32x2{gq.z, gq.w}) * bf4_lo(u32x2{sq.z, sq.w}) * sigmoid4(v1);
                    u32x4 w; w.x = pk2(o0[0], o0[1]); w.y = pk2(o0[2], o0[3]); w.z = pk2(o1[0], o1[1]); w.w = pk2(o1[2], o1[3]);
                    *(u32x4*)(A4 + (size_t)(n0 >> 6) * A4PLANE + (size_t)tok * 128 + (n0 & 63) * 2) = w; } } }
    }
};

struct ProbG5 {
    static constexpr bool PERM = true; static constexpr int NSEG = 1;
    const char* A4; const char* W5; const float* mod; char* fo;
    __host__ __device__ int nt0() const { return 32; } __host__ __device__ int nt(const Unit&) const { return 32; }
    __host__ __device__ long a_bias(int) const { return 0; } __host__ __device__ long b_bias(int) const { return 0; }
    __host__ __device__ bool unit(int L, Unit& u) const { return order_mn(L, RL / 256, 4, u); }
    __host__ __device__ const char* a_base(const Unit& u, int) const { return A4 + (size_t)u.pm * 256 * 128; }
    __host__ __device__ long a_off(int, int r, int k) const { return (long)r * 128 + (long)(k >> 6) * (long)A4PLANE + (k & 63) * 2; }
    __host__ __device__ const char* b_base(const Unit& u, int) const { return W5 + (size_t)u.pn * 256 * 128; }
    __host__ __device__ long b_off(int, int c, int k) const { return (long)c * 128 + (long)(k >> 6) * (1024L * 128) + (k & 63) * 2; }
    __device__ __forceinline__ void epi(Acc& acc, const Unit& u, int wr, int wc, int fr, int fq, LAS unsigned char*) const {
        const int rho = u.pm >> 6, col0 = u.pn * 256 + wc * 32 + 8 * fq;
        f32x4 gt[2][2];
#pragma unroll
        for (int bj = 0; bj < 2; ++bj)
#pragma unroll
            for (int n = 0; n < 2; ++n) gt[bj][n] = *(const f32x4*)(mod + (3 + rho) * 3072 + 2048 + col0 + bj * 128 + n * 4);
#pragma unroll
        for (int ai = 0; ai < 2; ++ai)
#pragma unroll
            for (int m = 0; m < 4; ++m) { char* rowp = fo + ((size_t)(u.pm * 256 + ai * 128 + wr * 64 + m * 16 + fr) * D + col0) * 2;
#pragma unroll
                for (int bj = 0; bj < 2; ++bj) { const f32x4 v0 = gt[bj][0] * acc[ai][bj][m][0], v1 = gt[bj][1] * acc[ai][bj][m][1];
                    u32x4 w; w.x = pk2(v0[0], v0[1]); w.y = pk2(v0[2], v0[3]); w.z = pk2(v1[0], v1[1]); w.w = pk2(v1[2], v1[3]);
                    *(u32x4*)(rowp + bj * 256) = w; } }
    }
};
}

struct Frame {
    LAS unsigned char* lds;
    int tid, lane, wave, G, bid;
    const float* in[23]; float* out; unsigned char* ws;
};

template <class RM>
__device__ __forceinline__ void transpose_item(const float* W, int K, int N, bf16* WT, LAS float* scr, int item, int lane, RM rowmap) {
    const int nblk = N / 64, kb = item / nblk, nb = item % nblk, k0 = 64 * kb, n0 = 64 * nb;
    f32x4 v[16];
#pragma unroll
    for (int i = 0; i < 16; ++i) v[i] = __builtin_nontemporal_load((const f32x4*)(W + (size_t)(k0 + 4 * i + (lane >> 4)) * N + n0 + 4 * (lane & 15)));
#pragma unroll
    for (int i = 0; i < 16; ++i) { LAS float* d = scr + (4 * i + (lane >> 4)) * 65 + 4 * (lane & 15); d[0] = v[i][0]; d[1] = v[i][1]; d[2] = v[i][2]; d[3] = v[i][3]; }
    LDS_WAIT(); asm volatile("" ::: "memory");
    const int c = lane & 7;
#pragma unroll
    for (int j = 0; j < 8; ++j) { const int n = (lane >> 3) + 8 * j; const LAS float* sp = scr + (8 * c) * 65 + n;
        u32x4 o; o.x = pk2(sp[0 * 65], sp[1 * 65]); o.y = pk2(sp[2 * 65], sp[3 * 65]); o.z = pk2(sp[4 * 65], sp[5 * 65]); o.w = pk2(sp[6 * 65], sp[7 * 65]);
        *(u32x4*)(WT + (size_t)kb * N * 64 + (size_t)rowmap(n0 + n) * 64 + 8 * c) = o; }
    LDS_WAIT(); asm volatile("" ::: "memory");
}
struct RowId { __device__ int operator()(int n) const { return n; } };
struct RowW1 { __device__ int operator()(int n) const { const int p = n >> 11, chg = n & 2047, nt = chg >> 6, ch = chg & 63; return nt * 256 + 128 * (p >> 1) + 16 * (p & 1) + 32 * (ch >> 4) + (ch & 15); } };

__device__ __forceinline__ void prep_ssm(Frame& F) {
    LAS float* fl = (LAS float*)F.lds;
    const int tid = F.tid;
    for (int prep_ = 0; prep_ < (PROBE_PREP_PART == 0 ? 2 : 1); ++prep_)
    for (int item = F.bid; item < 2 * NG; item += F.G) {
        const int g = item >> 1, r = item & 1;
        LAS float* Av = fl; LAS float* Fv = fl + 256; LAS float* BBs = fl + 512; LAS float* Cs = fl + 4608; LAS float* PW = fl + 8768;
        __syncthreads();
        float pbre[4], pbim[4], pcre[4], pcim[4];
#pragma unroll
        for (int it = 0; it < 4; ++it) { const int e = tid + 512 * it, rr = e >> 10, n = (e >> 4) & 63, q = e & 15, p = (e >> 6) & 15, nn = e & 63;
            pbre[it] = F.in[I_BRE][((size_t)(rr * NG + g) * 64 + n) * 16 + q]; pbim[it] = F.in[I_BIM][((size_t)(rr * NG + g) * 64 + n) * 16 + q];
            pcre[it] = F.in[I_CRE][((size_t)(rr * NG + g) * 16 + p) * 64 + nn]; pcim[it] = F.in[I_CIM][((size_t)(rr * NG + g) * 16 + p) * 64 + nn]; }
        if (tid < 128) { const int rr = tid >> 6, n = tid & 63;
            const float dt = expf(F.in[I_LSTEP][rr * NG + g]);
            const float lre = F.in[I_LRE][(rr * NG + g) * 64 + n], lim = F.in[I_LIM][(rr * NG + g) * 64 + n];
            const float mag = expf(lre * dt); float sn, cs; sincosf(lim * dt, &sn, &cs);
            const float ar = mag * cs, ai = mag * sn, qr = ar - 1.0f, qi = ai, den = lre * lre + lim * lim;
            Av[(rr * 64 + n) * 2] = ar; Av[(rr * 64 + n) * 2 + 1] = ai;
            Fv[(rr * 64 + n) * 2] = (qr * lre + qi * lim) / den; Fv[(rr * 64 + n) * 2 + 1] = (qi * lre - qr * lim) / den;
        }
        __syncthreads();
#pragma unroll
        for (int it = 0; it < 4; ++it) { const int e = tid + 512 * it, rr = e >> 10, n = (e >> 4) & 63, q = e & 15;
            const float bre = pbre[it], bim = pbim[it];
            const float fr_ = Fv[(rr * 64 + n) * 2], fi_ = Fv[(rr * 64 + n) * 2 + 1];
            const float bbr = fr_ * bre - fi_ * bim, bbi = fr_ * bim + fi_ * bre;
            BBs[e * 2] = bbr; BBs[e * 2 + 1] = bbi;
            if (rr == r) { float* bg = (float*)(F.ws + WS_BBG) + (((size_t)(r * NG + g) * 64 + n) * 16 + q) * 2; bg[0] = bbr; bg[1] = bbi; }
            const int p = (e >> 6) & 15, nn = e & 63;
            Cs[((rr * 16 + p) * 65 + nn) * 2] = pcre[it];
            Cs[((rr * 16 + p) * 65 + nn) * 2 + 1] = pcim[it]; }
        __syncthreads();
        if (tid < 64) { const int n = tid; const float ar = Av[(r * 64 + n) * 2], ai = Av[(r * 64 + n) * 2 + 1]; float pr = 1.f, pi = 0.f;
            for (int e = 0; e <= TCH; ++e) { PW[(n * 65 + e) * 2] = pr; PW[(n * 65 + e) * 2 + 1] = pi; const float nr = pr * ar - pi * ai, ni = pr * ai + pi * ar; pr = nr; pi = ni; }
            float* za = (float*)(F.ws + WS_ZA) + ((size_t)(r * NG + g) * 64 + n) * 4; za[0] = ar; za[1] = ai; za[2] = PW[(n * 65 + TCH) * 2]; za[3] = PW[(n * 65 + TCH) * 2 + 1]; }
        __syncthreads();
        { bf16* M2g = (bf16*)(F.ws + WS_M2 + (size_t)g * MiB);
          constexpr int TPR = TP / 8;
          const int k8 = (tid % TPR) * 8, s_ = k8 >> 4, q0 = k8 & 15, e = r ? s_ : (TCH - 1 - s_);
          for (int j = tid / TPR; j < 128; j += 512 / TPR) { const int cc = j >> 6, n = j & 63;
            const float pr = PW[(n * 65 + e) * 2], pi = PW[(n * 65 + e) * 2 + 1];
            float v[8];
#pragma unroll
            for (int i = 0; i < 8; ++i) { const float br_ = BBs[((r * 64 + n) * 16 + q0 + i) * 2], bi_ = BBs[((r * 64 + n) * 16 + q0 + i) * 2 + 1]; v[i] = cc ? (pr * bi_ + pi * br_) : (pr * br_ - pi * bi_); }
            u32x4 w; w.x = pk2(v[0], v[1]); w.y = pk2(v[2], v[3]); w.z = pk2(v[4], v[5]); w.w = pk2(v[6], v[7]);
            *(u32x4*)(M2g + (size_t)(r * 128 + j) * TP + k8) = w; } }
        { bf16* M4g = (bf16*)(F.ws + WS_M4) + (size_t)g * TP * 256;
          const int jj0 = (tid & 15) * 8, cc = jj0 >> 6, n0 = jj0 & 63;
          for (int row = tid >> 4; row < TP; row += 32) { const int t = row >> 4, p = row & 15, e = r ? (TCH - t) : (t + 1);
            float v[8];
#pragma unroll
            for (int i = 0; i < 8; ++i) { const float cr = Cs[((r * 16 + p) * 65 + n0 + i) * 2], ci = Cs[((r * 16 + p) * 65 + n0 + i) * 2 + 1], pr = PW[((n0 + i) * 65 + e) * 2], pi = PW[((n0 + i) * 65 + e) * 2 + 1];
                v[i] = cc ? -(cr * pi + ci * pr) : (cr * pr - ci * pi); }
            u32x4 w; w.x = pk2(v[0], v[1]); w.y = pk2(v[2], v[3]); w.z = pk2(v[4], v[5]); w.w = pk2(v[6], v[7]);
            *(u32x4*)(M4g + (size_t)row * 256 + r * 128 + jj0) = w; } }
        { bf16* KRg = (bf16*)(F.ws + WS_KR) + (size_t)g * KRG;
          const int p = tid & 15, es = tid >> 4;
          for (int jx = es; jx < TCH; jx += 32) {
            int j, e; if (r == 0) { j = jx; e = TCH - 1 - jx; } else { if (jx == 0) continue; j = TCH - 1 + jx; e = jx; }
            float a16[16];
#pragma unroll
            for (int q = 0; q < 16; ++q) a16[q] = 0.f;
#pragma unroll 2
            for (int n = 0; n < 64; ++n) { const float cr = Cs[((r * 16 + p) * 65 + n) * 2], ci = Cs[((r * 16 + p) * 65 + n) * 2 + 1], pr = PW[(n * 65 + e) * 2], pi = PW[(n * 65 + e) * 2 + 1];
                const float wr_ = cr * pr - ci * pi, wi_ = cr * pi + ci * pr;
                const LAS f32x4* bq = (const LAS f32x4*)(BBs + ((r * 64 + n) * 16) * 2);
#pragma unroll
                for (int q2 = 0; q2 < 8; ++q2) { const f32x4 bv = bq[q2]; a16[2 * q2] += wr_ * bv[0] - wi_ * bv[1]; a16[2 * q2 + 1] += wr_ * bv[2] - wi_ * bv[3]; } }
            if (r == 0 && e == 0) {
                for (int n = 0; n < 64; ++n) { const float cr = Cs[((16 + p) * 65 + n) * 2], ci = Cs[((16 + p) * 65 + n) * 2 + 1];
                    const LAS f32x4* bq = (const LAS f32x4*)(BBs + ((64 + n) * 16) * 2);
#pragma unroll
                    for (int q2 = 0; q2 < 8; ++q2) { const f32x4 bv = bq[q2]; a16[2 * q2] += cr * bv[0] - ci * bv[1]; a16[2 * q2 + 1] += cr * bv[2] - ci * bv[3]; } }
                const float dv = F.in[I_SD][g * 16 + p];
#pragma unroll
                for (int q = 0; q < 16; ++q) if (q == p) a16[q] += dv; }
            u32x4 w0, w1; w0.x = pk2(a16[0], a16[1]); w0.y = pk2(a16[2], a16[3]); w0.z = pk2(a16[4], a16[5]); w0.w = pk2(a16[6], a16[7]);
            w1.x = pk2(a16[8], a16[9]); w1.y = pk2(a16[10], a16[11]); w1.z = pk2(a16[12], a16[13]); w1.w = pk2(a16[14], a16[15]);
            *(u32x4*)(KRg + (size_t)p * PSTR + j * 16) = w0; *(u32x4*)(KRg + (size_t)p * PSTR + j * 16 + 8) = w1; } }
    }
    __syncthreads();
}
__device__ __forceinline__ void prep_mod(Frame& F) {
    LAS float* fl = (LAS float*)F.lds;
    const int tid = F.tid;
    for (int prep_ = 0; prep_ < (PROBE_PREP_PART == 1 ? 2 : 1); ++prep_)
    {   LAS float* sc = fl;
        for (int e = tid; e < 3 * D; e += 512) { const int rho = e >> 10, k = e & 1023; const float v = rho < 2 ? F.in[I_C][rho * D + k] : F.in[I_CCTX][k]; sc[e] = siluf_(v); }
        __syncthreads();
        LAS float* red = fl + 3 * D;
        for (int item = F.bid; item < 2 * 96; item += F.G) {
            const int layer = item / 96, n0 = (item % 96) * 32, kk = tid >> 5, nn = tid & 31;
            const float* w = F.in[I_ADAW] + (size_t)layer * D * 3072 + n0 + nn;
            float s0 = 0.f, s1 = 0.f, s2 = 0.f;
            for (int k = kk; k < D; k += 256) { float wv[16];
#pragma unroll
                for (int i = 0; i < 16; ++i) wv[i] = w[(size_t)(k + 16 * i) * 3072];
#pragma unroll
                for (int i = 0; i < 16; ++i) { s0 += sc[k + 16 * i] * wv[i]; s1 += sc[D + k + 16 * i] * wv[i]; s2 += sc[2 * D + k + 16 * i] * wv[i]; } }
            red[(kk * 32 + nn) * 3] = s0; red[(kk * 32 + nn) * 3 + 1] = s1; red[(kk * 32 + nn) * 3 + 2] = s2;
            __syncthreads();
            if (tid < 96) { const int rho = tid >> 5, n = tid & 31; float s = 0.f;
                for (int k2 = 0; k2 < 16; ++k2) s += red[(k2 * 32 + n) * 3 + rho];
                ((float*)(F.ws + WS_MOD))[(layer * 3 + rho) * 3072 + n0 + n] = s + F.in[I_ADAB][layer * 3072 + n0 + n]; }
            __syncthreads();
        }
    }
    __syncthreads();
}
__device__ __forceinline__ void prep_tr(Frame& F) {
    {   LAS float* scr = (LAS float*)(F.lds + F.wave * 16640);
        const int gw = F.bid * 8 + F.wave, NGW = F.G * 8;
        constexpr int I1 = (1024 / 64) * (8192 / 64), I2 = (2048 / 64) * (1024 / 64);
        for (int it = gw; it < I1 + I2; it += NGW) {
            int rI = it;
            if (rI < I1) { transpose_item(F.in[I_CWIN], 1024, 8192, (bf16*)(F.ws + WS_W1), scr, rI, F.lane, RowW1()); continue; } rI -= I1;
            transpose_item(F.in[I_CWOUT], 2048, 1024, (bf16*)(F.ws + WS_W2), scr, rI, F.lane, RowId());
        }
    }
}
__device__ __forceinline__ void prep_tr_late(Frame& F, int first_bid, int nblocks) {
    LAS float* scr = (LAS float*)(F.lds + F.wave * 16640);
    const int gw = (F.bid - first_bid) * 8 + F.wave, NGW = nblocks * 8;
    constexpr int I3 = (1024 / 64) * (4096 / 64), I4 = (2048 / 64) * (2048 / 64), I5 = (2048 / 64) * (1024 / 64);
    for (int it = gw; it < I3 + I4 + I5; it += NGW) {
        int rI = it;
        if (rI < I3) { transpose_item(F.in[I_SWIN], 1024, 4096, (bf16*)(F.ws + WS_W3), scr, rI, F.lane, RowId()); continue; } rI -= I3;
        if (rI < I4) { transpose_item(F.in[I_WGLU], 2048, 2048, (bf16*)(F.ws + WS_WG), scr, rI, F.lane, RowId()); continue; } rI -= I4;
        transpose_item(F.in[I_SWOUT], 2048, 1024, (bf16*)(F.ws + WS_W5), scr, rI, F.lane, RowId());
    }
}
__device__ __forceinline__ void phase_prep(Frame& F) {
    prep_mod(F);
    { VM_WAIT(); __syncthreads();
      if (F.tid == 0) { int mine = 0; for (int item = F.bid; item < 2 * 96; item += F.G) ++mine;
          if (mine) { __builtin_amdgcn_fence(__ATOMIC_RELEASE, "agent"); asm volatile("s_waitcnt vmcnt(0)" ::: "memory"); (void)xb_add((unsigned*)(F.ws + WS_CTL) + CW_MOD, (unsigned)mine); } } }
    if (F.bid & 1) { prep_tr(F); __syncthreads(); prep_ssm(F); } else { prep_ssm(F); prep_tr(F); }
}
__device__ __forceinline__ void store_row_blk64(char* base, size_t row, int lane, const f32x4 (&v)[4]) {
#pragma unroll
    for (int j = 0; j < 4; ++j) { const int kb = 4 * j + (lane >> 4), col = 4 * (lane & 15);
        u32x2 w; w.x = pk2(v[j][0], v[j][1]); w.y = pk2(v[j][2], v[j][3]);
        *(u32x2*)(base + (size_t)kb * HXPLANE + row * 128 + col * 2) = w; }
}
__device__ __forceinline__ void phase_mod0(Frame& F) {
    { if (F.tid == 0) { unsigned* cnt = (unsigned*)(F.ws + WS_CTL) + CW_MOD; unsigned sp = 0; while (xb_ld(cnt) < 2u * 96u && ++sp < (1u << 22)) __builtin_amdgcn_s_sleep(2);
          __builtin_amdgcn_fence(__ATOMIC_ACQUIRE, "agent"); asm volatile("s_waitcnt vmcnt(0)" ::: "memory"); }
      __syncthreads(); }
    const int gw = F.bid * 8 + F.wave, NGW = F.G * 8; const float* mod = (const float*)(F.ws + WS_MOD);
    for (int row = gw; row < RT; row += NGW) {
        const bool isctx = row >= RL; const int rho = isctx ? 2 : row / SEQ;
        const float* src = isctx ? F.in[I_CTX] + (size_t)(row - RL) * D : F.in[I_X] + (size_t)row * D;
        f32x4 v[4];
#pragma unroll
        for (int j = 0; j < 4; ++j) { const int idx = 256 * j + 4 * F.lane; const f32x4 xv = __builtin_nontemporal_load((const f32x4*)(src + idx));
            const f32x4 sh = *(const f32x4*)(mod + rho * 3072 + idx), sc = *(const f32x4*)(mod + rho * 3072 + 1024 + idx);
            v[j] = xv * (1.0f + sc) + sh; }
        store_row_blk64((char*)F.ws + WS_HX, (size_t)row, F.lane, v);
        if (!isctx) { const int b = row / SEQ, t = row % SEQ; store_row_blk64((char*)F.out, (size_t)b * SEQ + (size_t)(t % GRIDW) * 256 + t / GRIDW, F.lane, v); }
    }
}
__device__ __forceinline__ void ln_row(f32x4 (&v)[4], const float* g, const float* b, int lane) {
    float s = 0.f;
#pragma unroll
    for (int j = 0; j < 4; ++j) s += (v[j][0] + v[j][1]) + (v[j][2] + v[j][3]);
    const float mean = wave_sum(s) * (1.f / D); float s2 = 0.f;
#pragma unroll
    for (int j = 0; j < 4; ++j) { v[j] = v[j] - mean; s2 += (v[j][0] * v[j][0] + v[j][1] * v[j][1]) + (v[j][2] * v[j][2] + v[j][3] * v[j][3]); }
    const float rstd = 1.0f / sqrtf(wave_sum(s2) * (1.f / D) + LN_EPS);
#pragma unroll
    for (int j = 0; j < 4; ++j) { const int idx = 256 * j + 4 * lane; v[j] = v[j] * rstd * *(const f32x4*)(g + idx) + *(const f32x4*)(b + idx); }
}
__device__ __forceinline__ void phase_ln_mod1(Frame& F) {
    const int gw = F.bid * 8 + F.wave, NGW = F.G * 8; const float* mod = (const float*)(F.ws + WS_MOD) + 3 * 3072;
    for (int row = gw; row < RT; row += NGW) {
        const bool isctx = row >= RL; const int rho = isctx ? 2 : row / SEQ;
        float* src = F.out + (size_t)row * D;
        f32x4 v[4];
        if (isctx) { const float* mod0 = (const float*)(F.ws + WS_MOD);
#pragma unroll
            for (int j = 0; j < 4; ++j) { const int idx = 256 * j + 4 * F.lane; f32x4 a = {0.f, 0.f, 0.f, 0.f};
#pragma unroll
                for (int ks = 0; ks < 8; ++ks) a += *(const f32x4*)((const float*)(F.ws + WS_Y1S) + ((size_t)ks * RC + (row - RL)) * D + idx);
                v[j] = DN_ALPHA * *(const f32x4*)(F.in[I_CTX] + (size_t)(row - RL) * D + idx) + *(const f32x4*)(mod0 + 2 * 3072 + 2048 + idx) * a; } }
        else {
#pragma unroll
            for (int j = 0; j < 4; ++j) { const int idx = 256 * j + 4 * F.lane; const u32x2 f = __builtin_nontemporal_load((const u32x2*)((const char*)src + 2048 + idx * 2));
                const f32x4 fv = {bf2f(f.x), bf2f(f.x >> 16), bf2f(f.y), bf2f(f.y >> 16)};
                v[j] = DN_ALPHA * __builtin_nontemporal_load((const f32x4*)(F.in[I_X] + (size_t)row * D + idx)) + fv; } }
        ln_row(v, F.in[I_LNG], F.in[I_LNB], F.lane);
        if (!isctx) {
#pragma unroll
            for (int j = 0; j < 4; ++j) { u32x2 w; w.x = pk2(v[j][0], v[j][1]); w.y = pk2(v[j][2], v[j][3]); __builtin_nontemporal_store(w, (u32x2*)((char*)src + 2048 + (256 * j + 4 * F.lane) * 2)); } }
#pragma unroll
        for (int j = 0; j < 4; ++j) { const int idx = 256 * j + 4 * F.lane;
            const f32x4 sh = *(const f32x4*)(mod + rho * 3072 + idx), sc = *(const f32x4*)(mod + rho * 3072 + 1024 + idx);
            v[j] = v[j] * (1.0f + sc) + sh; }
        store_row_blk64((char*)F.ws + WS_HX, (size_t)row, F.lane, v);
    }
}
__device__ __forceinline__ void phase_ln_out(Frame& F) {
    const int gw = F.bid * 8 + F.wave, NGW = F.G * 8;
    for (int row = gw; row < RL; row += NGW) {
        float* src = F.out + (size_t)row * D;
        f32x4 v[4];
#pragma unroll
        for (int j = 0; j < 4; ++j) { const int idx = 256 * j + 4 * F.lane; const u32x2 f = __builtin_nontemporal_load((const u32x2*)((const char*)F.ws + WS_FO + ((size_t)row * D + idx) * 2));
            const f32x4 fv = {bf2f(f.x), bf2f(f.x >> 16), bf2f(f.y), bf2f(f.y >> 16)};
            const u32x2 xb = __builtin_nontemporal_load((const u32x2*)((const char*)src + 2048 + idx * 2));
            const f32x4 xv = {bf2f(xb.x), bf2f(xb.x >> 16), bf2f(xb.y), bf2f(xb.y >> 16)};
            v[j] = DN_ALPHA * xv + fv; }
        ln_row(v, F.in[I_LNG] + D, F.in[I_LNB] + D, F.lane);
#pragma unroll
        for (int j = 0; j < 4; ++j) __builtin_nontemporal_store(v[j], (f32x4*)(src + 256 * j + 4 * F.lane));
    }
}
__device__ __forceinline__ void cmul_acc(float& hr, float& hi, float ar, float ai, float sr, float si) { const float nr = ar * hr - ai * hi + sr, ni = ar * hi + ai * hr + si; hr = nr; hi = ni; }
#define SCAN_STAMP(k) do { if (PROBE_SSM_PART == 3 + (k)) pt0 = __builtin_amdgcn_s_memrealtime(); if (PROBE_SSM_PART == 2 + (k)) pt1 = __builtin_amdgcn_s_memrealtime(); } while (0)
__device__ __forceinline__ void scan_pair(Frame& F, const int g, const int b, unsigned long long& pt0, unsigned long long& pt1) {
    SCAN_STAMP(0);
    int n = F.lane; asm volatile("" : "+v"(n));
    const int wq = F.wave & 3, r = F.wave >> 2;
    LAS float* ex = (LAS float*)F.lds;
    const f32x4 za = *(const f32x4*)((const float*)(F.ws + WS_ZA) + ((size_t)(r * NG + g) * 64 + n) * 4);
    const float aTr = za[2], aTi = za[3];
    float hr, hi;
    LAS unsigned char* uct = F.lds + 16384;
    LAS float* sctx = (LAS float*)(F.lds + 16384 + 8 * 1040);
    {   const int tt = (F.wave * 64 + n) >> 1, hf = n & 1;
        f32x4 a0 = {0.f, 0.f, 0.f, 0.f}, a1 = a0;
#pragma unroll
        for (int ks = 0; ks < 4; ++ks) { const f32x4* rp = (const f32x4*)((const float*)(F.ws + WS_UCS) + ((size_t)ks * RC + b * CTXL + tt) * 2048 + g * 16 + hf * 8); a0 += rp[0]; a1 += rp[1]; }
        u32x4 w; w.x = pk2(a0[0], a0[1]); w.y = pk2(a0[2], a0[3]); w.z = pk2(a1[0], a1[1]); w.w = pk2(a1[2], a1[3]);
        *(LAS u32x4*)(uct + (tt >> 5) * 1040 + ((tt & 31) * 16 + hf * 8) * 2) = w; }
    __syncthreads();
    {   const int kg = n >> 4, cl = n & 15;
        const char* m2 = (const char*)(F.ws + WS_M2 + (size_t)g * MiB);
#pragma unroll
        for (int jb = 0; jb < 2; ++jb) { const int j = (F.wave * 2 + jb) * 16 + cl;
            bf16x8 bm[16];
#pragma unroll
            for (int kt = 0; kt < 16; ++kt) bm[kt] = *(const bf16x8*)(m2 + ((size_t)j * TP + kt * 32 + kg * 8) * 2);
            f32x4 d = {0.f, 0.f, 0.f, 0.f};
#pragma unroll
            for (int kt = 0; kt < 16; ++kt) { const bf16x8 au = *(const LAS bf16x8*)(uct + (cl & 7) * 1040 + (kt * 32 + kg * 8) * 2);
                d = __builtin_amdgcn_mfma_f32_16x16x32_bf16(au, bm[kt], d, 0, 0, 0); }
            if (kg < 2) *(LAS f32x4*)(sctx + j * 8 + 4 * kg) = d; } }
    __syncthreads();
    float h0r = 0.f, h0i = 0.f;
    {   const LAS f32x4* sre = (const LAS f32x4*)(sctx + (r * 128 + n) * 8); const LAS f32x4* sim = (const LAS f32x4*)(sctx + (r * 128 + 64 + n) * 8);
        const f32x4 re0 = sre[0], re1 = sre[1], im0 = sim[0], im1 = sim[1];
        if (r == 0) {
#pragma unroll
            for (int c = 0; c < 8; ++c) cmul_acc(h0r, h0i, aTr, aTi, c < 4 ? re0[c & 3] : re1[c & 3], c < 4 ? im0[c & 3] : im1[c & 3]);
        } else {
#pragma unroll
            for (int c = 7; c >= 0; --c) cmul_acc(h0r, h0i, aTr, aTi, c < 4 ? re0[c & 3] : re1[c & 3], c < 4 ? im0[c & 3] : im1[c & 3]); } }
    SCAN_STAMP(1);
    constexpr int CPW = NCHB / 4; static_assert(CPW == 128, "scan register blocking");
    const int cb = b * NCHB + (r ? NCHB - CPW * (wq + 1) : CPW * wq);
    const bf16* re_row = (const bf16*)(F.ws + WS_S + (size_t)g * MiB) + ((size_t)(cb >> 3) * 256 + r * 128 + n) * 8;
    const bf16* im_row = re_row + 64 * 8;
    bf16* Xg = (bf16*)(F.ws + WS_X + (size_t)g * XPLANE) + TP + r * 128 + n;
#define SCAN_LOAD(HALF) do { _Pragma("unroll") for (int k = 0; k < 8; ++k) { const int kk = r ? (15 - 8 * (HALF) - k) : (8 * (HALF) + k); pre[k] = *(const u32x4*)(re_row + 2048 * kk); pim[k] = *(const u32x4*)(im_row + 2048 * kk); } } while (0)
#define SCAN_RE(i) bf2f(pre[(i) >> 3][((r ? 7 - ((i) & 7) : ((i) & 7)) >> 1)] >> (16 * ((r ? 7 - ((i) & 7) : ((i) & 7)) & 1)))
#define SCAN_IM(i) bf2f(pim[(i) >> 3][((r ? 7 - ((i) & 7) : ((i) & 7)) >> 1)] >> (16 * ((r ? 7 - ((i) & 7) : ((i) & 7)) & 1)))
    u32x4 pre[8], pim[8];
    float er = 0.f, ei = 0.f;
#pragma unroll
    for (int half = 0; half < 2; ++half) { SCAN_LOAD(half);
        if (r == 0) {
#pragma unroll
            for (int i = 0; i < 64; ++i) cmul_acc(er, ei, aTr, aTi, bf2f(pre[i >> 3][(i & 7) >> 1] >> (16 * (i & 1))), bf2f(pim[i >> 3][(i & 7) >> 1] >> (16 * (i & 1))));
        } else {
#pragma unroll
            for (int i = 0; i < 64; ++i) { const int e = 7 - (i & 7); cmul_acc(er, ei, aTr, aTi, bf2f(pre[i >> 3][e >> 1] >> (16 * (e & 1))), bf2f(pim[i >> 3][e >> 1] >> (16 * (e & 1)))); }
        }
        asm volatile("" ::: "memory"); }
    float qr = aTr, qi = aTi;
    for (int k = 1; k < CPW; k <<= 1) { const float nr = qr * qr - qi * qi, ni = 2.f * qr * qi; qr = nr; qi = ni; }
    __syncthreads();
    ex[((r * 4 + wq) * 64 + n) * 2] = er; ex[((r * 4 + wq) * 64 + n) * 2 + 1] = ei;
    __syncthreads();
    SCAN_STAMP(2);
    hr = h0r; hi = h0i;
    for (int k = 0; k < wq; ++k) cmul_acc(hr, hi, qr, qi, ex[((r * 4 + k) * 64 + n) * 2], ex[((r * 4 + k) * 64 + n) * 2 + 1]);
    LAS bf16* tile = (LAS bf16*)(F.lds + 8192 + F.wave * 1024);
    GAS char* hp = (GAS char*)(F.ws + WS_X + (size_t)g * XPLANE) + ((size_t)(cb + (r ? CPW - 1 - (n >> 4) : (n >> 4))) * XLD + TP + r * 128) * 2 + (n & 15) * 16;
    const long hstep4 = (r ? -4L : 4L) * XLD * 2;
#pragma unroll
    for (int half = 0; half < 2; ++half) { SCAN_LOAD(half);
        if (r == 0) {
#pragma unroll
            for (int i = 0; i < 64; ++i) {
                tile[(i & 3) * 128 + n] = (bf16)f2bf(hr); tile[(i & 3) * 128 + 64 + n] = (bf16)f2bf(hi);
                if ((i & 3) == 3) { const u32x4 w = *(const LAS u32x4*)((const LAS char*)tile + n * 16); *(GAS u32x4*)hp = w; hp += hstep4; asm volatile("" : "+v"(hp)); }
                cmul_acc(hr, hi, aTr, aTi, bf2f(pre[i >> 3][(i & 7) >> 1] >> (16 * (i & 1))), bf2f(pim[i >> 3][(i & 7) >> 1] >> (16 * (i & 1)))); }
        } else {
#pragma unroll
            for (int i = 0; i < 64; ++i) { const int e = 7 - (i & 7);
                tile[(i & 3) * 128 + n] = (bf16)f2bf(hr); tile[(i & 3) * 128 + 64 + n] = (bf16)f2bf(hi);
                if ((i & 3) == 3) { const u32x4 w = *(const LAS u32x4*)((const LAS char*)tile + n * 16); *(GAS u32x4*)hp = w; hp += hstep4; asm volatile("" : "+v"(hp)); }
                cmul_acc(hr, hi, aTr, aTi, bf2f(pre[i >> 3][e >> 1] >> (16 * (e & 1))), bf2f(pim[i >> 3][e >> 1] >> (16 * (e & 1)))); }
        }
        asm volatile("" ::: "memory"); }
#undef SCAN_LOAD
#undef SCAN_RE
#undef SCAN_IM
    if (PROBE_SSM_PART == 5) { VM_WAIT(); SCAN_STAMP(3); }
}

constexpr int N_PHASES = 11;
template <class P> __device__ __forceinline__ void run_gemm(Frame& F, const P& p, int bit) {
    if ((NAIVE_MASK >> bit) & 1) g8::gemm_phase_naive<P>(F.lds, p, F.G, F.bid); else g8::gemm_phase<P>(F.lds, p, F.G, F.bid);
}
__global__ void __launch_bounds__(512, 2) mk_fwd(Args args) {
    extern __shared__ __attribute__((aligned(16))) unsigned char lds_raw[];
    Frame F;
    F.lds = (LAS unsigned char*)lds_raw;
    F.tid = threadIdx.x; F.lane = F.tid & 63; F.wave = __builtin_amdgcn_readfirstlane(F.tid >> 6); F.G = gridDim.x; F.bid = blockIdx.x;
#pragma unroll
    for (int i = 0; i < 23; ++i) F.in[i] = args.in[i];
    F.out = args.out; F.ws = args.ws;
    volatile LAS unsigned* MISC = (volatile LAS unsigned*)(F.lds + MISC_OFF);
    if (F.tid < 32) MISC[F.tid] = 0u;
    __syncthreads();
    XcdBarrier bar; bar.bar = (unsigned*)(F.ws + WS_CTL) + CW_BAR; bar.x = 0; bar.st = nullptr;
    if (MK_N_LAUNCHES == 1) bar = xcd_barrier_post((unsigned*)(F.ws + WS_CTL) + CW_BAR, MISC + 8);
    const int lo = args.ph_lo, hi = args.ph_hi;
#define IN(k) (lo <= (k) && (k) < hi)
#define REP(k) for (int rep_ = 0; rep_ < 1 + ((k) == PROBE_REP_PHASE ? PROBE_REP_N : 0); ++rep_)
#define SEAM(k) do { if (IN(k) && IN((k) + 1)) xcd_barrier(bar); if ((k) + 1 == PROBE_T_LO) pt0 = __builtin_amdgcn_s_memrealtime(); if ((k) == PROBE_T_HI) pt1 = __builtin_amdgcn_s_memrealtime(); } while (0)
    unsigned long long pt0 = (PROBE_T_LO == 0) ? __builtin_amdgcn_s_memrealtime() : 0ull, pt1 = 0ull;
    unsigned char* ws = F.ws; const float* mod = (const float*)(ws + WS_MOD);
    if (IN(0)) REP(0) { phase_prep(F); }
    if (IN(1)) REP(1) { phase_mod0(F); } SEAM(1);
    if (IN(2)) REP(2) { { LAS float* cwl = (LAS float*)(F.lds + CWL_OFF); for (int e = F.tid; e < 3 * 2048; e += 512) cwl[e] = F.in[I_CW][e]; __syncthreads(); } g8::ProbG1 p{(const char*)ws + WS_HX, (const char*)F.out, (const char*)ws + WS_W1, F.in[I_CW], (char*)ws + WS_A2}; run_gemm(F, p, 0);
        { const int nun = (RT / 256) * 32, full = nun / F.G, rem = nun - full * F.G;
          __syncthreads();
          if (rem > 0 && rem < F.G) { if (F.bid >= rem) prep_tr_late(F, rem, F.G - rem); } else prep_tr_late(F, 0, F.G); } } SEAM(2);
    if (IN(3)) REP(3) { g8::ProbG2 p{(const char*)ws + WS_A2, (const char*)ws + WS_W2, mod, (char*)F.out, (float*)(ws + WS_Y1S)}; run_gemm(F, p, 1); } SEAM(3);
    if (IN(4)) REP(4) { phase_ln_mod1(F); } SEAM(4);
    if (IN(5)) REP(5) { g8::ProbG3 p{(const char*)ws + WS_HX, (const char*)ws + WS_W3, (char*)ws + WS_X, (float*)(ws + WS_UCS), (char*)ws + WS_SZ, 0}; run_gemm(F, p, 2); } SEAM(5);
    if (IN(6)) REP(6) {
        for (int pl = F.bid; pl < NG * NBATCH; pl += F.G) { const int wg = g8::xcd_remap(pl, NG * NBATCH), g = wg >> 1, b = wg & 1;
            if (PROBE_SSM_PART == 0) pt0 = __builtin_amdgcn_s_memrealtime();
            { g8::ProbS p{(const char*)ws + WS_X, (const char*)ws + WS_M2, (char*)ws + WS_S, g, b}; if ((NAIVE_MASK >> 3) & 1) g8::gemm_phase_naive(F.lds, p, 1, 0); else g8::gemm_phase(F.lds, p, 1, 0); }
            VM_WAIT(); __syncthreads();
            if (PROBE_SSM_PART == 0) pt1 = __builtin_amdgcn_s_memrealtime(); if (PROBE_SSM_PART == 1) pt0 = __builtin_amdgcn_s_memrealtime();
            scan_pair(F, g, b, pt0, pt1);
            VM_WAIT(); __syncthreads();
            if (PROBE_SSM_PART == 1) pt1 = __builtin_amdgcn_s_memrealtime(); if (PROBE_SSM_PART == 2) pt0 = __builtin_amdgcn_s_memrealtime();
            if (F.tid == 0) { unsigned* cnt = (unsigned*)(ws + WS_CTL) + CW_PAIR + g; (void)xb_add(cnt, 1u);
                unsigned sp = 0; while (xb_ld(cnt) < 2u && ++sp < (1u << 22)) __builtin_amdgcn_s_sleep(2); }
            __syncthreads();
            { g8::ProbY p{(const char*)ws + WS_X, (const char*)ws + WS_KR, (const char*)ws + WS_M4, (char*)ws + WS_G, g, b}; if ((NAIVE_MASK >> 4) & 1) g8::gemm_phase_naive(F.lds, p, 1, 0); else g8::gemm_phase(F.lds, p, 1, 0); }
            VM_WAIT(); __syncthreads(); if (PROBE_SSM_PART == 2) pt1 = __builtin_amdgcn_s_memrealtime(); } } SEAM(6);
    if (IN(7)) REP(7) { g8::ProbG3 p{(const char*)ws + WS_HX, (const char*)ws + WS_W3, (char*)ws + WS_X, (float*)(ws + WS_UCS), (char*)ws + WS_SZ, 1}; run_gemm(F, p, 5); VM_WAIT(); __syncthreads(); }
    if (IN(8)) REP(8) { g8::ProbG4 p{(const char*)ws + WS_G, (const char*)ws + WS_WG, (const char*)ws + WS_SZ, F.in[I_BGLU], (char*)ws + WS_A4}; run_gemm(F, p, 6); } SEAM(8);
    if (IN(9)) REP(9) { g8::ProbG5 p{(const char*)ws + WS_A4, (const char*)ws + WS_W5, mod, (char*)ws + WS_FO}; run_gemm(F, p, 7); } SEAM(9);
    if (IN(10)) REP(10) { phase_ln_out(F); }
    if (PROBE_T_LO >= 0 || PROBE_SSM_PART >= 0) { if (PROBE_T_HI == 10) { VM_WAIT(); pt1 = __builtin_amdgcn_s_memrealtime(); }
        if (F.bid == 0 && F.tid == 0) { const unsigned long long tgt = __builtin_amdgcn_s_memrealtime() + (unsigned long long)PROBE_T_MULT * (pt1 - pt0);
            while (__builtin_amdgcn_s_memrealtime() < tgt) __builtin_amdgcn_s_sleep(8); } }
#undef IN
#undef SEAM
}

extern "C" void kernel_launch(void* const* d_in, const int* in_sizes, int n_in, void* d_out, int out_size, void* d_ws, size_t ws_size, hipStream_t stream) {
    static int grid = 0;
    if (grid == 0) {
        if (n_in != 23 || in_sizes[0] != RL * D || out_size != RL * D || ws_size < WS_END) { fprintf(stderr, "kernel_launch: unexpected shapes (n_in %d, in0 %d, out %d, ws %zu); nothing launched\n", n_in, n_in > 0 ? in_sizes[0] : -1, out_size, ws_size); grid = -1; return; }
        int dev = 0, cus = 0, per_cu = 0;
        if (hipGetDevice(&dev) != hipSuccess || hipDeviceGetAttribute(&cus, hipDeviceAttributeMultiprocessorCount, dev) != hipSuccess) { grid = -1; return; }
        if (hipFuncSetAttribute((const void*)mk_fwd, hipFuncAttributeMaxDynamicSharedMemorySize, LDS_BYTES) != hipSuccess) { fprintf(stderr, "kernel_launch: hipFuncSetAttribute failed\n"); grid = -1; return; }
        if (hipOccupancyMaxActiveBlocksPerMultiprocessor(&per_cu, (const void*)mk_fwd, 512, LDS_BYTES) != hipSuccess || per_cu < 1) { fprintf(stderr, "kernel_launch: occupancy query says %d\n", per_cu); per_cu = 1; }
        (void)hipGetLastError();
        grid = cus * 1;
        if (per_cu < 1) grid = -1;
    }
    if (grid < 0) return;
    (void)hipMemsetAsync((char*)d_ws + WS_CTL, 0, CTL_ZERO_BYTES, stream);
    Args a{};
    for (int i = 0; i < 23; ++i) a.in[i] = (const float*)d_in[i];
    a.out = (float*)d_out; a.ws = (unsigned char*)d_ws;
    if (MK_N_LAUNCHES == 1) {
        a.ph_lo = 0; a.ph_hi = N_PHASES;
        void* kargs[] = {&a};
        hipError_t e = hipLaunchCooperativeKernel((const void*)mk_fwd, dim3(grid), dim3(512), kargs, LDS_BYTES, stream);
        if (e != hipSuccess) fprintf(stderr, "kernel_launch: cooperative launch failed: %s (grid %d)\n", hipGetErrorString(e), grid);
    } else {
        for (int ph = 0; ph < N_PHASES; ++ph) { a.ph_lo = ph; a.ph_hi = ph + 1; hipLaunchKernelGGL(mk_fwd, dim3(grid), dim3(512), LDS_BYTES, stream, a); }
    }
}
```

```cpp
#include <hip/hip_runtime.h>
#include <cstdio>
#include <cstdint>

#ifndef MK_N_LAUNCHES
#define MK_N_LAUNCHES 1
#endif
#ifndef NAIVE_MASK
#define NAIVE_MASK 0
#endif

#ifndef PROBE_REP_PHASE
#define PROBE_REP_PHASE -1
#define PROBE_REP_N 0
#endif
#ifndef PROBE_PREP_PART
#define PROBE_PREP_PART -1
#endif
#ifndef PROBE_SSM_PART
#define PROBE_SSM_PART -1
#endif
#ifndef PROBE_T_LO
#define PROBE_T_LO -1
#define PROBE_T_HI -1
#define PROBE_T_MULT 4
#endif
#define GAS __attribute__((address_space(1)))
#define LAS __attribute__((address_space(3)))
typedef unsigned short bf16;
typedef short bf16x8 __attribute__((ext_vector_type(8)));
typedef float f32x4 __attribute__((ext_vector_type(4)));
typedef float f32x2 __attribute__((ext_vector_type(2)));
typedef unsigned u32x4 __attribute__((ext_vector_type(4)));
typedef unsigned u32x2 __attribute__((ext_vector_type(2)));

constexpr int D = 1024, NBATCH = 2, SEQ = 16384, CTXL = 256, GRIDW = 64, EW = 2048, NG = 128, NST = 64, PG = 16;
constexpr int RL = NBATCH * SEQ;
constexpr int RC = NBATCH * CTXL;
constexpr int RT = RL + RC;
constexpr int TCH = 32;
constexpr int TP = TCH * PG;
constexpr int XLD = TP + 4 * NST;
constexpr int NCHB = SEQ / TCH;
constexpr int NCOL = NBATCH * NCHB;
constexpr int PSTR = 2 * TCH * PG;
constexpr int KRG = PG * PSTR;
constexpr float LN_EPS = 1e-5f;
constexpr float DN_ALPHA = 1.41421356237f;

constexpr size_t MiB = 1u << 20;
constexpr size_t WS_CTL = 0, CTL_ZERO_BYTES = 128 * 1024;
constexpr size_t WS_MOD = 1 * MiB;
constexpr size_t WS_ZA = 1 * MiB + 256 * 1024;
constexpr size_t WS_BBG = 2 * MiB;
constexpr size_t WS_WG = 6 * MiB, WS_W5 = 14 * MiB, WS_W3 = 18 * MiB;
constexpr size_t WS_KR = 26 * MiB;
constexpr size_t WS_M4 = 34 * MiB;
constexpr size_t WS_HX = 98 * MiB;
constexpr size_t WS_X = 163 * MiB;
constexpr size_t WS_A2 = 163 * MiB;
constexpr size_t WS_SZ = 195 * MiB;
constexpr size_t WS_M2 = 355 * MiB;
constexpr size_t WS_G = 355 * MiB;
constexpr size_t WS_S = 355 * MiB + 256 * 1024;
constexpr size_t WS_UCTX = 483 * MiB;
constexpr size_t WS_W1 = 484 * MiB, WS_W2 = 500 * MiB;
constexpr size_t WS_Y1S = 294 * MiB;
constexpr size_t WS_UCS = 484 * MiB;
constexpr size_t WS_FO = 163 * MiB;
constexpr size_t WS_A4 = 34 * MiB;
constexpr size_t WS_END = 504 * MiB;
constexpr size_t HXPLANE = (size_t)RT * 128;
constexpr size_t A4PLANE = (size_t)RL * 128;
constexpr size_t GPLANE = (size_t)RL * 32;
constexpr size_t XPLANE = (size_t)NCOL * XLD * 2;
static_assert(WS_X + (size_t)NG * XPLANE <= WS_M2 && WS_A2 + 32 * HXPLANE <= WS_M2 && WS_Y1S + 8 * (size_t)RC * D * 4 <= WS_M2, "map");
static_assert(WS_HX + 16 * HXPLANE <= WS_X && 16 * HXPLANE <= (size_t)RL * D * 4, "map");
static_assert(WS_G + (size_t)NG * GPLANE <= WS_UCTX && WS_SZ + (size_t)RL * 2048 * 2 <= WS_X + (size_t)NG * XPLANE && WS_A4 + 32 * A4PLANE <= WS_X, "map");
static_assert(WS_M4 + (size_t)NG * TP * 256 * 2 <= WS_HX && WS_KR + (size_t)NG * KRG * 2 <= WS_M4 && (size_t)256 * TP * 2 == 256 * 1024 && (size_t)NCOL * 256 * 2 == 512 * 1024 && GPLANE == MiB && WS_W2 + 4 * MiB <= WS_END, "map");
constexpr int CW_BAR = 4096, CW_MOD = 8000, CW_PAIR = 8192;

constexpr int RING_BYTES = 131072;
constexpr int XL_OFF = RING_BYTES;
constexpr int XL_BYTES = 2048;
constexpr int CWL_OFF = XL_OFF + XL_BYTES;
constexpr int MISC_OFF = CWL_OFF + 3 * 2048 * 4;
constexpr int LDS_BYTES = MISC_OFF + 128;

#define RLX_AGENT __ATOMIC_RELAXED, __HIP_MEMORY_SCOPE_AGENT
#define LDS_WAIT() asm volatile("s_waitcnt lgkmcnt(0)" ::: "memory")
#define VM_WAIT() asm volatile("s_waitcnt vmcnt(0)" ::: "memory")
__host__ __device__ __forceinline__ unsigned f2bf(float f) { unsigned u = __builtin_bit_cast(unsigned, f); return (u + 0x7fffu + ((u >> 16) & 1u)) >> 16; }
typedef __bf16 bf16x2_t __attribute__((ext_vector_type(2)));
__host__ __device__ __forceinline__ unsigned pk2(float lo, float hi) {
#if defined(__HIP_DEVICE_COMPILE__)
    const f32x2 v = {lo, hi}; return __builtin_bit_cast(unsigned, __builtin_convertvector(v, bf16x2_t));
#else
    return f2bf(lo) | (f2bf(hi) << 16);
#endif
}
__host__ __device__ __forceinline__ float bf2f(unsigned b) { return __builtin_bit_cast(float, (b & 0xffffu) << 16); }
__device__ __forceinline__ float sigmoidf_(float x) { return __builtin_amdgcn_rcpf(1.0f + __expf(-x)); }
__device__ __forceinline__ float siluf_(float x) { return x * sigmoidf_(x); }
__device__ __forceinline__ float gelu_tanh(float x) { return x * sigmoidf_(1.5957691216f * (x + 0.044715f * x * x * x)); }
__device__ __forceinline__ f32x4 rcp_1p_exp2(f32x4 u) { f32x4 e;
#pragma unroll
    for (int i = 0; i < 4; ++i) e[i] = __builtin_amdgcn_exp2f(u[i]);
    e = e + 1.0f;
#pragma unroll
    for (int i = 0; i < 4; ++i) e[i] = __builtin_amdgcn_rcpf(e[i]);
    return e; }
__device__ __forceinline__ f32x4 sigmoid4(f32x4 x) { return rcp_1p_exp2(x * -1.4426950409f); }
__device__ __forceinline__ f32x4 silu4(f32x4 x) { return x * sigmoid4(x); }
__device__ __forceinline__ f32x4 gelu_tanh4(f32x4 x) { return x * rcp_1p_exp2(x * (x * x * (-1.4426950409f * 1.5957691216f * 0.044715f) + (-1.4426950409f * 1.5957691216f))); }
__device__ __forceinline__ f32x4 bf4_lo(u32x2 p) { f32x4 r; r[0] = __builtin_bit_cast(float, p.x << 16); r[1] = __builtin_bit_cast(float, p.x & 0xffff0000u); r[2] = __builtin_bit_cast(float, p.y << 16); r[3] = __builtin_bit_cast(float, p.y & 0xffff0000u); return r; }
__device__ __forceinline__ float wave_sum(float v) {
#pragma unroll
    for (int o = 1; o < 64; o <<= 1) v += __shfl_xor(v, o);
    return v;
}

__device__ __forceinline__ float dpp_from_prev(float carry, float v) { return __builtin_bit_cast(float, __builtin_amdgcn_update_dpp(__builtin_bit_cast(int, carry), __builtin_bit_cast(int, v), 0x111, 0xf, 0xf, false)); }
__device__ __forceinline__ float dpp_from_next(float carry, float v) { return __builtin_bit_cast(float, __builtin_amdgcn_update_dpp(__builtin_bit_cast(int, carry), __builtin_bit_cast(int, v), 0x101, 0xf, 0xf, false)); }
__device__ __forceinline__ float dpp_ror1(float v) { return __builtin_bit_cast(float, __builtin_amdgcn_update_dpp(0, __builtin_bit_cast(int, v), 0x121, 0xf, 0xf, false)); }
__device__ __forceinline__ float dpp_ror15(float v) { return __builtin_bit_cast(float, __builtin_amdgcn_update_dpp(0, __builtin_bit_cast(int, v), 0x12F, 0xf, 0xf, false)); }
#define XB_TMO      128
#define XB_XCNT(j)  (256  + 64 * (j))
#define XB_XSUB(j)  (1280 + 64 * (j))
#define XB_XGEN(j)  (2304 + 64 * (j))
#define XB_TOP      3328
#define XB_TOPGEN   3392
#define XCD_BAR_WORDS 3456
#define XB_SPIN_CAP (1u << 20)
__device__ __forceinline__ unsigned xb_ld(unsigned* p)              { return __hip_atomic_load(p, __ATOMIC_RELAXED, __HIP_MEMORY_SCOPE_AGENT); }
__device__ __forceinline__ unsigned xb_add(unsigned* p, unsigned v) { return __hip_atomic_fetch_add(p, v, __ATOMIC_RELAXED, __HIP_MEMORY_SCOPE_AGENT); }
__device__ __forceinline__ unsigned xb_xcc_id() { return (unsigned)__builtin_amdgcn_s_getreg((3 << 11) | 20) & 0xFu; }
#define XB_SPIN(cond, bar) do { unsigned _sp = 0; while (cond) { __builtin_amdgcn_s_sleep(1); \
    if ((++_sp & 255u) == 0u) { if (xb_ld(&(bar)[XB_TMO])) break; if (_sp > XB_SPIN_CAP) { atomicAdd(&(bar)[XB_TMO], 1u); break; } } } } while (0)
struct XcdBarrier { unsigned* bar; unsigned x; volatile LAS unsigned* st; };
__device__ __forceinline__ XcdBarrier xcd_barrier_post(unsigned* bar, volatile LAS unsigned* st) {
    XcdBarrier b; b.bar = bar; b.x = xb_xcc_id(); b.st = st;
    if (threadIdx.x == 0) (void)xb_add(&bar[XB_XCNT(b.x)], 1u);
    return b;
}
__device__ __forceinline__ void xcd_barrier_complete(unsigned* bar, unsigned x, unsigned& nloc, unsigned& nx) {
    const unsigned G = gridDim.x * gridDim.y * gridDim.z;
    unsigned sum, cnt, mine, sp = 0u;
    for (;;) {
        sum = 0u; cnt = 0u; mine = 0u;
#pragma unroll
        for (unsigned j = 0; j < 16; ++j) { const unsigned c = xb_ld(&bar[XB_XCNT(j)]); sum += c; cnt += (c > 0u) ? 1u : 0u; mine = (j == x) ? c : mine; }
        if (sum == G) break;
        __builtin_amdgcn_s_sleep(1);
        if ((++sp & 255u) == 0u) { if (xb_ld(&bar[XB_TMO])) break; if (sp > XB_SPIN_CAP) { atomicAdd(&bar[XB_TMO], 1u); break; } }
    }
    nloc = mine > 0u ? mine : 1u; nx = cnt > 0u ? cnt : 1u;
}
__device__ __forceinline__ void xcd_barrier(const XcdBarrier& b) {
    asm volatile("s_waitcnt vmcnt(0)" ::: "memory");
    __syncthreads();
    if (threadIdx.x == 0) {
        unsigned* bar = b.bar;
        __builtin_amdgcn_s_waitcnt(0);
        unsigned nloc = b.st[0], nx = b.st[1];
        if (nloc == 0u) { xcd_barrier_complete(bar, b.x, nloc, nx); b.st[0] = nloc; b.st[1] = nx; }
        const unsigned old = xb_add(&bar[XB_XSUB(b.x)], 1u);
        const unsigned gen = old / nloc;
        if (old + 1u == (gen + 1u) * nloc) {
            __builtin_amdgcn_fence(__ATOMIC_RELEASE, "agent");
            asm volatile("s_waitcnt vmcnt(0)" ::: "memory");
            __builtin_amdgcn_fence(__ATOMIC_ACQUIRE, "agent");
            asm volatile("s_waitcnt vmcnt(0)" ::: "memory");
            (void)xb_add(&bar[XB_TOP], 1u);
        } else {
            asm volatile("buffer_inv sc0\n s_waitcnt vmcnt(0)" ::: "memory");
        }
        XB_SPIN(xb_ld(&bar[XB_TOP]) < (gen + 1u) * nx, bar);
    }
    __syncthreads();
}

struct Args {
    const float* in[23];
    float* out; unsigned char* ws;
    int ph_lo, ph_hi;
};
enum { I_X = 0, I_C, I_CTX, I_CCTX, I_ADAW, I_ADAB, I_LNG, I_LNB, I_CWIN, I_CW, I_CWOUT, I_SWIN, I_LRE, I_LIM, I_LSTEP, I_BRE, I_BIM, I_CRE, I_CIM, I_SD, I_WGLU, I_BGLU, I_SWOUT };

namespace g8 {
constexpr int BM = 256, BK = 64, HALF = 128, HTB = HALF * BK * 2, NXCD = 8, WGM = 8;
__host__ __device__ __forceinline__ int lds_byte(int r, int c) { const int st = (r >> 4) * 2 + (c >> 5), rr = r & 15, cc = c & 31, ob = rr * 64 + cc * 2; return st * 1024 + (ob ^ (((ob >> 9) & 1) << 5)); }
__host__ __device__ __forceinline__ void stage_rc(int b, int& R, int& C) { const int st = b / 1024, sb = b % 1024, swz = sb ^ (((sb >> 9) & 1) << 5); R = (st >> 1) * 16 + swz / 64; C = (st & 1) * 32 + (swz % 64) / 2; }
__host__ __device__ __forceinline__ int perm32(int rho) { const int n = rho >> 4, i = rho & 15; return 8 * (i >> 2) + 4 * n + (i & 3); }

struct Unit { int pm, pn, g, ks; };
__host__ __device__ __forceinline__ int xcd_remap(int L, int nwg) { const int q = nwg / NXCD, r = nwg % NXCD, xcd = L % NXCD, off = L / NXCD; return (xcd < r ? xcd * (q + 1) : r * (q + 1) + (xcd - r) * q) + off; }
__host__ __device__ __forceinline__ bool order_mn(int L, int nM, int nN, Unit& u) {
    const int nwg = nM * nN; if (L >= nwg) return false;
    const int wgid = xcd_remap(L, nwg);
    const int nig = WGM * nN, gid = wgid / nig, fm = gid * WGM, gsz = (nM - fm) < WGM ? (nM - fm) : WGM;
    u.pm = fm + ((wgid % nig) % gsz); u.pn = (wgid % nig) / gsz; u.g = 0; u.ks = 0; return true;
}
__host__ __device__ __forceinline__ bool order_g(int L, int ng, int nM, int nN, Unit& u) {
    const int per = nM * nN, nwg = ng * per; if (L >= nwg) return false;
    const int wgid = xcd_remap(L, nwg);
    u.g = wgid / per; const int rem = wgid % per; u.pm = rem / nN; u.pn = rem % nN; u.ks = 0; return true;
}

__device__ __forceinline__ unsigned cvt_pk_bf16(float lo, float hi) { unsigned r; asm volatile("v_cvt_pk_bf16_f32 %0, %1, %2" : "=v"(r) : "v"(lo), "v"(hi)); return r; }

typedef f32x4 Acc[2][2][4][2];

template <class P>
__device__ __forceinline__ void gemm_phase(LAS unsigned char* lds, const P& p, const int G, const int c) {
    int tid = threadIdx.x; asm volatile("" : "+v"(tid));
    const int wid = __builtin_amdgcn_readfirstlane(tid >> 6), lane = tid & 63, wr = wid >> 2, wc = wid & 3, fr = lane & 15, fq = lane >> 4;
    constexpr int NS = P::NSEG; constexpr int S1 = NS - 1;
    const int nt0 = p.nt0();
    unsigned voffA0, voffA1, voffB0, voffB1;
    { int R, C; stage_rc(tid * 16, R, C); const int Rb = P::PERM ? ((R & ~31) + perm32(R & 31)) : R;
      voffA0 = (unsigned)(p.a_off(0, R, C) - p.a_off(0, 0, 0) + p.a_bias(0)); voffB0 = (unsigned)(p.b_off(0, Rb, C) - p.b_off(0, 0, 0) + p.b_bias(0));
      voffA1 = (unsigned)(p.a_off(S1, R, C) - p.a_off(S1, 0, 0) + p.a_bias(S1)); voffB1 = (unsigned)(p.b_off(S1, Rb, C) - p.b_off(S1, 0, 0) + p.b_bias(S1)); }
    const long r64A0 = p.a_off(0, 64, 0) - p.a_off(0, 0, 0), r64A1 = p.a_off(S1, 64, 0) - p.a_off(S1, 0, 0), r64B0 = p.b_off(0, 64, 0) - p.b_off(0, 0, 0), r64B1 = p.b_off(S1, 64, 0) - p.b_off(S1, 0, 0);
    const long hA0 = p.a_off(0, 128, 0) - p.a_off(0, 0, 0), hA1 = p.a_off(S1, 128, 0) - p.a_off(S1, 0, 0), hB0 = p.b_off(0, 128, 0) - p.b_off(0, 0, 0), hB1 = p.b_off(S1, 128, 0) - p.b_off(S1, 0, 0);
    const long ksA0 = p.a_off(0, 0, 64) - p.a_off(0, 0, 0), ksA1 = p.a_off(S1, 0, 64) - p.a_off(S1, 0, 0), ksB0 = p.b_off(0, 0, 64) - p.b_off(0, 0, 0), ksB1 = p.b_off(S1, 0, 64) - p.b_off(S1, 0, 0);
    const unsigned ldsw = (unsigned)wid * 1024u;
    const int aoff = lds_byte(wr * 64 + fr, fq * 8), boff = lds_byte(wc * 32 + fr, fq * 8);
#define G8_SA(b, h) (((b) * 2 + (h)) * HTB)
#define G8_SB(b, h) ((4 + (b) * 2 + (h)) * HTB)
#define G8_STAGE1(bufoff, gptr, voff, r64) do { \
        __builtin_amdgcn_global_load_lds((const unsigned*)((gptr) + (voff)), (LAS unsigned*)(lds + (bufoff) + ldsw), 16, 0, 0); \
        __builtin_amdgcn_global_load_lds((const unsigned*)((gptr) + (r64) + (voff)), (LAS unsigned*)(lds + (bufoff) + ldsw + 8192), 16, 0, 0); } while (0)
#define G8_STA(bufoff, ptr, sg, h) G8_STAGE1(bufoff, (ptr) + (h) * ((sg) ? hA1 : hA0), ((sg) ? voffA1 : voffA0), ((sg) ? r64A1 : r64A0))
#define G8_STB(bufoff, ptr, sg, h) G8_STAGE1(bufoff, (ptr) + (h) * ((sg) ? hB1 : hB0), ((sg) ? voffB1 : voffB0), ((sg) ? r64B1 : r64B0))
#define G8_LDA(dst, b, h) do { _Pragma("unroll") for (int m = 0; m < 4; ++m) _Pragma("unroll") for (int k = 0; k < 2; ++k) dst[m][k] = *(const LAS bf16x8*)(lds + G8_SA(b, h) + aoff + m * 2048 + k * 1024); } while (0)
#define G8_LDB(dst, b, h) do { _Pragma("unroll") for (int n = 0; n < 2; ++n) _Pragma("unroll") for (int k = 0; k < 2; ++k) dst[n][k] = *(const LAS bf16x8*)(lds + G8_SB(b, h) + boff + n * 2048 + k * 1024); } while (0)
#define G8_MMA(ai, bj, At, Bt) do { __builtin_amdgcn_s_setprio(1); _Pragma("unroll") for (int m = 0; m < 4; ++m) _Pragma("unroll") for (int n = 0; n < 2; ++n) _Pragma("unroll") for (int k = 0; k < 2; ++k) \
        acc[ai][bj][m][n] = __builtin_amdgcn_mfma_f32_16x16x32_bf16(Bt[n][k], At[m][k], acc[ai][bj][m][n], 0, 0, 0); __builtin_amdgcn_s_setprio(0); } while (0)
#define G8_WAIT_V(n) asm volatile("s_waitcnt vmcnt(" #n ")" ::: "memory")
#define G8_WAIT_L(n) asm volatile("s_waitcnt lgkmcnt(" #n ")" ::: "memory")
#define G8_BAR __builtin_amdgcn_s_barrier()
#define G8_SCHED __builtin_amdgcn_sched_barrier(0)
    Unit cur, nxt; int ui = 0;
    if (!p.unit(c, cur)) return;
    Acc acc;
#pragma unroll
    for (int a = 0; a < 2; ++a)
#pragma unroll
        for (int b = 0; b < 2; ++b)
#pragma unroll
            for (int m = 0; m < 4; ++m)
#pragma unroll
                for (int n = 0; n < 2; ++n) acc[a][b][m][n] = (f32x4){0.f, 0.f, 0.f, 0.f};
    bf16x8 At[4][2], B0[2][2], B1[2][2];
    const char* cA0 = p.a_base(cur, 0) - p.a_bias(0); const char* cA1 = p.a_base(cur, S1) - p.a_bias(S1);
    const char* cB0 = p.b_base(cur, 0) - p.b_bias(0); const char* cB1 = p.b_base(cur, S1) - p.b_bias(S1);
    G8_STB(G8_SB(0, 0), cB0, false, 0); G8_STB(G8_SB(0, 1), cB0, false, 1); G8_STA(G8_SA(0, 0), cA0, false, 0); G8_STA(G8_SA(0, 1), cA0, false, 1);
    if (wr == 1) G8_BAR;
    G8_WAIT_V(2); G8_BAR;
    G8_STB(G8_SB(1, 0), cB0 + ksB0, false, 0); G8_STA(G8_SA(1, 0), cA0 + ksA0, false, 0); G8_STB(G8_SB(1, 1), cB0 + ksB0, false, 1);
    G8_WAIT_V(6); G8_BAR;
    for (;;) {
        const bool has_next = p.unit((ui + 1) * G + c, nxt);
        const int nt = p.nt(cur);
        const char* nA0 = has_next ? p.a_base(nxt, 0) - p.a_bias(0) : cA0; const char* nA1 = has_next ? p.a_base(nxt, S1) - p.a_bias(S1) : cA1;
        const char* nB0 = has_next ? p.b_base(nxt, 0) - p.b_bias(0) : cB0; const char* nB1 = has_next ? p.b_base(nxt, S1) - p.b_bias(S1) : cB1;
        for (int t = 0; t < nt; t += 2) {
            const bool last = (t == nt - 2);
            const bool sg1 = (NS > 1) && (t + 1 >= nt0);
            const bool sg2 = (NS > 1) && !last && (t + 2 >= nt0);
            const char* a1 = sg1 ? cA1 + (long)(t + 1 - nt0) * ksA1 : cA0 + (long)(t + 1) * ksA0;
            const char* a2 = last ? nA0 : (sg2 ? cA1 + (long)(t + 2 - nt0) * ksA1 : cA0 + (long)(t + 2) * ksA0);
            const char* b2 = last ? nB0 : (sg2 ? cB1 + (long)(t + 2 - nt0) * ksB1 : cB0 + (long)(t + 2) * ksB0);
            const char* a3 = a2 + (sg2 ? ksA1 : ksA0); const char* b3 = b2 + (sg2 ? ksB1 : ksB0);
            G8_LDB(B0, 0, 0); G8_LDB(B1, 0, 1); G8_SCHED; G8_LDA(At, 0, 0); G8_STA(G8_SA(1, 1), a1, sg1, 1);
            G8_WAIT_V(8); G8_WAIT_L(0); G8_BAR; G8_MMA(0, 0, At, B0); G8_MMA(0, 1, At, B1); G8_BAR; G8_SCHED;
            G8_LDA(At, 0, 1); G8_STB(G8_SB(0, 0), b2, sg2, 0); G8_STB(G8_SB(0, 1), b2, sg2, 1); G8_STA(G8_SA(0, 0), a2, sg2, 0);
            G8_WAIT_V(8); G8_WAIT_L(0); G8_BAR; G8_MMA(1, 0, At, B0); G8_MMA(1, 1, At, B1); G8_BAR; G8_SCHED;
            G8_LDB(B0, 1, 0); G8_LDB(B1, 1, 1); G8_SCHED; G8_LDA(At, 1, 0); G8_STA(G8_SA(0, 1), a2, sg2, 1);
            G8_WAIT_V(8); G8_WAIT_L(0); G8_BAR; G8_MMA(0, 0, At, B0); G8_MMA(0, 1, At, B1); G8_BAR; G8_SCHED;
            G8_LDA(At, 1, 1); G8_STB(G8_SB(1, 0), b3, sg2, 0); G8_STB(G8_SB(1, 1), b3, sg2, 1); G8_STA(G8_SA(1, 0), a3, sg2, 0);
            G8_WAIT_V(8); G8_WAIT_L(0); G8_BAR; G8_MMA(1, 0, At, B0); G8_MMA(1, 1, At, B1); G8_BAR; G8_SCHED;
        }
        if (wr == 0) G8_BAR;
        p.epi(acc, cur, wr, wc, fr, fq, lds);
        if (!has_next) break;
#pragma unroll
        for (int a = 0; a < 2; ++a)
#pragma unroll
            for (int b = 0; b < 2; ++b)
#pragma unroll
                for (int m = 0; m < 4; ++m)
#pragma unroll
                    for (int n = 0; n < 2; ++n) acc[a][b][m][n] = (f32x4){0.f, 0.f, 0.f, 0.f};
        cur = nxt; ++ui; cA0 = nA0; cA1 = nA1; cB0 = nB0; cB1 = nB1;
        if (wr == 1) G8_BAR;
    }
    G8_WAIT_V(0);
    G8_BAR;
#undef G8_SA
#undef G8_SB
#undef G8_STAGE1
#undef G8_STA
#undef G8_STB
#undef G8_LDA
#undef G8_LDB
#undef G8_MMA
#undef G8_WAIT_V
#undef G8_WAIT_L
#undef G8_BAR
#undef G8_SCHED
}

template <class P>
__device__ __forceinline__ void gemm_phase_naive(LAS unsigned char* lds, const P& p, const int G, const int c) {
    const int tid = threadIdx.x, wid = tid >> 6, lane = tid & 63, wr = wid >> 2, wc = wid & 3, fr = lane & 15, fq = lane >> 4;
    LAS float* As = (LAS float*)lds;
    LAS float* Bs = As + 16 * 260;
    const int nt0 = p.nt0();
    Unit u;
    for (int ui = 0; p.unit(ui * G + c, u); ++ui) {
        const int nt = p.nt(u);
        Acc acc;
#pragma unroll
        for (int a = 0; a < 2; ++a)
#pragma unroll
            for (int b = 0; b < 2; ++b)
#pragma unroll
                for (int m = 0; m < 4; ++m)
#pragma unroll
                    for (int n = 0; n < 2; ++n) acc[a][b][m][n] = (f32x4){0.f, 0.f, 0.f, 0.f};
        for (int k0 = 0; k0 < nt * 64; k0 += 16) {
            const int seg = (P::NSEG > 1 && k0 >= nt0 * 64) ? 1 : 0, ks = k0 - (seg ? nt0 * 64 : 0);
            { const int row = tid >> 1, h8 = tid & 1;
              const u32x4 va = *(const u32x4*)(p.a_base(u, seg) + p.a_off(seg, row, ks + 8 * h8));
              const u32x4 vb = *(const u32x4*)(p.b_base(u, seg) + p.b_off(seg, row, ks + 8 * h8));
              __syncthreads();
#pragma unroll
              for (int i = 0; i < 4; ++i) { As[(8 * h8 + 2 * i) * 260 + row] = bf2f(va[i]); As[(8 * h8 + 2 * i + 1) * 260 + row] = bf2f(va[i] >> 16);
                                            Bs[(8 * h8 + 2 * i) * 260 + row] = bf2f(vb[i]); Bs[(8 * h8 + 2 * i + 1) * 260 + row] = bf2f(vb[i] >> 16); }
              __syncthreads(); }
            for (int kk = 0; kk < 16; ++kk) {
                float av[2][4], bv[2][2][4];
#pragma unroll
                for (int ai = 0; ai < 2; ++ai)
#pragma unroll
                    for (int m = 0; m < 4; ++m) av[ai][m] = As[kk * 260 + ai * 128 + wr * 64 + m * 16 + fr];
#pragma unroll
                for (int bj = 0; bj < 2; ++bj)
#pragma unroll
                    for (int n = 0; n < 2; ++n)
#pragma unroll
                        for (int j = 0; j < 4; ++j) bv[bj][n][j] = Bs[kk * 260 + bj * 128 + wc * 32 + (P::PERM ? 8 * fq + 4 * n + j : 16 * n + 4 * fq + j)];
#pragma unroll
                for (int ai = 0; ai < 2; ++ai)
#pragma unroll
                    for (int bj = 0; bj < 2; ++bj)
#pragma unroll
                        for (int m = 0; m < 4; ++m)
#pragma unroll
                            for (int n = 0; n < 2; ++n)
#pragma unroll
                                for (int j = 0; j < 4; ++j) acc[ai][bj][m][n][j] += av[ai][m] * bv[bj][n][j];
            }
        }
        __syncthreads();
        p.epi(acc, u, wr, wc, fr, fq, lds);
        __syncthreads();
    }
}


struct ProbG1 {
    static constexpr bool PERM = false; static constexpr int NSEG = 1;
    const char* HX; const char* HXV; const char* W1; const float* convw; char* A2;
    __host__ __device__ int nt0() const { return 16; } __host__ __device__ int nt(const Unit&) const { return 16; }
    __host__ __device__ long a_bias(int) const { return 0; } __host__ __device__ long b_bias(int) const { return 0; }
    __host__ __device__ bool unit(int L, Unit& u) const { return order_mn(L, RT / 256, 32, u); }
    __host__ __device__ const char* a_base(const Unit& u, int) const { return ((u.pn < 16 || u.pm >= 128) ? HX : HXV) + (size_t)u.pm * 256 * 128; }
    __host__ __device__ long a_off(int, int r, int k) const { return (long)r * 128 + (long)(k >> 6) * (long)HXPLANE + (k & 63) * 2; }
    __host__ __device__ const char* b_base(const Unit& u, int) const { return W1 + (size_t)u.pn * 256 * 128; }
    __host__ __device__ long b_off(int, int c, int k) const { return (long)c * 128 + (long)(k >> 6) * (8192L * 128) + (k & 63) * 2; }
    __device__ __forceinline__ void epi(Acc& acc, const Unit& u, int wr, int wc, int fr, int fq, LAS unsigned char* lds) const {
        LAS float* xb = (LAS float*)(lds + XL_OFF); const LAS float* cw = (const LAS float*)(lds + CWL_OFF);
        const bool chain = (u.pn >= 16) || (u.pm >= 128);
        const bool vert = (u.pn >= 16) && (u.pm < 128);
        const int ch0 = wc * 16 + fq * 4, chg = u.pn * 64 + ch0;
        const f32x4 w0 = *(const LAS f32x4*)(cw + chg), w1 = *(const LAS f32x4*)(cw + 2048 + chg), w2 = *(const LAS f32x4*)(cw + 4096 + chg);
        f32x4 uu[2][4];
#pragma unroll
        for (int ai = 0; ai < 2; ++ai)
#pragma unroll
            for (int m = 0; m < 4; ++m) uu[ai][m] = acc[ai][0][m][1] * acc[ai][1][m][0];
        f32x4 bu[2] = {{0.f, 0.f, 0.f, 0.f}, {0.f, 0.f, 0.f, 0.f}}, bd[2] = {{0.f, 0.f, 0.f, 0.f}, {0.f, 0.f, 0.f, 0.f}};
        if (chain) {
            const int sl = ch0;
#pragma unroll
            for (int ai = 0; ai < 2; ++ai) { const int bi = 2 * ai + wr;
                if (fr == 0) *(LAS f32x4*)(xb + (bi * 2 + 0) * 64 + sl) = uu[ai][0];
                if (fr == 15) *(LAS f32x4*)(xb + (bi * 2 + 1) * 64 + sl) = uu[ai][3]; }
            LDS_WAIT(); __builtin_amdgcn_s_barrier();
#pragma unroll
            for (int ai = 0; ai < 2; ++ai) { const int bi = 2 * ai + wr;
                if (bi > 0) bu[ai] = *(const LAS f32x4*)(xb + ((bi - 1) * 2 + 1) * 64 + sl);
                if (bi < 3) bd[ai] = *(const LAS f32x4*)(xb + ((bi + 1) * 2 + 0) * 64 + sl); }
        }
#pragma unroll
        for (int ai = 0; ai < 2; ++ai)
#pragma unroll
            for (int m = 0; m < 4; ++m) {
                const int rt = ai * 128 + wr * 64 + m * 16 + fr;
                f32x4 upv, dnv;
#pragma unroll
                for (int j = 0; j < 4; ++j) {
                    const float cu = (m == 0) ? bu[ai][j] : dpp_ror1(uu[ai][m > 0 ? m - 1 : 0][j]);
                    upv[j] = dpp_from_prev(cu, uu[ai][m][j]);
                    const float cd = (m == 3) ? bd[ai][j] : dpp_ror15(uu[ai][m < 3 ? m + 1 : 3][j]);
                    dnv[j] = dpp_from_next(cd, uu[ai][m][j]); }
                const f32x4 yc = w1 * uu[ai][m] + w0 * upv + w2 * dnv;
                const f32x4 bgv = acc[ai][0][m][0], zv = acc[ai][1][m][1];
                const f32x4 o = bgv * yc * silu4(zv);
                const int tok = vert ? ((u.pm >> 6) * SEQ + rt * GRIDW + (u.pm & 63)) : (u.pm * 256 + rt);
                u32x2 w; w.x = pk2(o[0], o[1]); w.y = pk2(o[2], o[3]);
                *(u32x2*)(A2 + (size_t)u.pn * HXPLANE + (size_t)tok * 128 + ch0 * 2) = w;
            }
    }
};

struct ProbG2 {
    static constexpr bool PERM = true; static constexpr int NSEG = 1;
    const char* A2; const char* W2; const float* mod; char* f1; float* y1s;
    __host__ __device__ int nt0() const { return 32; } __host__ __device__ int nt(const Unit& u) const { return u.pm >= 128 ? 4 : 32; }
    __host__ __device__ long a_bias(int) const { return 0; } __host__ __device__ long b_bias(int) const { return 0; }
    __host__ __device__ bool unit(int L, Unit& u) const {
        if (L < 512) return order_mn(L, RL / 256, 4, u);
        const int idx = L - 512; if (idx >= 64) return false;
        u.ks = idx & 7; const int tile = idx >> 3; u.pm = 128 + (tile >> 2); u.pn = tile & 3; u.g = 0; return true; }
    __host__ __device__ const char* a_base(const Unit& u, int) const { return A2 + (size_t)u.pm * 256 * 128 + (size_t)u.ks * 4 * HXPLANE; }
    __host__ __device__ long a_off(int, int r, int k) const { return (long)r * 128 + (long)(k >> 6) * (long)HXPLANE + (k & 63) * 2; }
    __host__ __device__ const char* b_base(const Unit& u, int) const { return W2 + (size_t)u.pn * 256 * 128 + (size_t)u.ks * 4 * (1024 * 128); }
    __host__ __device__ long b_off(int, int c, int k) const { return (long)c * 128 + (long)(k >> 6) * (1024L * 128) + (k & 63) * 2; }
    __device__ __forceinline__ void epi(Acc& acc, const Unit& u, int wr, int wc, int fr, int fq, LAS unsigned char*) const {
        const int col0 = u.pn * 256 + wc * 32 + 8 * fq;
        if (u.pm >= 128) {
#pragma unroll
            for (int ai = 0; ai < 2; ++ai)
#pragma unroll
                for (int m = 0; m < 4; ++m) { float* rowp = y1s + (((((size_t)u.ks * 2 + (u.pm - 128)) * 4 + u.pn) * 256 + ai * 128 + wr * 64 + m * 16 + fr) * 256) + wc * 32 + 8 * fq;
#pragma unroll
                    for (int bj = 0; bj < 2; ++bj)
#pragma unroll
                        for (int n = 0; n < 2; ++n) *(f32x4*)(rowp + bj * 128 + n * 4) = acc[ai][bj][m][n]; }
            return; }
        const int rho = u.pm >> 6;
        f32x4 gt[2][2];
#pragma unroll
        for (int bj = 0; bj < 2; ++bj)
#pragma unroll
            for (int n = 0; n < 2; ++n) gt[bj][n] = *(const f32x4*)(mod + rho * 3072 + 2048 + col0 + bj * 128 + n * 4);
#pragma unroll
        for (int ai = 0; ai < 2; ++ai)
#pragma unroll
            for (int m = 0; m < 4; ++m) { const size_t fv_ = (((size_t)(u.pm * 4 + u.pn) * 256 + ai * 128 + wr * 64 + m * 16 + fr) * 512) + (wc * 32 + 8 * fq) * 2;
                char* rowp = f1 + (fv_ >> 11) * 4096 + (fv_ & 2047);
#pragma unroll
                for (int bj = 0; bj < 2; ++bj) { const f32x4 v0 = gt[bj][0] * acc[ai][bj][m][0], v1 = gt[bj][1] * acc[ai][bj][m][1];
                    u32x4 w; w.x = pk2(v0[0], v0[1]); w.y = pk2(v0[2], v0[3]); w.z = pk2(v1[0], v1[1]); w.w = pk2(v1[2], v1[3]);
                    *(u32x4*)(rowp + bj * 256) = w; } }
    }
};

struct ProbG3 {
    static constexpr bool PERM = true; static constexpr int NSEG = 1;
    const char* HX; const char* W3; char* X; float* ucs; char* SZ; int zhalf;
    __host__ __device__ int nt0() const { return 16; } __host__ __device__ int nt(const Unit& u) const { return u.pm >= 128 ? 4 : 16; }
    __host__ __device__ long a_bias(int) const { return 0; } __host__ __device__ long b_bias(int) const { return 0; }
    __host__ __device__ bool unit(int L, Unit& u) const {
        if (L < 1024) return order_mn(L, RL / 256, 8, u);
        const int idx = L - 1024; if (zhalf || idx >= 64) return false;
        u.ks = idx & 3; const int tile = idx >> 2; u.pm = 128 + (tile >> 3); u.pn = tile & 7; u.g = 0; return true; }
    __host__ __device__ const char* a_base(const Unit& u, int) const { return HX + (size_t)u.pm * 256 * 128 + (size_t)u.ks * 4 * HXPLANE; }
    __host__ __device__ long a_off(int, int r, int k) const { return (long)r * 128 + (long)(k >> 6) * (long)HXPLANE + (k & 63) * 2; }
    __host__ __device__ const char* b_base(const Unit& u, int) const { return W3 + (size_t)(zhalf * 2048 + u.pn * 256) * 128 + (size_t)u.ks * 4 * (4096 * 128); }
    __host__ __device__ long b_off(int, int c, int k) const { return (long)c * 128 + (long)(k >> 6) * (4096L * 128) + (k & 63) * 2; }
    __device__ __forceinline__ void epi(Acc& acc, const Unit& u, int wr, int wc, int fr, int fq, LAS unsigned char*) const {
#pragma unroll
        for (int ai = 0; ai < 2; ++ai)
#pragma unroll
            for (int m = 0; m < 4; ++m) { const int tok = u.pm * 256 + ai * 128 + wr * 64 + m * 16 + fr;
#pragma unroll
                for (int bj = 0; bj < 2; ++bj) { const int n0 = u.pn * 256 + bj * 128 + wc * 32 + 8 * fq;
                    f32x4 v0 = acc[ai][bj][m][0], v1 = acc[ai][bj][m][1];
                    if (u.pm >= 128) { float* rp = ucs + ((((size_t)(n0 >> 4) * 4 + u.ks) * RC + (tok - RL)) * 16) + (n0 & 15); *(f32x4*)rp = v0; *(f32x4*)(rp + 4) = v1; continue; }
                    if (zhalf) { v0 = silu4(v0); v1 = silu4(v1); }
                    u32x4 w; w.x = pk2(v0[0], v0[1]); w.y = pk2(v0[2], v0[3]); w.z = pk2(v1[0], v1[1]); w.w = pk2(v1[2], v1[3]);
                    if (zhalf) *(u32x4*)(SZ + ((((size_t)(u.pm * 8 + u.pn) * 256 + (tok & 255)) * 256) + (n0 & 255)) * 2) = w;
                    else { const int g = n0 >> 4, p0 = n0 & 15;
                        const int b = tok / SEQ, tt = tok % SEQ, col = b * NCHB + tt / TCH, t = tt % TCH;
                        *(u32x4*)(X + (size_t)g * XPLANE + ((size_t)(t >> 2) * NCOL + col) * 128 + ((t & 3) * 16 + p0) * 2) = w; } } }
    }
};
struct ProbS {
    static constexpr bool PERM = true; static constexpr int NSEG = 1;
    const char* X; const char* M2; char* S; int g, b;
    __host__ __device__ int nt0() const { return TP / 64; } __host__ __device__ int nt(const Unit&) const { return TP / 64; }
    __host__ __device__ long a_bias(int) const { return 0; } __host__ __device__ long b_bias(int) const { return 0; }
    __host__ __device__ bool unit(int L, Unit& u) const { if (L >= NCHB / 256) return false; u.g = g; u.pm = 0; u.pn = b * (NCHB / 256) + L; u.ks = 0; return true; }
    __host__ __device__ const char* a_base(const Unit& u, int) const { return M2 + (size_t)u.g * MiB; }
    __host__ __device__ long a_off(int, int r, int k) const { return (long)(k >> 6) * (256 * 128) + (long)r * 128 + (k & 63) * 2; }
    __host__ __device__ const char* b_base(const Unit& u, int) const { return X + (size_t)u.g * XPLANE + (size_t)u.pn * 256 * 128; }
    __host__ __device__ long b_off(int, int c, int k) const { return (long)(k >> 6) * (NCOL * 128L) + (long)c * 128 + (k & 63) * 2; }
    __device__ __forceinline__ void epi(Acc& acc, const Unit& u, int wr, int wc, int fr, int fq, LAS unsigned char*) const {
#pragma unroll
        for (int ai = 0; ai < 2; ++ai)
#pragma unroll
            for (int m = 0; m < 4; ++m) { const int j = ai * 128 + wr * 64 + m * 16 + fr;
                char* rowp = S + (size_t)u.g * MiB + ((size_t)((u.pn * 256 + wc * 32 + 8 * fq) >> 3) * 256 + j) * 16;
#pragma unroll
                for (int bj = 0; bj < 2; ++bj) { const f32x4 v0 = acc[ai][bj][m][0], v1 = acc[ai][bj][m][1];
                    u32x4 w; w.x = pk2(v0[0], v0[1]); w.y = pk2(v0[2], v0[3]); w.z = pk2(v1[0], v1[1]); w.w = pk2(v1[2], v1[3]);
                    *(u32x4*)(rowp + bj * (16 * 256 * 16)) = w; } }
    }
};

struct ProbY {
    static constexpr bool PERM = true; static constexpr int NSEG = 2;
    const char* X; const char* KR; const char* M4; char* Gout; int g, b; unsigned* pair_cnt;
    __host__ __device__ int nt0() const { return TP / 64; } __host__ __device__ int nt(const Unit&) const { return XLD / 64; }
    __host__ __device__ long a_bias(int) const { return 0; } __host__ __device__ long b_bias(int seg) const { return seg ? 0 : 96; }
    __host__ __device__ bool unit(int L, Unit& u) const { constexpr int nN = TP / 256, nM = NCHB / 256; if (L >= nN * nM) return false; u.g = g; u.pm = b * nM + L / nN; u.pn = L % nN; u.ks = 0; return true; }
    __host__ __device__ const char* a_base(const Unit& u, int seg) const { return X + (size_t)u.g * XPLANE + (size_t)u.pm * 256 * 128 + (seg ? (size_t)(TP / 64) * NCOL * 128 : 0); }
    __host__ __device__ long a_off(int, int r, int k) const { return (long)(k >> 6) * (NCOL * 128L) + (long)r * 128 + (k & 63) * 2; }
    __host__ __device__ const char* b_base(const Unit& u, int seg) const {
        return seg ? M4 + (size_t)u.g * TP * 512 + (size_t)u.pn * 256 * 128 : KR + (size_t)u.g * KRG * 2 + (size_t)(TCH - 1 - 16 * u.pn) * 32; }
    __host__ __device__ long b_off(int seg, int c, int k) const { return seg ? (long)(k >> 6) * (TP * 128L) + (long)c * 128 + (k & 63) * 2 : ((long)(c & 15) * PSTR - (long)(c >> 4) * 16 + k) * 2; }
    __device__ __forceinline__ void epi(Acc& acc, const Unit& u, int wr, int wc, int fr, int fq, LAS unsigned char*) const {
        if (u.pm == b * (NCHB / 256) && u.pn == 0) {
            unsigned sp = 0;
            while (__hip_atomic_load(pair_cnt, __ATOMIC_RELAXED, __HIP_MEMORY_SCOPE_AGENT) < 2u && ++sp < (1u << 22)) __builtin_amdgcn_s_sleep(2); }
#pragma unroll
        for (int ai = 0; ai < 2; ++ai)
#pragma unroll
            for (int m = 0; m < 4; ++m) { const int col = u.pm * 256 + ai * 128 + wr * 64 + m * 16 + fr;
#pragma unroll
                for (int bj = 0; bj < 2; ++bj) { const int n0 = u.pn * 256 + bj * 128 + wc * 32 + 8 * fq;
                    const f32x4 v0 = gelu_tanh4(acc[ai][bj][m][0]), v1 = gelu_tanh4(acc[ai][bj][m][1]);
                    u32x4 w; w.x = pk2(v0[0], v0[1]); w.y = pk2(v0[2], v0[3]); w.z = pk2(v1[0], v1[1]); w.w = pk2(v1[2], v1[3]);
                    *(u32x4*)(Gout + (size_t)u.g * GPLANE + ((size_t)col * TP + n0) * 2) = w; } }
    }
};

struct ProbG4 {
    static constexpr bool PERM = true; static constexpr int NSEG = 1;
    const char* Gin; const char* WG; const char* SZ; const float* bglu; char* A4;
    __host__ __device__ int nt0() const { return 32; } __host__ __device__ int nt(const Unit&) const { return 32; }
    __host__ __device__ long a_bias(int) const { return 0; } __host__ __device__ long b_bias(int) const { return 0; }
    __host__ __device__ bool unit(int L, Unit& u) const { return order_mn(L, RL / 256, 8, u); }
    __host__ __device__ const char* a_base(const Unit& u, int) const { return Gin + (size_t)u.pm * 256 * 32; }
    __host__ __device__ long a_off(int, int r, int k) const { return (long)(k >> 4) * (long)GPLANE + (long)r * 32 + (k & 15) * 2; }
    __host__ __device__ const char* b_base(const Unit& u, int) const { return WG + (size_t)u.pn * 256 * 128; }
    __host__ __device__ long b_off(int, int c, int k) const { return (long)c * 128 + (long)(k >> 6) * (2048L * 128) + (k & 63) * 2; }
    __device__ __forceinline__ void epi(Acc& acc, const Unit& u, int wr, int wc, int fr, int fq, LAS unsigned char*) const {
        f32x4 b0[2], b1[2];
#pragma unroll
        for (int bj = 0; bj < 2; ++bj) { const int n0 = u.pn * 256 + bj * 128 + wc * 32 + 8 * fq; b0[bj] = *(const f32x4*)(bglu + n0); b1[bj] = *(const f32x4*)(bglu + n0 + 4); }
#pragma unroll
        for (int ai = 0; ai < 2; ++ai) {
            u32x4 gv[4][2], sv[4][2];
#pragma unroll
            for (int m = 0; m < 4; ++m) { const int tok = u.pm * 256 + ai * 128 + wr * 64 + m * 16 + fr;
#pragma unroll
                for (int bj = 0; bj < 2; ++bj) { const int n0 = u.pn * 256 + bj * 128 + wc * 32 + 8 * fq;
                    gv[m][bj] = __builtin_nontemporal_load((const u32x4*)(Gin + (size_t)(n0 >> 4) * GPLANE + (size_t)tok * 32 + (n0 & 15) * 2));
                    sv[m][bj] = __builtin_nontemporal_load((const u32x4*)(SZ + ((((size_t)(u.pm * 8 + u.pn) * 256 + (tok & 255)) * 256) + (n0 & 255)) * 2)); } }
#pragma unroll
            for (int m = 0; m < 4; ++m) { const int tok = u.pm * 256 + ai * 128 + wr * 64 + m * 16 + fr;
#pragma unroll
                for (int bj = 0; bj < 2; ++bj) { const int n0 = u.pn * 256 + bj * 128 + wc * 32 + 8 * fq;
                    const f32x4 v0 = acc[ai][bj][m][0] + b0[bj], v1 = acc[ai][bj][m][1] + b1[bj];
                    const u32x4 gq = gv[m][bj], sq = sv[m][bj];
                    const f32x4 o0 = bf4_lo(u32x2{gq.x, gq.y}) * bf4_lo(u32x2{sq.x, sq.y}) * sigmoid4(v0), o1 = bf4_lo(u32x2{gq.z, gq.w}) * bf4_lo(u32x2{sq.z, sq.w}) * sigmoid4(v1);
                    u32x4 w; w.x = pk2(o0[0], o0[1]); w.y = pk2(o0[2], o0[3]); w.z = pk2(o1[0], o1[1]); w.w = pk2(o1[2], o1[3]);
                    *(u32x4*)(A4 + (size_t)(n0 >> 6) * A4PLANE + (size_t)tok * 128 + (n0 & 63) * 2) = w; } } }
    }
};

struct ProbG5 {
    static constexpr bool PERM = true; static constexpr int NSEG = 1;
    const char* A4; const char* W5; const float* mod; char* fo;
    __host__ __device__ int nt0() const { return 32; } __host__ __device__ int nt(const Unit&) const { return 32; }
    __host__ __device__ long a_bias(int) const { return 0; } __host__ __device__ long b_bias(int) const { return 0; }
    __host__ __device__ bool unit(int L, Unit& u) const { return order_mn(L, RL / 256, 4, u); }
    __host__ __device__ const char* a_base(const Unit& u, int) const { return A4 + (size_t)u.pm * 256 * 128; }
    __host__ __device__ long a_off(int, int r, int k) const { return (long)r * 128 + (long)(k >> 6) * (long)A4PLANE + (k & 63) * 2; }
    __host__ __device__ const char* b_base(const Unit& u, int) const { return W5 + (size_t)u.pn * 256 * 128; }
    __host__ __device__ long b_off(int, int c, int k) const { return (long)c * 128 + (long)(k >> 6) * (1024L * 128) + (k & 63) * 2; }
    __device__ __forceinline__ void epi(Acc& acc, const Unit& u, int wr, int wc, int fr, int fq, LAS unsigned char*) const {
        const int rho = u.pm >> 6, col0 = u.pn * 256 + wc * 32 + 8 * fq;
        f32x4 gt[2][2];
#pragma unroll
        for (int bj = 0; bj < 2; ++bj)
#pragma unroll
            for (int n = 0; n < 2; ++n) gt[bj][n] = *(const f32x4*)(mod + (3 + rho) * 3072 + 2048 + col0 + bj * 128 + n * 4);
#pragma unroll
        for (int ai = 0; ai < 2; ++ai)
#pragma unroll
            for (int m = 0; m < 4; ++m) { char* rowp = fo + ((((size_t)(u.pm * 4 + u.pn) * 256 + ai * 128 + wr * 64 + m * 16 + fr) * 256) + wc * 32 + 8 * fq) * 2;
#pragma unroll
                for (int bj = 0; bj < 2; ++bj) { const f32x4 v0 = gt[bj][0] * acc[ai][bj][m][0], v1 = gt[bj][1] * acc[ai][bj][m][1];
                    u32x4 w; w.x = pk2(v0[0], v0[1]); w.y = pk2(v0[2], v0[3]); w.z = pk2(v1[0], v1[1]); w.w = pk2(v1[2], v1[3]);
                    *(u32x4*)(rowp + bj * 256) = w; } }
    }
};
}

struct Frame {
    LAS unsigned char* lds;
    int tid, lane, wave, G, bid;
    const float* in[23]; float* out; unsigned char* ws;
};

template <class RM>
__device__ __forceinline__ void transpose_item(const float* W, int K, int N, bf16* WT, LAS float* scr, int item, int lane, RM rowmap) {
    const int nblk = N / 64, kb = item / nblk, nb = item % nblk, k0 = 64 * kb, n0 = 64 * nb;
    f32x4 v[16];
#pragma unroll
    for (int i = 0; i < 16; ++i) v[i] = __builtin_nontemporal_load((const f32x4*)(W + (size_t)(k0 + 4 * i + (lane >> 4)) * N + n0 + 4 * (lane & 15)));
#pragma unroll
    for (int i = 0; i < 16; ++i) { LAS float* d = scr + (4 * i + (lane >> 4)) * 65 + 4 * (lane & 15); d[0] = v[i][0]; d[1] = v[i][1]; d[2] = v[i][2]; d[3] = v[i][3]; }
    LDS_WAIT(); asm volatile("" ::: "memory");
    const int c = lane & 7;
#pragma unroll
    for (int j = 0; j < 8; ++j) { const int n = (lane >> 3) + 8 * j; const LAS float* sp = scr + (8 * c) * 65 + n;
        u32x4 o; o.x = pk2(sp[0 * 65], sp[1 * 65]); o.y = pk2(sp[2 * 65], sp[3 * 65]); o.z = pk2(sp[4 * 65], sp[5 * 65]); o.w = pk2(sp[6 * 65], sp[7 * 65]);
        *(u32x4*)(WT + (size_t)kb * N * 64 + (size_t)rowmap(n0 + n) * 64 + 8 * c) = o; }
    LDS_WAIT(); asm volatile("" ::: "memory");
}
struct RowId { __device__ int operator()(int n) const { return n; } };
struct RowW1 { __device__ int operator()(int n) const { const int p = n >> 11, chg = n & 2047, nt = chg >> 6, ch = chg & 63; return nt * 256 + 128 * (p >> 1) + 16 * (p & 1) + 32 * (ch >> 4) + (ch & 15); } };

__device__ __forceinline__ void prep_ssm(Frame& F) {
    LAS float* fl = (LAS float*)F.lds;
    const int tid = F.tid;
    for (int prep_ = 0; prep_ < (PROBE_PREP_PART == 0 ? 2 : 1); ++prep_)
    for (int item = F.bid; item < 2 * NG; item += F.G) {
        const int g = item >> 1, r = item & 1;
        LAS float* Av = fl; LAS float* Fv = fl + 256; LAS float* BBs = fl + 512; LAS float* Cs = fl + 4608; LAS float* PW = fl + 8768;
        __syncthreads();
        float pbre[4], pbim[4], pcre[4], pcim[4];
#pragma unroll
        for (int it = 0; it < 4; ++it) { const int e = tid + 512 * it, rr = e >> 10, n = (e >> 4) & 63, q = e & 15, p = (e >> 6) & 15, nn = e & 63;
            pbre[it] = F.in[I_BRE][((size_t)(rr * NG + g) * 64 + n) * 16 + q]; pbim[it] = F.in[I_BIM][((size_t)(rr * NG + g) * 64 + n) * 16 + q];
            pcre[it] = F.in[I_CRE][((size_t)(rr * NG + g) * 16 + p) * 64 + nn]; pcim[it] = F.in[I_CIM][((size_t)(rr * NG + g) * 16 + p) * 64 + nn]; }
        if (tid < 128) { const int rr = tid >> 6, n = tid & 63;
            const float dt = expf(F.in[I_LSTEP][rr * NG + g]);
            const float lre = F.in[I_LRE][(rr * NG + g) * 64 + n], lim = F.in[I_LIM][(rr * NG + g) * 64 + n];
            const float mag = expf(lre * dt); float sn, cs; sincosf(lim * dt, &sn, &cs);
            const float ar = mag * cs, ai = mag * sn, qr = ar - 1.0f, qi = ai, den = lre * lre + lim * lim;
            Av[(rr * 64 + n) * 2] = ar; Av[(rr * 64 + n) * 2 + 1] = ai;
            Fv[(rr * 64 + n) * 2] = (qr * lre + qi * lim) / den; Fv[(rr * 64 + n) * 2 + 1] = (qi * lre - qr * lim) / den;
        }
        __syncthreads();
#pragma unroll
        for (int it = 0; it < 4; ++it) { const int e = tid + 512 * it, rr = e >> 10, n = (e >> 4) & 63, q = e & 15;
            const float bre = pbre[it], bim = pbim[it];
            const float fr_ = Fv[(rr * 64 + n) * 2], fi_ = Fv[(rr * 64 + n) * 2 + 1];
            const float bbr = fr_ * bre - fi_ * bim, bbi = fr_ * bim + fi_ * bre;
            BBs[e * 2] = bbr; BBs[e * 2 + 1] = bbi;
            if (rr == r) { float* bg = (float*)(F.ws + WS_BBG) + (((size_t)(r * NG + g) * 64 + n) * 16 + q) * 2; bg[0] = bbr; bg[1] = bbi; }
            const int p = (e >> 6) & 15, nn = e & 63;
            Cs[((rr * 16 + p) * 65 + nn) * 2] = pcre[it];
            Cs[((rr * 16 + p) * 65 + nn) * 2 + 1] = pcim[it]; }
        __syncthreads();
        if (tid < 64) { const int n = tid; const float ar = Av[(r * 64 + n) * 2], ai = Av[(r * 64 + n) * 2 + 1]; float pr = 1.f, pi = 0.f;
            for (int e = 0; e <= TCH; ++e) { PW[(n * 65 + e) * 2] = pr; PW[(n * 65 + e) * 2 + 1] = pi; const float nr = pr * ar - pi * ai, ni = pr * ai + pi * ar; pr = nr; pi = ni; }
            float* za = (float*)(F.ws + WS_ZA) + ((size_t)(r * NG + g) * 64 + n) * 4; za[0] = ar; za[1] = ai; za[2] = PW[(n * 65 + TCH) * 2]; za[3] = PW[(n * 65 + TCH) * 2 + 1]; }
        __syncthreads();
        { bf16* M2g = (bf16*)(F.ws + WS_M2 + (size_t)g * MiB);
          constexpr int TPR = TP / 8;
          const int k8 = (tid % TPR) * 8, s_ = k8 >> 4, q0 = k8 & 15, e = r ? s_ : (TCH - 1 - s_);
          for (int j = tid / TPR; j < 128; j += 512 / TPR) { const int cc = j >> 6, n = j & 63;
            const float pr = PW[(n * 65 + e) * 2], pi = PW[(n * 65 + e) * 2 + 1];
            float v[8];
#pragma unroll
            for (int i = 0; i < 8; ++i) { const float br_ = BBs[((r * 64 + n) * 16 + q0 + i) * 2], bi_ = BBs[((r * 64 + n) * 16 + q0 + i) * 2 + 1]; v[i] = cc ? (pr * bi_ + pi * br_) : (pr * br_ - pi * bi_); }
            u32x4 w; w.x = pk2(v[0], v[1]); w.y = pk2(v[2], v[3]); w.z = pk2(v[4], v[5]); w.w = pk2(v[6], v[7]);
            *(u32x4*)(M2g + ((size_t)(k8 >> 6) * 256 + r * 128 + j) * 64 + (k8 & 63)) = w; } }
        { bf16* M4g = (bf16*)(F.ws + WS_M4) + (size_t)g * TP * 256;
          const int jj0 = (tid & 15) * 8, n0 = jj0 >> 1;
          for (int row = tid >> 4; row < TP; row += 32) { const int t = row >> 4, p = row & 15, e = r ? (TCH - t) : (t + 1);
            float v[8];
#pragma unroll
            for (int i = 0; i < 4; ++i) { const float cr = Cs[((r * 16 + p) * 65 + n0 + i) * 2], ci = Cs[((r * 16 + p) * 65 + n0 + i) * 2 + 1], pr = PW[((n0 + i) * 65 + e) * 2], pi = PW[((n0 + i) * 65 + e) * 2 + 1];
                v[2 * i] = cr * pr - ci * pi; v[2 * i + 1] = -(cr * pi + ci * pr); }
            u32x4 w; w.x = pk2(v[0], v[1]); w.y = pk2(v[2], v[3]); w.z = pk2(v[4], v[5]); w.w = pk2(v[6], v[7]);
            *(u32x4*)(M4g + ((size_t)((r * 128 + jj0) >> 6) * TP + row) * 64 + (jj0 & 63)) = w; } }
        { bf16* KRg = (bf16*)(F.ws + WS_KR) + (size_t)g * KRG;
          const int l = tid & 63, wv = tid >> 6, li = l & 15, kq = l >> 4, cbit = kq & 1;
          float X[32], Y[32], bbv[32];
#pragma unroll
          for (int s_ = 0; s_ < 32; ++s_) { const int n = 2 * s_ + (kq >> 1);
              const float cr = Cs[((r * 16 + li) * 65 + n) * 2], ci = Cs[((r * 16 + li) * 65 + n) * 2 + 1];
              X[s_] = cbit ? -ci : cr; Y[s_] = cbit ? -cr : -ci;
              bbv[s_] = BBs[((r * 64 + n) * 16 + li) * 2 + cbit]; }
#pragma unroll 1
          for (int ei = 0; ei < 4; ++ei) { const int e = wv * 4 + ei;
              if (r == 1 && e == 0) continue;
              f32x4 d = {0.f, 0.f, 0.f, 0.f};
#pragma unroll
              for (int s_ = 0; s_ < 32; ++s_) { const int n = 2 * s_ + (kq >> 1); const f32x2 pw = *(const LAS f32x2*)(PW + (n * 65 + e) * 2);
                  d = __builtin_amdgcn_mfma_f32_16x16x4f32(bbv[s_], X[s_] * pw[0] + Y[s_] * pw[1], d, 0, 0, 0); }
              if (r == 0 && e == 0) {
#pragma unroll 4
                  for (int s_ = 0; s_ < 32; ++s_) { const int n = 2 * s_ + (kq >> 1);
                      const float cr1 = Cs[((16 + li) * 65 + n) * 2], ci1 = Cs[((16 + li) * 65 + n) * 2 + 1];
                      d = __builtin_amdgcn_mfma_f32_16x16x4f32(BBs[((64 + n) * 16 + li) * 2 + cbit], cbit ? -ci1 : cr1, d, 0, 0, 0); }
                  const float dv = F.in[I_SD][g * 16 + li];
#pragma unroll
                  for (int i = 0; i < 4; ++i) if (4 * kq + i == li) d[i] += dv; }
              const int j = r ? (TCH - 1 + e) : (TCH - 1 - e);
              u32x2 w2; w2.x = pk2(d[0], d[1]); w2.y = pk2(d[2], d[3]);
              *(u32x2*)(KRg + (size_t)li * PSTR + j * 16 + 4 * kq) = w2; } }
    }
    __syncthreads();
}
__device__ __forceinline__ void prep_mod(Frame& F) {
    LAS float* fl = (LAS float*)F.lds;
    const int tid = F.tid;
    for (int prep_ = 0; prep_ < (PROBE_PREP_PART == 1 ? 2 : 1); ++prep_)
    {   LAS float* sc = fl;
        for (int e = tid; e < 3 * D; e += 512) { const int rho = e >> 10, k = e & 1023; const float v = rho < 2 ? F.in[I_C][rho * D + k] : F.in[I_CCTX][k]; sc[e] = siluf_(v); }
        __syncthreads();
        LAS float* red = fl + 3 * D;
        for (int item = F.bid; item < 2 * 96; item += F.G) {
            const int layer = item / 96, n0 = (item % 96) * 32, kk = tid >> 5, nn = tid & 31;
            const float* w = F.in[I_ADAW] + (size_t)layer * D * 3072 + n0 + nn;
            float s0 = 0.f, s1 = 0.f, s2 = 0.f;
            for (int k = kk; k < D; k += 256) { float wv[16];
#pragma unroll
                for (int i = 0; i < 16; ++i) wv[i] = w[(size_t)(k + 16 * i) * 3072];
#pragma unroll
                for (int i = 0; i < 16; ++i) { s0 += sc[k + 16 * i] * wv[i]; s1 += sc[D + k + 16 * i] * wv[i]; s2 += sc[2 * D + k + 16 * i] * wv[i]; } }
            red[(kk * 32 + nn) * 3] = s0; red[(kk * 32 + nn) * 3 + 1] = s1; red[(kk * 32 + nn) * 3 + 2] = s2;
            __syncthreads();
            if (tid < 96) { const int rho = tid >> 5, n = tid & 31; float s = 0.f;
                for (int k2 = 0; k2 < 16; ++k2) s += red[(k2 * 32 + n) * 3 + rho];
                __hip_atomic_store((float*)(F.ws + WS_MOD) + (layer * 3 + rho) * 3072 + n0 + n, s + F.in[I_ADAB][layer * 3072 + n0 + n], __ATOMIC_RELAXED, __HIP_MEMORY_SCOPE_AGENT); }
            __syncthreads();
        }
    }
    __syncthreads();
}
__device__ __forceinline__ void prep_tr(Frame& F) {
    {   LAS float* scr = (LAS float*)(F.lds + F.wave * 16640);
        const int gw = F.bid * 8 + F.wave, NGW = F.G * 8;
        constexpr int I1 = (1024 / 64) * (8192 / 64), I2 = (2048 / 64) * (1024 / 64);
        for (int it = gw; it < I1 + I2; it += NGW) {
            int rI = it;
            if (rI < I1) { transpose_item(F.in[I_CWIN], 1024, 8192, (bf16*)(F.ws + WS_W1), scr, rI, F.lane, RowW1()); continue; } rI -= I1;
            transpose_item(F.in[I_CWOUT], 2048, 1024, (bf16*)(F.ws + WS_W2), scr, rI, F.lane, RowId());
        }
    }
}
__device__ __forceinline__ void prep_tr_late(Frame& F, int first_bid, int nblocks) {
    LAS float* scr = (LAS float*)(F.lds + F.wave * 16640);
    const int gw = (F.bid - first_bid) * 8 + F.wave, NGW = nblocks * 8;
    constexpr int I3 = (1024 / 64) * (4096 / 64), I4 = (2048 / 64) * (2048 / 64), I5 = (2048 / 64) * (1024 / 64);
    for (int it = gw; it < I3 + I4 + I5; it += NGW) {
        int rI = it;
        if (rI < I3) { transpose_item(F.in[I_SWIN], 1024, 4096, (bf16*)(F.ws + WS_W3), scr, rI, F.lane, RowId()); continue; } rI -= I3;
        if (rI < I4) { transpose_item(F.in[I_WGLU], 2048, 2048, (bf16*)(F.ws + WS_WG), scr, rI, F.lane, RowId()); continue; } rI -= I4;
        transpose_item(F.in[I_SWOUT], 2048, 1024, (bf16*)(F.ws + WS_W5), scr, rI, F.lane, RowId());
    }
}
__device__ __forceinline__ void phase_prep(Frame& F) {
    prep_mod(F);
    { VM_WAIT(); __syncthreads();
      if (F.tid == 0) { int mine = 0; for (int item = F.bid; item < 2 * 96; item += F.G) ++mine;
          if (mine) (void)xb_add((unsigned*)(F.ws + WS_CTL) + CW_MOD, (unsigned)mine); } }
    { prep_tr(F); __syncthreads(); prep_ssm(F); }
}
__device__ __forceinline__ void store_row_blk64(char* base, size_t row, int lane, const f32x4 (&v)[4]) {
#pragma unroll
    for (int j = 0; j < 4; ++j) { const int kb = 4 * j + (lane >> 4), col = 4 * (lane & 15);
        u32x2 w; w.x = pk2(v[j][0], v[j][1]); w.y = pk2(v[j][2], v[j][3]);
        *(u32x2*)(base + (size_t)kb * HXPLANE + row * 128 + col * 2) = w; }
}
__device__ __forceinline__ void phase_mod0(Frame& F) {
    { if (F.tid == 0) { unsigned* cnt = (unsigned*)(F.ws + WS_CTL) + CW_MOD; unsigned sp = 0; while (xb_ld(cnt) < 2u * 96u && ++sp < (1u << 22)) __builtin_amdgcn_s_sleep(2);
          asm volatile("buffer_inv sc0\n s_waitcnt vmcnt(0)" ::: "memory"); }
      __syncthreads(); }
    const int gw = F.bid * 8 + F.wave, NGW = F.G * 8; const float* mod = (const float*)(F.ws + WS_MOD);
    for (int row = gw; row < RT; row += NGW) {
        const bool isctx = row >= RL; const int rho = isctx ? 2 : row / SEQ;
        const float* src = isctx ? F.in[I_CTX] + (size_t)(row - RL) * D : F.in[I_X] + (size_t)row * D;
        f32x4 v[4];
#pragma unroll
        for (int j = 0; j < 4; ++j) { const int idx = 256 * j + 4 * F.lane; const f32x4 xv = __builtin_nontemporal_load((const f32x4*)(src + idx));
            const f32x4 sh = *(const f32x4*)(mod + rho * 3072 + idx), sc = *(const f32x4*)(mod + rho * 3072 + 1024 + idx);
            v[j] = xv * (1.0f + sc) + sh; }
        store_row_blk64((char*)F.ws + WS_HX, (size_t)row, F.lane, v);
        if (!isctx) { const int b = row / SEQ, t = row % SEQ; store_row_blk64((char*)F.out, (size_t)b * SEQ + (size_t)(t % GRIDW) * 256 + t / GRIDW, F.lane, v); }
    }
}
__device__ __forceinline__ void ln_row(f32x4 (&v)[4], const float* g, const float* b, int lane) {
    float s = 0.f;
#pragma unroll
    for (int j = 0; j < 4; ++j) s += (v[j][0] + v[j][1]) + (v[j][2] + v[j][3]);
    const float mean = wave_sum(s) * (1.f / D); float s2 = 0.f;
#pragma unroll
    for (int j = 0; j < 4; ++j) { v[j] = v[j] - mean; s2 += (v[j][0] * v[j][0] + v[j][1] * v[j][1]) + (v[j][2] * v[j][2] + v[j][3] * v[j][3]); }
    const float rstd = 1.0f / sqrtf(wave_sum(s2) * (1.f / D) + LN_EPS);
#pragma unroll
    for (int j = 0; j < 4; ++j) { const int idx = 256 * j + 4 * lane; v[j] = v[j] * rstd * *(const f32x4*)(g + idx) + *(const f32x4*)(b + idx); }
}
__device__ __forceinline__ void phase_ln_mod1(Frame& F) {
    const int gw = F.bid * 8 + F.wave, NGW = F.G * 8; const float* mod = (const float*)(F.ws + WS_MOD) + 3 * 3072;
    for (int row = gw; row < RT; row += NGW) {
        const bool isctx = row >= RL; const int rho = isctx ? 2 : row / SEQ;
        float* src = F.out + (size_t)row * D;
        f32x4 v[4];
        if (isctx) { const float* mod0 = (const float*)(F.ws + WS_MOD);
#pragma unroll
            for (int j = 0; j < 4; ++j) { const int idx = 256 * j + 4 * F.lane; f32x4 a = {0.f, 0.f, 0.f, 0.f};
#pragma unroll
                for (int ks = 0; ks < 8; ++ks) a += *(const f32x4*)((const float*)(F.ws + WS_Y1S) + (((((size_t)ks * 2 + ((row - RL) >> 8)) * 4 + j) * 256 + ((row - RL) & 255)) * 256) + 4 * F.lane);
                v[j] = DN_ALPHA * *(const f32x4*)(F.in[I_CTX] + (size_t)(row - RL) * D + idx) + *(const f32x4*)(mod0 + 2 * 3072 + 2048 + idx) * a; } }
        else {
#pragma unroll
            for (int j = 0; j < 4; ++j) { const int idx = 256 * j + 4 * F.lane; const size_t fv_ = ((((size_t)(row >> 8) * 4 + j) * 256 + (row & 255)) * 512) + 8 * F.lane;
                const u32x2 f = __builtin_nontemporal_load((const u32x2*)((const char*)F.out + (fv_ >> 11) * 4096 + (fv_ & 2047)));
                const f32x4 fv = {bf2f(f.x), bf2f(f.x >> 16), bf2f(f.y), bf2f(f.y >> 16)};
                v[j] = DN_ALPHA * __builtin_nontemporal_load((const f32x4*)(F.in[I_X] + (size_t)row * D + idx)) + fv; } }
        ln_row(v, F.in[I_LNG], F.in[I_LNB], F.lane);
        if (!isctx) {
#pragma unroll
            for (int j = 0; j < 4; ++j) { u32x2 w; w.x = pk2(v[j][0], v[j][1]); w.y = pk2(v[j][2], v[j][3]); __builtin_nontemporal_store(w, (u32x2*)((char*)src + 2048 + (256 * j + 4 * F.lane) * 2)); } }
#pragma unroll
        for (int j = 0; j < 4; ++j) { const int idx = 256 * j + 4 * F.lane;
            const f32x4 sh = *(const f32x4*)(mod + rho * 3072 + idx), sc = *(const f32x4*)(mod + rho * 3072 + 1024 + idx);
            v[j] = v[j] * (1.0f + sc) + sh; }
        store_row_blk64((char*)F.ws + WS_HX, (size_t)row, F.lane, v);
    }
}
__device__ __forceinline__ void phase_ln_out(Frame& F) {
    const int gw = F.bid * 8 + F.wave, NGW = F.G * 8;
    for (int row = gw; row < RL; row += NGW) {
        float* src = F.out + (size_t)row * D;
        f32x4 v[4];
#pragma unroll
        for (int j = 0; j < 4; ++j) { const int idx = 256 * j + 4 * F.lane; const u32x2 f = __builtin_nontemporal_load((const u32x2*)((const char*)F.ws + WS_FO + (((((size_t)(row >> 8) * 4 + j) * 256 + (row & 255)) * 256) + 4 * F.lane) * 2));
            const f32x4 fv = {bf2f(f.x), bf2f(f.x >> 16), bf2f(f.y), bf2f(f.y >> 16)};
            const u32x2 xb = __builtin_nontemporal_load((const u32x2*)((const char*)src + 2048 + idx * 2));
            const f32x4 xv = {bf2f(xb.x), bf2f(xb.x >> 16), bf2f(xb.y), bf2f(xb.y >> 16)};
            v[j] = DN_ALPHA * xv + fv; }
        ln_row(v, F.in[I_LNG] + D, F.in[I_LNB] + D, F.lane);
#pragma unroll
        for (int j = 0; j < 4; ++j) __builtin_nontemporal_store(v[j], (f32x4*)(src + 256 * j + 4 * F.lane));
    }
}
__device__ __forceinline__ void cmul_acc(float& hr, float& hi, float ar, float ai, float sr, float si) { const float nr = ar * hr - ai * hi + sr, ni = ar * hi + ai * hr + si; hr = nr; hi = ni; }
#define SCAN_STAMP(k) do { if (PROBE_SSM_PART == 3 + (k)) pt0 = __builtin_amdgcn_s_memrealtime(); if (PROBE_SSM_PART == 2 + (k)) pt1 = __builtin_amdgcn_s_memrealtime(); } while (0)
__device__ __forceinline__ void scan_pair(Frame& F, const int g, const int b, unsigned long long& pt0, unsigned long long& pt1) {
    SCAN_STAMP(0);
    int n = F.lane; asm volatile("" : "+v"(n));
    const int wq = F.wave & 3, r = F.wave >> 2;
    LAS float* ex = (LAS float*)F.lds;
    const f32x4 za = *(const f32x4*)((const float*)(F.ws + WS_ZA) + ((size_t)(r * NG + g) * 64 + n) * 4);
    const float aTr = za[2], aTi = za[3];
    float hr, hi;
    LAS unsigned char* uct = F.lds + 16384;
    LAS float* sctx = (LAS float*)(F.lds + 16384 + 8 * 1040);
    {   const int tt = (F.wave * 64 + n) >> 1, hf = n & 1;
        f32x4 a0 = {0.f, 0.f, 0.f, 0.f}, a1 = a0;
#pragma unroll
        for (int ks = 0; ks < 4; ++ks) { const f32x4* rp = (const f32x4*)((const float*)(F.ws + WS_UCS) + ((((size_t)g * 4 + ks) * RC + b * CTXL + tt) * 16) + hf * 8); a0 += rp[0]; a1 += rp[1]; }
        u32x4 w; w.x = pk2(a0[0], a0[1]); w.y = pk2(a0[2], a0[3]); w.z = pk2(a1[0], a1[1]); w.w = pk2(a1[2], a1[3]);
        *(LAS u32x4*)(uct + (tt >> 5) * 1040 + ((tt & 31) * 16 + hf * 8) * 2) = w; }
    __syncthreads();
    {   const int kg = n >> 4, cl = n & 15;
        const char* m2 = (const char*)(F.ws + WS_M2 + (size_t)g * MiB);
#pragma unroll
        for (int jb = 0; jb < 2; ++jb) { const int j = (F.wave * 2 + jb) * 16 + cl;
            bf16x8 bm[16];
#pragma unroll
            for (int kt = 0; kt < 16; ++kt) bm[kt] = *(const bf16x8*)(m2 + ((size_t)((kt * 32 + kg * 8) >> 6) * 256 + j) * 128 + ((kt * 32 + kg * 8) & 63) * 2);
            f32x4 d = {0.f, 0.f, 0.f, 0.f};
#pragma unroll
            for (int kt = 0; kt < 16; ++kt) { const bf16x8 au = *(const LAS bf16x8*)(uct + (cl & 7) * 1040 + (kt * 32 + kg * 8) * 2);
                d = __builtin_amdgcn_mfma_f32_16x16x32_bf16(au, bm[kt], d, 0, 0, 0); }
            if (kg < 2) *(LAS f32x4*)(sctx + j * 8 + 4 * kg) = d; } }
    __syncthreads();
    float h0r = 0.f, h0i = 0.f;
    {   const LAS f32x4* sre = (const LAS f32x4*)(sctx + (r * 128 + n) * 8); const LAS f32x4* sim = (const LAS f32x4*)(sctx + (r * 128 + 64 + n) * 8);
        const f32x4 re0 = sre[0], re1 = sre[1], im0 = sim[0], im1 = sim[1];
        if (r == 0) {
#pragma unroll
            for (int c = 0; c < 8; ++c) cmul_acc(h0r, h0i, aTr, aTi, c < 4 ? re0[c & 3] : re1[c & 3], c < 4 ? im0[c & 3] : im1[c & 3]);
        } else {
#pragma unroll
            for (int c = 7; c >= 0; --c) cmul_acc(h0r, h0i, aTr, aTi, c < 4 ? re0[c & 3] : re1[c & 3], c < 4 ? im0[c & 3] : im1[c & 3]); } }
    SCAN_STAMP(1);
    constexpr int CPW = NCHB / 4; static_assert(CPW == 128, "scan register blocking");
    const int cb = b * NCHB + (r ? NCHB - CPW * (wq + 1) : CPW * wq);
    const bf16* re_row = (const bf16*)(F.ws + WS_S + (size_t)g * MiB) + ((size_t)(cb >> 3) * 256 + r * 128 + n) * 8;
    const bf16* im_row = re_row + 64 * 8;
    bf16* Xg = (bf16*)(F.ws + WS_X + (size_t)g * XPLANE) + TP + r * 128 + n;
#define SCAN_LOAD(HALF) do { _Pragma("unroll") for (int k = 0; k < 8; ++k) { const int kk = r ? (15 - 8 * (HALF) - k) : (8 * (HALF) + k); pre[k] = *(const u32x4*)(re_row + 2048 * kk); pim[k] = *(const u32x4*)(im_row + 2048 * kk); } } while (0)
#define SCAN_RE(i) bf2f(pre[(i) >> 3][((r ? 7 - ((i) & 7) : ((i) & 7)) >> 1)] >> (16 * ((r ? 7 - ((i) & 7) : ((i) & 7)) & 1)))
#define SCAN_IM(i) bf2f(pim[(i) >> 3][((r ? 7 - ((i) & 7) : ((i) & 7)) >> 1)] >> (16 * ((r ? 7 - ((i) & 7) : ((i) & 7)) & 1)))
    u32x4 pre[8], pim[8];
    float er = 0.f, ei = 0.f;
#pragma unroll
    for (int half = 0; half < 2; ++half) { SCAN_LOAD(half);
        if (r == 0) {
#pragma unroll
            for (int i = 0; i < 64; ++i) cmul_acc(er, ei, aTr, aTi, bf2f(pre[i >> 3][(i & 7) >> 1] >> (16 * (i & 1))), bf2f(pim[i >> 3][(i & 7) >> 1] >> (16 * (i & 1))));
        } else {
#pragma unroll
            for (int i = 0; i < 64; ++i) { const int e = 7 - (i & 7); cmul_acc(er, ei, aTr, aTi, bf2f(pre[i >> 3][e >> 1] >> (16 * (e & 1))), bf2f(pim[i >> 3][e >> 1] >> (16 * (e & 1)))); }
        }
        asm volatile("" ::: "memory"); }
    float qr = aTr, qi = aTi;
    for (int k = 1; k < CPW; k <<= 1) { const float nr = qr * qr - qi * qi, ni = 2.f * qr * qi; qr = nr; qi = ni; }
    __syncthreads();
    ex[((r * 4 + wq) * 64 + n) * 2] = er; ex[((r * 4 + wq) * 64 + n) * 2 + 1] = ei;
    __syncthreads();
    SCAN_STAMP(2);
    hr = h0r; hi = h0i;
    for (int k = 0; k < wq; ++k) cmul_acc(hr, hi, qr, qi, ex[((r * 4 + k) * 64 + n) * 2], ex[((r * 4 + k) * 64 + n) * 2 + 1]);
    LAS bf16* tile = (LAS bf16*)(F.lds + 8192 + F.wave * 1024);
    GAS char* hp = (GAS char*)(F.ws + WS_X + (size_t)g * XPLANE) + ((size_t)(TP / 64 + 2 * r + ((n & 15) >> 3)) * NCOL + (cb + (r ? CPW - 1 - (n >> 4) : (n >> 4)))) * 128 + (n & 7) * 16;
    const long hstep4 = (r ? -4L : 4L) * 128;
#pragma unroll
    for (int half = 0; half < 2; ++half) { SCAN_LOAD(half);
        if (r == 0) {
#pragma unroll
            for (int i = 0; i < 64; ++i) {
                ((LAS unsigned*)tile)[(i & 3) * 64 + n] = pk2(hr, hi);
                if ((i & 3) == 3) { const u32x4 w = *(const LAS u32x4*)((const LAS char*)tile + n * 16); *(GAS u32x4*)hp = w; hp += hstep4; asm volatile("" : "+v"(hp)); }
                cmul_acc(hr, hi, aTr, aTi, bf2f(pre[i >> 3][(i & 7) >> 1] >> (16 * (i & 1))), bf2f(pim[i >> 3][(i & 7) >> 1] >> (16 * (i & 1)))); }
        } else {
#pragma unroll
            for (int i = 0; i < 64; ++i) { const int e = 7 - (i & 7);
                ((LAS unsigned*)tile)[(i & 3) * 64 + n] = pk2(hr, hi);
                if ((i & 3) == 3) { const u32x4 w = *(const LAS u32x4*)((const LAS char*)tile + n * 16); *(GAS u32x4*)hp = w; hp += hstep4; asm volatile("" : "+v"(hp)); }
                cmul_acc(hr, hi, aTr, aTi, bf2f(pre[i >> 3][e >> 1] >> (16 * (e & 1))), bf2f(pim[i >> 3][e >> 1] >> (16 * (e & 1)))); }
        }
        asm volatile("" ::: "memory"); }
#undef SCAN_LOAD
#undef SCAN_RE
#undef SCAN_IM
    if (PROBE_SSM_PART == 5) { VM_WAIT(); SCAN_STAMP(3); }
}

constexpr int N_PHASES = 11;
template <class P> __device__ __forceinline__ void run_gemm(Frame& F, const P& p, int bit) {
    if ((NAIVE_MASK >> bit) & 1) g8::gemm_phase_naive<P>(F.lds, p, F.G, F.bid); else g8::gemm_phase<P>(F.lds, p, F.G, F.bid);
}
__global__ void __launch_bounds__(512, 2) mk_fwd(Args args) {
    extern __shared__ __attribute__((aligned(16))) unsigned char lds_raw[];
    Frame F;
    F.lds = (LAS unsigned char*)lds_raw;
    F.tid = threadIdx.x; F.lane = F.tid & 63; F.wave = __builtin_amdgcn_readfirstlane(F.tid >> 6); F.G = gridDim.x; F.bid = blockIdx.x;
#pragma unroll
    for (int i = 0; i < 23; ++i) F.in[i] = args.in[i];
    F.out = args.out; F.ws = args.ws;
    volatile LAS unsigned* MISC = (volatile LAS unsigned*)(F.lds + MISC_OFF);
    if (F.tid < 32) MISC[F.tid] = 0u;
    __syncthreads();
    XcdBarrier bar; bar.bar = (unsigned*)(F.ws + WS_CTL) + CW_BAR; bar.x = 0; bar.st = nullptr;
    if (MK_N_LAUNCHES == 1) bar = xcd_barrier_post((unsigned*)(F.ws + WS_CTL) + CW_BAR, MISC + 8);
    const int lo = args.ph_lo, hi = args.ph_hi;
#define IN(k) (lo <= (k) && (k) < hi)
#define REP(k) for (int rep_ = 0; rep_ < 1 + ((k) == PROBE_REP_PHASE ? PROBE_REP_N : 0); ++rep_)
#define SEAM(k) do { if (IN(k) && IN((k) + 1)) xcd_barrier(bar); if ((k) + 1 == PROBE_T_LO) pt0 = __builtin_amdgcn_s_memrealtime(); if ((k) == PROBE_T_HI) pt1 = __builtin_amdgcn_s_memrealtime(); } while (0)
    unsigned long long pt0 = (PROBE_T_LO == 0) ? __builtin_amdgcn_s_memrealtime() : 0ull, pt1 = 0ull;
    unsigned char* ws = F.ws; const float* mod = (const float*)(ws + WS_MOD);
    if (IN(0)) REP(0) { phase_prep(F); }
    if (IN(1)) REP(1) { phase_mod0(F);
        if (IN(2)) { LAS float* cwl = (LAS float*)(F.lds + CWL_OFF); for (int e = F.tid; e < 3 * 2048; e += 512) cwl[e] = F.in[I_CW][e]; } } SEAM(1);
    if (IN(2)) REP(2) { if (!IN(1)) { LAS float* cwl = (LAS float*)(F.lds + CWL_OFF); for (int e = F.tid; e < 3 * 2048; e += 512) cwl[e] = F.in[I_CW][e]; __syncthreads(); } g8::ProbG1 p{(const char*)ws + WS_HX, (const char*)F.out, (const char*)ws + WS_W1, F.in[I_CW], (char*)ws + WS_A2}; run_gemm(F, p, 0);
        { const int nun = (RT / 256) * 32, full = nun / F.G, rem = nun - full * F.G;
          __syncthreads();
          if (rem > 0 && rem < F.G) { if (F.bid >= rem) prep_tr_late(F, rem, F.G - rem); } else prep_tr_late(F, 0, F.G); } } SEAM(2);
    if (IN(3)) REP(3) { g8::ProbG2 p{(const char*)ws + WS_A2, (const char*)ws + WS_W2, mod, (char*)F.out, (float*)(ws + WS_Y1S)}; run_gemm(F, p, 1); } SEAM(3);
    if (IN(4)) REP(4) { phase_ln_mod1(F); } SEAM(4);
    if (IN(5)) REP(5) { g8::ProbG3 p{(const char*)ws + WS_HX, (const char*)ws + WS_W3, (char*)ws + WS_X, (float*)(ws + WS_UCS), (char*)ws + WS_SZ, 0}; run_gemm(F, p, 2); } SEAM(5);
    if (IN(6)) REP(6) {
        for (int pl = F.bid; pl < NG * NBATCH; pl += F.G) { const int wg = g8::xcd_remap(pl, NG * NBATCH), g = wg >> 1, b = wg & 1;
            if (PROBE_SSM_PART == 0) pt0 = __builtin_amdgcn_s_memrealtime();
            { g8::ProbS p{(const char*)ws + WS_X, (const char*)ws + WS_M2, (char*)ws + WS_S, g, b}; if ((NAIVE_MASK >> 3) & 1) g8::gemm_phase_naive(F.lds, p, 1, 0); else g8::gemm_phase(F.lds, p, 1, 0); }
            VM_WAIT(); __syncthreads();
            if (PROBE_SSM_PART == 0) pt1 = __builtin_amdgcn_s_memrealtime(); if (PROBE_SSM_PART == 1) pt0 = __builtin_amdgcn_s_memrealtime();
            scan_pair(F, g, b, pt0, pt1);
            if (PROBE_SSM_PART >= 0) VM_WAIT();
            __syncthreads();
            if (PROBE_SSM_PART == 1) pt1 = __builtin_amdgcn_s_memrealtime(); if (PROBE_SSM_PART == 2) pt0 = __builtin_amdgcn_s_memrealtime();
            if (F.tid == 0) (void)xb_add((unsigned*)(ws + WS_CTL) + CW_PAIR + g, 1u);
            { g8::ProbY p{(const char*)ws + WS_X, (const char*)ws + WS_KR, (const char*)ws + WS_M4, (char*)ws + WS_G, g, b, (unsigned*)(ws + WS_CTL) + CW_PAIR + g}; if ((NAIVE_MASK >> 4) & 1) g8::gemm_phase_naive(F.lds, p, 1, 0); else g8::gemm_phase(F.lds, p, 1, 0); }
            VM_WAIT(); __syncthreads(); if (PROBE_SSM_PART == 2) pt1 = __builtin_amdgcn_s_memrealtime(); } } SEAM(6);
    if (IN(7)) REP(7) { g8::ProbG3 p{(const char*)ws + WS_HX, (const char*)ws + WS_W3, (char*)ws + WS_X, (float*)(ws + WS_UCS), (char*)ws + WS_SZ, 1}; run_gemm(F, p, 5); VM_WAIT(); __syncthreads(); }
    if (IN(8)) REP(8) { g8::ProbG4 p{(const char*)ws + WS_G, (const char*)ws + WS_WG, (const char*)ws + WS_SZ, F.in[I_BGLU], (char*)ws + WS_A4}; run_gemm(F, p, 6); } SEAM(8);
    if (IN(9)) REP(9) { g8::ProbG5 p{(const char*)ws + WS_A4, (const char*)ws + WS_W5, mod, (char*)ws + WS_FO}; run_gemm(F, p, 7); } SEAM(9);
    if (IN(10)) REP(10) { phase_ln_out(F); }
    if (PROBE_T_LO >= 0 || PROBE_SSM_PART >= 0) { if (PROBE_T_HI == 10) { VM_WAIT(); pt1 = __builtin_amdgcn_s_memrealtime(); }
        if (F.bid == 0 && F.tid == 0) { const unsigned long long tgt = __builtin_amdgcn_s_memrealtime() + (unsigned long long)PROBE_T_MULT * (pt1 - pt0);
            while (__builtin_amdgcn_s_memrealtime() < tgt) __builtin_amdgcn_s_sleep(8); } }
#undef IN
#undef SEAM
}

extern "C" void kernel_launch(void* const* d_in, const int* in_sizes, int n_in, void* d_out, int out_size, void* d_ws, size_t ws_size, hipStream_t stream) {
    static int grid = 0;
    if (grid == 0) {
        if (n_in != 23 || in_sizes[0] != RL * D || out_size != RL * D || ws_size < WS_END) { fprintf(stderr, "kernel_launch: unexpected shapes (n_in %d, in0 %d, out %d, ws %zu); nothing launched\n", n_in, n_in > 0 ? in_sizes[0] : -1, out_size, ws_size); grid = -1; return; }
        int dev = 0, cus = 0, per_cu = 0;
        if (hipGetDevice(&dev) != hipSuccess || hipDeviceGetAttribute(&cus, hipDeviceAttributeMultiprocessorCount, dev) != hipSuccess) { grid = -1; return; }
        if (hipFuncSetAttribute((const void*)mk_fwd, hipFuncAttributeMaxDynamicSharedMemorySize, LDS_BYTES) != hipSuccess) { fprintf(stderr, "kernel_launch: hipFuncSetAttribute failed\n"); grid = -1; return; }
        if (hipOccupancyMaxActiveBlocksPerMultiprocessor(&per_cu, (const void*)mk_fwd, 512, LDS_BYTES) != hipSuccess || per_cu < 1) { fprintf(stderr, "kernel_launch: occupancy query says %d\n", per_cu); per_cu = 1; }
        (void)hipGetLastError();
        grid = cus * 1;
        if (per_cu < 1) grid = -1;
    }
    if (grid < 0) return;
    (void)hipMemsetAsync((char*)d_ws + WS_CTL, 0, CTL_ZERO_BYTES, stream);
    Args a{};
    for (int i = 0; i < 23; ++i) a.in[i] = (const float*)d_in[i];
    a.out = (float*)d_out; a.ws = (unsigned char*)d_ws;
    if (MK_N_LAUNCHES == 1) {
        a.ph_lo = 0; a.ph_hi = N_PHASES;
        void* kargs[] = {&a};
        hipError_t e = hipLaunchCooperativeKernel((const void*)mk_fwd, dim3(grid), dim3(512), kargs, LDS_BYTES, stream);
        if (e != hipSuccess) fprintf(stderr, "kernel_launch: cooperative launch failed: %s (grid %d)\n", hipGetErrorString(e), grid);
    } else {
        for (int ph = 0; ph < N_PHASES; ++ph) { a.ph_lo = ph; a.ph_hi = ph + 1; hipLaunchKernelGGL(mk_fwd, dim3(grid), dim3(512), LDS_BYTES, stream, a); }
    }
}
```
